# Optimizing an MI355X kernel written in HIP

```python
import math
import jax, jax.numpy as jnp
from jax import lax
import numpy as np


D_MODEL = 1024
BATCH = 8
SEQ = 4096
DEPTH = 2

N_HEADS = 8
HEAD_DIM = 128
N_KV_HEADS = 2
Q_PER_KV = N_HEADS // N_KV_HEADS
ATTN_WIDTH = N_HEADS * HEAD_DIM
KV_WIDTH = N_KV_HEADS * HEAD_DIM
IDX_HEADS = 8
IDX_DIM = 64
TOPK_MAX = 256
Q_BLOCK = 128
ROPE_THETA = 500000.0
ROPE_FRACTION = 4

SSD_EXPAND = 2
SSD_INNER = SSD_EXPAND * D_MODEL
SSD_HEAD_DIM = 64
SSD_HEADS = SSD_INNER // SSD_HEAD_DIM
SSD_GROUPS = 4
SSD_HEADS_PER_GROUP = SSD_HEADS // SSD_GROUPS
SSD_STATE = 128
SSD_CONV = 4
SSD_CHUNK = 128
SSD_CONV_DIM = SSD_INNER + 2 * SSD_GROUPS * SSD_STATE

FFN_DIM = 2816
FFN_CONV = 3
NORM_EPS = 1e-6

IN_SPLITS = (ATTN_WIDTH, KV_WIDTH, KV_WIDTH, IDX_HEADS * IDX_DIM, IDX_DIM, IDX_HEADS,
             SSD_INNER, SSD_CONV_DIM, SSD_HEADS, D_MODEL, D_MODEL)
IN_COLS = (ATTN_WIDTH + 2 * KV_WIDTH + IDX_HEADS * IDX_DIM + IDX_DIM + IDX_HEADS
           + SSD_INNER + SSD_CONV_DIM + SSD_HEADS + 2 * D_MODEL)

kernel_name = 'hybrid_dsa_ssd_convffn'


def rms_norm(x, w):
    xf = x.astype(jnp.float32)
    y = xf * lax.rsqrt(jnp.mean(xf * xf, axis=-1, keepdims=True) + NORM_EPS)
    return (y * w.astype(jnp.float32)).astype(x.dtype)


def rope_tables(seq, rot_dim):
    inv = ROPE_THETA ** (-jnp.arange(0, rot_dim, 2, dtype=jnp.float32) / rot_dim)
    ang = jnp.arange(seq, dtype=jnp.float32)[:, None] * inv[None, :]
    return jnp.cos(ang), jnp.sin(ang)


def apply_partial_rope(t, cos, sin):
    half = cos.shape[-1]
    rot = 2 * half
    c = cos[None, :, None, :]
    s = sin[None, :, None, :]
    tf = t[..., :rot].astype(jnp.float32)
    x1, x2 = tf[..., :half], tf[..., half:]
    r = jnp.concatenate([x1 * c - x2 * s, x2 * c + x1 * s], axis=-1).astype(t.dtype)
    return jnp.concatenate([r, t[..., rot:]], axis=-1)


def causal_dwconv(u, w, b):
    width = w.shape[0]
    seq = u.shape[1]
    up = jnp.pad(u, ((0, 0), (width - 1, 0), (0, 0)))
    out = b
    for j in range(width):
        out = out + up[:, j:j + seq] * w[j]
    return out


def dsa_attention(q, k, v, q_idx, k_idx, w_idx):
    bsz, seq = q.shape[0], q.shape[1]
    topk = min(TOPK_MAX, seq // 4)
    n_blk = seq // Q_BLOCK
    kv = jnp.concatenate([k, v], axis=-1)
    k_idx_f = k_idx.astype(jnp.float32)
    kpos = jnp.arange(seq)
    scale = HEAD_DIM ** -0.5

    def block(i):
        t0 = i * Q_BLOCK
        sl = lambda a: lax.dynamic_slice_in_dim(a, t0, Q_BLOCK, axis=1)
        qpos = t0 + jnp.arange(Q_BLOCK)
        qi = sl(q_idx).astype(jnp.float32)
        wi = sl(w_idx).astype(jnp.float32)
        rel = jax.nn.relu(jnp.einsum('bqhd,bsd->bqhs', qi, k_idx_f))
        score = jnp.einsum('bqhs,bqh->bqs', rel, wi)
        causal = kpos[None, :] <= qpos[:, None]
        score = jnp.where(causal[None], score, -jnp.inf)
        _, sel = lax.top_k(score, topk)
        valid = sel <= qpos[None, :, None]
        kv_sel = jax.vmap(lambda a, ix: a[ix])(kv, sel)
        k_sel, v_sel = kv_sel[..., :HEAD_DIM], kv_sel[..., HEAD_DIM:]
        qb = sl(q).reshape(bsz, Q_BLOCK, N_KV_HEADS, Q_PER_KV, HEAD_DIM)
        logits = jnp.einsum('bqhgd,bqkhd->bqhgk', qb, k_sel).astype(jnp.float32) * scale
        logits = jnp.where(valid[:, :, None, None, :], logits, -jnp.inf)
        p = jax.nn.softmax(logits, axis=-1).astype(v.dtype)
        o = jnp.einsum('bqhgk,bqkhd->bqhgd', p, v_sel)
        return o.reshape(bsz, Q_BLOCK, ATTN_WIDTH)

    out = lax.map(block, jnp.arange(n_blk))
    return out.transpose(1, 0, 2, 3).reshape(bsz, seq, ATTN_WIDTH)


def ssd_scan(xdt, adt, bm, cm):
    bsz, seq = xdt.shape[0], xdt.shape[1]
    nc = seq // SSD_CHUNK
    X = xdt.reshape(bsz, nc, SSD_CHUNK, SSD_GROUPS, SSD_HEADS_PER_GROUP, SSD_HEAD_DIM)
    Bc = bm.reshape(bsz, nc, SSD_CHUNK, SSD_GROUPS, SSD_STATE)
    Cc = cm.reshape(bsz, nc, SSD_CHUNK, SSD_GROUPS, SSD_STATE)
    A = adt.reshape(bsz, nc, SSD_CHUNK, SSD_GROUPS, SSD_HEADS_PER_GROUP).transpose(0, 3, 4, 1, 2)
    A_cs = jnp.cumsum(A, axis=-1)
    tril = jnp.tril(jnp.ones((SSD_CHUNK, SSD_CHUNK), dtype=bool))
    seg = A_cs[..., :, None] - A_cs[..., None, :]
    Lmat = jnp.exp(jnp.where(tril, seg, -jnp.inf))
    CB = jnp.einsum('bclgn,bcsgn->bcgls', Cc, Bc)
    y_diag = jnp.einsum('bcgls,bgecls,bcsgep->bclgep', CB, Lmat, X)
    decay_states = jnp.exp(A_cs[..., -1:] - A_cs)
    states = jnp.einsum('bclgn,bgecl,bclgep->bcgepn', Bc, decay_states, X)
    chunk_decay = jnp.exp(A_cs[..., -1])

    def step(h, inp):
        s_c, d_c = inp
        return h * d_c[..., None, None] + s_c, h

    h0 = jnp.zeros(states.shape[:1] + states.shape[2:], states.dtype)
    _, states_in = lax.scan(step, h0, (states.transpose(1, 0, 2, 3, 4, 5), chunk_decay.transpose(3, 0, 1, 2)))
    states_in = states_in.transpose(1, 0, 2, 3, 4, 5)
    y_off = jnp.einsum('bclgn,bcgepn,bgecl->bclgep', Cc, states_in, jnp.exp(A_cs))
    return (y_diag + y_off).reshape(bsz, seq, SSD_HEADS, SSD_HEAD_DIM)


def mamba2_branch(z, xbc, dt_raw, conv_w, conv_b, dt_bias, a_log, d_skip, norm_w):
    bsz, seq = z.shape[0], z.shape[1]
    xbc = jax.nn.silu(causal_dwconv(xbc, conv_w, conv_b))
    gn = SSD_GROUPS * SSD_STATE
    xs = xbc[..., :SSD_INNER].reshape(bsz, seq, SSD_HEADS, SSD_HEAD_DIM)
    bm = xbc[..., SSD_INNER:SSD_INNER + gn].reshape(bsz, seq, SSD_GROUPS, SSD_STATE)
    cm = xbc[..., SSD_INNER + gn:].reshape(bsz, seq, SSD_GROUPS, SSD_STATE)
    dt = jax.nn.softplus(dt_raw.astype(jnp.float32) + dt_bias.astype(jnp.float32))
    A = -jnp.exp(a_log.astype(jnp.float32))
    y = ssd_scan(xs * dt[..., None], dt * A, bm, cm) + xs * d_skip[:, None]
    y = y.reshape(bsz, seq, SSD_INNER) * jax.nn.silu(z.astype(jnp.float32))
    yg = y.astype(jnp.float32).reshape(bsz, seq, SSD_GROUPS, SSD_INNER // SSD_GROUPS)
    yg = yg * lax.rsqrt(jnp.mean(yg * yg, axis=-1, keepdims=True) + NORM_EPS)
    y = yg.reshape(bsz, seq, SSD_INNER) * norm_w.astype(jnp.float32)
    return y.astype(z.dtype)


def hybrid_mixer(h, w_in, ssd_conv_w, ssd_conv_b, ssd_dt_bias, ssd_a_log, ssd_d, ssd_norm_w,
                 w_proj_attn, w_proj_ssd, w_out):
    bsz, seq = h.shape[0], h.shape[1]
    proj = h @ w_in
    offsets = np.cumsum(np.array(IN_SPLITS))[:-1].tolist()
    (q, k, v, qi, ki, wi, z, xbc, dt_raw, g_attn, g_ssd) = jnp.split(proj, offsets, axis=-1)
    cos_a, sin_a = rope_tables(seq, HEAD_DIM // ROPE_FRACTION)
    cos_i, sin_i = rope_tables(seq, IDX_DIM // ROPE_FRACTION)
    q = apply_partial_rope(q.reshape(bsz, seq, N_HEADS, HEAD_DIM), cos_a, sin_a)
    k = apply_partial_rope(k.reshape(bsz, seq, N_KV_HEADS, HEAD_DIM), cos_a, sin_a)
    v = v.reshape(bsz, seq, N_KV_HEADS, HEAD_DIM)
    qi = apply_partial_rope(qi.reshape(bsz, seq, IDX_HEADS, IDX_DIM), cos_i, sin_i)
    ki = apply_partial_rope(ki.reshape(bsz, seq, 1, IDX_DIM), cos_i, sin_i)[:, :, 0]
    a = dsa_attention(q, k, v, qi, ki, wi)
    b = mamba2_branch(z, xbc, dt_raw, ssd_conv_w, ssd_conv_b, ssd_dt_bias, ssd_a_log, ssd_d, ssd_norm_w)
    merged = jax.nn.sigmoid(g_attn) * (a @ w_proj_attn) + jax.nn.sigmoid(g_ssd) * (b @ w_proj_ssd)
    return merged @ w_out


def conv_glu_ffn(h, w_up, conv_w, conv_b, w_down):
    u = causal_dwconv(h @ w_up, conv_w, conv_b)
    gate, val = u[..., :FFN_DIM], u[..., FFN_DIM:]
    return (jax.nn.silu(gate) * val) @ w_down


def setup_inputs(seed: int = 0) -> dict:
    key = jax.random.key(seed)
    ks = jax.random.split(key, 20)
    nrm = lambda k, shape, s: jax.random.normal(k, shape, jnp.float32) * s
    x = nrm(ks[0], (BATCH, SEQ, D_MODEL), 1.0)
    norm_mix_w = 1.0 + nrm(ks[1], (DEPTH, D_MODEL), 0.02)
    w_in = nrm(ks[2], (DEPTH, D_MODEL, IN_COLS), D_MODEL ** -0.5)
    ssd_conv_w = nrm(ks[3], (DEPTH, SSD_CONV, SSD_CONV_DIM), SSD_CONV ** -0.5)
    ssd_conv_b = nrm(ks[4], (DEPTH, SSD_CONV_DIM), 0.01)
    u = jax.random.uniform(ks[5], (DEPTH, SSD_HEADS), jnp.float32)
    dt0 = jnp.exp(u * (math.log(0.1) - math.log(0.001)) + math.log(0.001))
    ssd_dt_bias = dt0 + jnp.log(-jnp.expm1(-dt0))
    ssd_a_log = jnp.log(jax.random.uniform(ks[6], (DEPTH, SSD_HEADS), jnp.float32, minval=1.0, maxval=16.0))
    ssd_d = 1.0 + nrm(ks[7], (DEPTH, SSD_HEADS), 0.1)
    ssd_norm_w = 1.0 + nrm(ks[8], (DEPTH, SSD_INNER), 0.02)
    w_proj_attn = nrm(ks[9], (DEPTH, ATTN_WIDTH, D_MODEL), ATTN_WIDTH ** -0.5)
    w_proj_ssd = nrm(ks[10], (DEPTH, SSD_INNER, D_MODEL), SSD_INNER ** -0.5)
    w_out = nrm(ks[11], (DEPTH, D_MODEL, D_MODEL), D_MODEL ** -0.5)
    norm_ffn_w = 1.0 + nrm(ks[12], (DEPTH, D_MODEL), 0.02)
    ffn_w_up = nrm(ks[13], (DEPTH, D_MODEL, 2 * FFN_DIM), D_MODEL ** -0.5)
    ffn_conv_w = nrm(ks[14], (DEPTH, FFN_CONV, 2 * FFN_DIM), FFN_CONV ** -0.5)
    ffn_conv_b = nrm(ks[15], (DEPTH, 2 * FFN_DIM), 0.01)
    ffn_w_down = nrm(ks[16], (DEPTH, FFN_DIM, D_MODEL), FFN_DIM ** -0.5)
    norm_final_w = 1.0 + nrm(ks[17], (D_MODEL,), 0.02)
    return {'x': x, 'norm_mix_w': norm_mix_w, 'w_in': w_in, 'ssd_conv_w': ssd_conv_w,
            'ssd_conv_b': ssd_conv_b, 'ssd_dt_bias': ssd_dt_bias, 'ssd_a_log': ssd_a_log,
            'ssd_d': ssd_d, 'ssd_norm_w': ssd_norm_w, 'w_proj_attn': w_proj_attn,
            'w_proj_ssd': w_proj_ssd, 'w_out': w_out, 'norm_ffn_w': norm_ffn_w,
            'ffn_w_up': ffn_w_up, 'ffn_conv_w': ffn_conv_w, 'ffn_conv_b': ffn_conv_b,
            'ffn_w_down': ffn_w_down, 'norm_final_w': norm_final_w}


def reference(x, norm_mix_w, w_in, ssd_conv_w, ssd_conv_b, ssd_dt_bias, ssd_a_log, ssd_d, ssd_norm_w,
              w_proj_attn, w_proj_ssd, w_out, norm_ffn_w, ffn_w_up, ffn_conv_w, ffn_conv_b,
              ffn_w_down, norm_final_w):
    for l in range(DEPTH):
        h = rms_norm(x, norm_mix_w[l])
        x = x + hybrid_mixer(h, w_in[l], ssd_conv_w[l], ssd_conv_b[l], ssd_dt_bias[l], ssd_a_log[l],
                             ssd_d[l], ssd_norm_w[l], w_proj_attn[l], w_proj_ssd[l], w_out[l])
        h = rms_norm(x, norm_ffn_w[l])
        x = x + conv_glu_ffn(h, ffn_w_up[l], ffn_conv_w[l], ffn_conv_b[l], ffn_w_down[l])
    return rms_norm(x, norm_final_w)
```

```cpp
#include <hip/hip_runtime.h>
#include <hip/hip_cooperative_groups.h>
#include <cstdio>
#include <cmath>
namespace cg = cooperative_groups;

#define LAS __attribute__((address_space(3)))
typedef unsigned short bf16_t;
typedef short bf16x8 __attribute__((ext_vector_type(8)));
typedef float f32x4 __attribute__((ext_vector_type(4)));
typedef unsigned u32x2 __attribute__((ext_vector_type(2)));
typedef unsigned u32x4 __attribute__((ext_vector_type(4)));

constexpr int D_MODEL = 1024, SEQ = 4096, NTOK = 32768, SLAB = 16384, NSLAB = 2, DEPTH = 2;
constexpr int IN_COLS = 9320, NP = 9472;
constexpr int C_Q = 0, C_K = 1024, C_V = 1280, C_QI = 1536, C_MISC = 2048, C_Z = 2304, C_XBC = 4352, C_GA = 7424, C_GS = 8448;
constexpr int FFN = 2816, FFN2 = 5632;
constexpr float EPS = 1e-6f;

constexpr size_t SZ_WIN = (size_t)NP * 1024 * 2, SZ_WPA = (size_t)1024 * 1024 * 2, SZ_WPS = (size_t)1024 * 2048 * 2, SZ_WO = SZ_WPA,
                 SZ_WUP = (size_t)FFN2 * 1024 * 2, SZ_WDN = (size_t)1024 * FFN * 2;
constexpr size_t SZ_WL = SZ_WIN + SZ_WPA + SZ_WPS + SZ_WO + SZ_WUP + SZ_WDN;
constexpr size_t OFF_W = 0;
constexpr size_t OFF_ROPE = OFF_W + 2 * SZ_WL;
constexpr size_t OFF_H = OFF_ROPE + (size_t)4096 * 48 * 4;
constexpr size_t OFF_PROJ = OFF_H + (size_t)SLAB * 1024 * 2;
constexpr size_t OFF_MISC = OFF_PROJ + (size_t)SLAB * NP * 2;
constexpr size_t OFF_MASK = OFF_MISC + (size_t)SLAB * 256 * 4;
constexpr size_t OFF_SEL = OFF_MASK + (size_t)SLAB * 128 * 4;
constexpr size_t OFF_SSQ = OFF_SEL + (size_t)SLAB * 256 * 4;
constexpr size_t OFF_VT = OFF_SSQ + (size_t)SLAB * 32 * 4;
constexpr size_t OFF_END = OFF_VT + (size_t)4 * 2 * 128 * 4096 * 2;
constexpr size_t OFF_GL = OFF_PROJ + (size_t)SLAB * FFN2 * 2;

constexpr int LDS_BYTES = 147456;

struct Params {
    const float* x; const float* norm_mix_w; const float* w_in; const float* ssd_conv_w; const float* ssd_conv_b;
    const float* ssd_dt_bias; const float* ssd_a_log; const float* ssd_d; const float* ssd_norm_w;
    const float* w_proj_attn; const float* w_proj_ssd; const float* w_out; const float* norm_ffn_w;
    const float* ffn_w_up; const float* ffn_conv_w; const float* ffn_conv_b; const float* ffn_w_down; const float* norm_final_w;
    float* out; unsigned char* ws;
    float invA[16]; float invI[8];
};

__device__ __forceinline__ int opaque_tid() { int t = threadIdx.x; asm volatile("" : "+v"(t)); return t; }
__device__ __forceinline__ float bf2f(bf16_t b) { return __uint_as_float(((unsigned)b) << 16); }
__device__ __forceinline__ bf16_t f2bf(float f) { unsigned u = __float_as_uint(f); u += 0x7FFFu + ((u >> 16) & 1u); return (bf16_t)(u >> 16); }
__device__ __forceinline__ unsigned pack2(float lo, float hi) { return (unsigned)f2bf(lo) | ((unsigned)f2bf(hi) << 16); }
__device__ __forceinline__ float lo16(unsigned w) { return __uint_as_float(w << 16); }
__device__ __forceinline__ float hi16(unsigned w) { return __uint_as_float(w & 0xffff0000u); }
__device__ __forceinline__ float silu_f(float v) { return v / (1.0f + __expf(-v)); }
__device__ __forceinline__ float sigmoid_f(float v) { return 1.0f / (1.0f + __expf(-v)); }
__device__ __forceinline__ void wave_lds_sync() { __builtin_amdgcn_fence(__ATOMIC_SEQ_CST, "wavefront"); __builtin_amdgcn_wave_barrier(); }
__device__ __forceinline__ float wave_sum(float v) {
#pragma unroll
    for (int o = 32; o >= 1; o >>= 1) v += __shfl_xor(v, o);
    return v;
}
__device__ __forceinline__ float wave_max(float v) {
#pragma unroll
    for (int o = 32; o >= 1; o >>= 1) v = fmaxf(v, __shfl_xor(v, o));
    return v;
}
__device__ __forceinline__ int permI(int p) { return p < 8 ? p : (p < 16 ? p + 8 : (p < 24 ? p - 8 : p)); }
__device__ __forceinline__ int inproj_map(int n) {
    if (n < C_QI) return n;
    if (n < C_MISC) { const int r = n - C_QI; return C_QI + (r & ~63) + permI(r & 63); }
    if (n < C_Z) { const int c = n - C_MISC; if (c < 64) return 2048 + permI(c); if (c < 72) return 2112 + (c - 64); if (c < 104) return 7240 + (c - 72); return -1; }
    if (n < C_XBC) return 2120 + (n - C_Z);
    if (n < C_GA) return 4168 + (n - C_XBC);
    if (n < C_GS) return 7272 + (n - C_GA);
    return 8296 + (n - C_GS);
}

namespace pg8 {
constexpr int BM = 256, BK = 64, HALF = 128, HTB = HALF * BK * 2, NXCD = 8, WGM = 8;
__device__ __forceinline__ int lds_byte(int r, int c) { const int st = (r >> 4) * 2 + (c >> 5), rr = r & 15, cc = c & 31, ob = rr * 64 + cc * 2; return st * 1024 + (ob ^ (((ob >> 9) & 1) << 5)); }
__device__ __forceinline__ void stage_rc(int b, int& R, int& C) { const int st = b / 1024, sb = b % 1024, swz = sb ^ (((sb >> 9) & 1) << 5); R = (st >> 1) * 16 + swz / 64; C = (st & 1) * 32 + (swz % 64) / 2; }
struct Unit { int pm, pn; };
struct StaticOrder {
    int nM, nN, nwg, G, c;
    __device__ void init(int M, int N, int G_, int c_) { nM = M / BM; nN = N / BM; nwg = nM * nN; G = G_; c = c_; }
    __device__ bool next(int i, Unit& u) const {
        const long L = (long)i * G + c; if (L >= nwg) return false;
        int wgid = (int)L; { const int q = nwg / NXCD, r = nwg % NXCD, xcd = wgid % NXCD, off = wgid / NXCD; wgid = (xcd < r ? xcd * (q + 1) : r * (q + 1) + (xcd - r) * q) + off; }
        const int nig = WGM * nN, gid = wgid / nig, fm = gid * WGM, gsz = (nM - fm) < WGM ? (nM - fm) : WGM;
        u.pm = fm + ((wgid % nig) % gsz); u.pn = (wgid % nig) / gsz; return true;
    }
};
__device__ __forceinline__ unsigned cvt_pk_bf16(float lo, float hi) { unsigned r; asm volatile("v_cvt_pk_bf16_f32 %0, %1, %2" : "=v"(r) : "v"(lo), "v"(hi)); return r; }

template <class Epi>
__device__ __forceinline__ void gemm_phase(LAS unsigned char* lds, const bf16_t* A, int lda, const bf16_t* Bt, int M, int N, int K, const Epi& E) {
    const int tid = opaque_tid(), wid = __builtin_amdgcn_readfirstlane(tid >> 6), lane = tid & 63, wr = wid >> 2, wc = wid & 3, fr = lane & 15, fq = lane >> 4;
    const int nt = K / BK;
    StaticOrder S; S.init(M, N, (int)gridDim.x, (int)blockIdx.x);
    unsigned voffA[2], voffB[2];
#pragma unroll
    for (int i = 0; i < 2; ++i) { int R, C; stage_rc(tid * 16 + i * 8192, R, C); voffA[i] = (unsigned)(R * lda + C) * 2u; voffB[i] = (unsigned)(R * K + C) * 2u; }
    const size_t kstep = (size_t)(BK * 2);
    const size_t hstepA = (size_t)HALF * lda * 2, hstepB = (size_t)HALF * K * 2;
    const size_t tstepA = 2 * hstepA, tstepB = 2 * hstepB;
    const unsigned ldsw = (unsigned)wid * 1024u;
    const int aoff = lds_byte(wr * 64 + fr, fq * 8), boff = lds_byte(wc * 32 + fr, fq * 8);
#define PG8_SA(b, h) (((b) * 2 + (h)) * HTB)
#define PG8_SB(b, h) ((4 + (b) * 2 + (h)) * HTB)
#define PG8_STAGE(bufoff, gbase, voff) do { _Pragma("unroll") for (int _i = 0; _i < 2; ++_i) \
        __builtin_amdgcn_global_load_lds((const unsigned*)((const char*)(gbase) + (voff)[_i]), (LAS unsigned*)(lds + (bufoff) + ldsw + _i * 8192), 16, 0, 0); } while (0)
#define PG8_LDA(dst, b, h) do { _Pragma("unroll") for (int m = 0; m < 4; ++m) _Pragma("unroll") for (int k = 0; k < 2; ++k) dst[m][k] = *(const LAS bf16x8*)(lds + PG8_SA(b, h) + aoff + m * 2048 + k * 1024); } while (0)
#define PG8_LDB(dst, b, h) do { _Pragma("unroll") for (int n = 0; n < 2; ++n) _Pragma("unroll") for (int k = 0; k < 2; ++k) dst[n][k] = *(const LAS bf16x8*)(lds + PG8_SB(b, h) + boff + n * 2048 + k * 1024); } while (0)
#define PG8_MMA(ai, bj, At, Bt_) do { __builtin_amdgcn_s_setprio(1); _Pragma("unroll") for (int m = 0; m < 4; ++m) _Pragma("unroll") for (int n = 0; n < 2; ++n) _Pragma("unroll") for (int k = 0; k < 2; ++k) \
        acc[ai][bj][m][n] = __builtin_amdgcn_mfma_f32_16x16x32_bf16(Bt_[n][k], At[m][k], acc[ai][bj][m][n], 0, 0, 0); __builtin_amdgcn_s_setprio(0); } while (0)
#define PG8_WAIT_V(n) asm volatile("s_waitcnt vmcnt(" #n ")" ::: "memory")
#define PG8_WAIT_L(n) asm volatile("s_waitcnt lgkmcnt(" #n ")" ::: "memory")
#define PG8_BAR __builtin_amdgcn_s_barrier()
#define PG8_SCHED __builtin_amdgcn_sched_barrier(0)
    Unit cur, nxt; int ui = 0;
    if (!S.next(0, cur)) return;
    f32x4 acc[2][2][4][2];
#pragma unroll
    for (int a = 0; a < 2; ++a)
#pragma unroll
        for (int b = 0; b < 2; ++b)
#pragma unroll
            for (int m = 0; m < 4; ++m)
#pragma unroll
                for (int n = 0; n < 2; ++n) acc[a][b][m][n] = (f32x4){0.f, 0.f, 0.f, 0.f};
    bf16x8 At[4][2], B0[2][2], B1[2][2];
    const char* cA = (const char*)A + (size_t)cur.pm * tstepA; const char* cB = (const char*)Bt + (size_t)cur.pn * tstepB;
    PG8_STAGE(PG8_SB(0, 0), cB, voffB); PG8_STAGE(PG8_SA(0, 0), cA, voffA); PG8_STAGE(PG8_SB(0, 1), cB + hstepB, voffB); PG8_STAGE(PG8_SA(0, 1), cA + hstepA, voffA);
    if (wr == 1) PG8_BAR;
    PG8_WAIT_V(4); PG8_BAR;
    PG8_STAGE(PG8_SB(1, 0), cB + kstep, voffB); PG8_STAGE(PG8_SA(1, 0), cA + kstep, voffA); PG8_STAGE(PG8_SB(1, 1), cB + hstepB + kstep, voffB);
    PG8_WAIT_V(6); PG8_BAR;
    for (;;) {
        const bool has_next = S.next(ui + 1, nxt);
        const char* nA = has_next ? (const char*)A + (size_t)nxt.pm * tstepA : cA; const char* nB = has_next ? (const char*)Bt + (size_t)nxt.pn * tstepB : cB;
        for (int t = 0; t < nt; t += 2) {
            const bool last = (t == nt - 2);
            const char* a1 = cA + (size_t)(t + 1) * kstep;
            const char* a2 = last ? nA : cA + (size_t)(t + 2) * kstep; const char* b2 = last ? nB : cB + (size_t)(t + 2) * kstep;
            const char* a3 = a2 + kstep; const char* b3 = b2 + kstep;
            PG8_LDB(B0, 0, 0); PG8_SCHED; PG8_LDA(At, 0, 0); PG8_STAGE(PG8_SA(1, 1), a1 + hstepA, voffA);
            PG8_WAIT_L(8); PG8_BAR; PG8_WAIT_L(0); PG8_MMA(0, 0, At, B0); PG8_BAR; PG8_SCHED;
            PG8_LDB(B1, 0, 1); PG8_STAGE(PG8_SB(0, 0), b2, voffB);
            PG8_BAR; PG8_WAIT_L(0); PG8_MMA(0, 1, At, B1); PG8_BAR;
            PG8_LDA(At, 0, 1); PG8_STAGE(PG8_SA(0, 0), a2, voffA);
            PG8_BAR; PG8_WAIT_L(0); PG8_MMA(1, 0, At, B0); PG8_BAR; PG8_SCHED;
            PG8_STAGE(PG8_SB(0, 1), b2 + hstepB, voffB);
            PG8_WAIT_V(6); PG8_BAR; PG8_MMA(1, 1, At, B1); PG8_BAR;
            PG8_LDB(B0, 1, 0); PG8_SCHED; PG8_LDA(At, 1, 0); PG8_STAGE(PG8_SA(0, 1), a2 + hstepA, voffA);
            PG8_WAIT_L(8); PG8_BAR; PG8_WAIT_L(0); PG8_MMA(0, 0, At, B0); PG8_BAR; PG8_SCHED;
            PG8_LDB(B1, 1, 1); PG8_STAGE(PG8_SB(1, 0), b3, voffB);
            PG8_BAR; PG8_WAIT_L(0); PG8_MMA(0, 1, At, B1); PG8_BAR;
            PG8_LDA(At, 1, 1); PG8_STAGE(PG8_SA(1, 0), a3, voffA);
            PG8_BAR; PG8_WAIT_L(0); PG8_MMA(1, 0, At, B0); PG8_BAR; PG8_SCHED;
            PG8_STAGE(PG8_SB(1, 1), b3 + hstepB, voffB);
            PG8_WAIT_V(6); PG8_BAR; PG8_MMA(1, 1, At, B1); PG8_BAR;
        }
        E(acc, cur, wr, wc, fr, fq);
        if (!has_next) break;
#pragma unroll
        for (int a = 0; a < 2; ++a)
#pragma unroll
            for (int b = 0; b < 2; ++b)
#pragma unroll
                for (int m = 0; m < 4; ++m)
#pragma unroll
                    for (int n = 0; n < 2; ++n) acc[a][b][m][n] = (f32x4){0.f, 0.f, 0.f, 0.f};
        cur = nxt; cA = nA; cB = nB; ++ui;
    }
    PG8_WAIT_V(0);
    if (wr == 0) PG8_BAR;
    PG8_BAR;
#undef PG8_SA
#undef PG8_SB
#undef PG8_STAGE
#undef PG8_LDA
#undef PG8_LDB
#undef PG8_MMA
#undef PG8_WAIT_V
#undef PG8_WAIT_L
#undef PG8_BAR
#undef PG8_SCHED
}
}
using pg8::Unit;

struct EpiInProj {
    bf16_t* proj; float* misc; const float* cosA; const float* sinA; const float* cosI; const float* sinI;
    __device__ __forceinline__ void operator()(const f32x4 (&acc)[2][2][4][2], const Unit& u, int wr, int wc, int fr, int fq) const {
        const int pn = u.pn, row0 = u.pm * 256 + wr * 64 + fr;
        const bool is_misc = (pn == 8), is_sig = (pn >= 29);
#pragma unroll
        for (int ai = 0; ai < 2; ++ai)
#pragma unroll
            for (int m = 0; m < 4; ++m) {
                const int r = row0 + ai * 128 + m * 16, pos = r & (SEQ - 1);
#pragma unroll
                for (int bj = 0; bj < 2; ++bj) {
                    int kind = 0;
                    if (pn <= 4) kind = (wc == 0) ? 1 : 0;
                    else if (pn == 6 || pn == 7) kind = (((wc & 1) == 0) && fq < 2) ? 2 : 0;
                    else if (pn == 8) kind = (bj == 0 && wc == 0 && fq < 2) ? 2 : 0;
                    f32x4 c4 = (f32x4){1.f, 1.f, 1.f, 1.f}, s4 = (f32x4){0.f, 0.f, 0.f, 0.f};
                    if (kind == 1) { c4 = *(const f32x4*)(cosA + pos * 16 + 4 * fq); s4 = *(const f32x4*)(sinA + pos * 16 + 4 * fq); }
                    else if (kind == 2) { c4 = *(const f32x4*)(cosI + pos * 8 + 4 * fq); s4 = *(const f32x4*)(sinI + pos * 8 + 4 * fq); }
                    const f32x4 v0 = acc[ai][bj][m][0], v1 = acc[ai][bj][m][1];
                    f32x4 o0 = v0 * c4 - v1 * s4, o1 = v1 * c4 + v0 * s4;
                    if (is_sig) {
#pragma unroll
                        for (int j = 0; j < 4; ++j) { o0[j] = sigmoid_f(o0[j]); o1[j] = sigmoid_f(o1[j]); }
                    }
                    const int cc = bj * 128 + wc * 32 + 4 * fq;
                    if (is_misc) {
                        float* mp = misc + (size_t)r * 256 + cc;
                        *(f32x4*)mp = o0; *(f32x4*)(mp + 16) = o1;
                    } else {
                        bf16_t* pp = proj + (size_t)r * NP + pn * 256 + cc;
                        u32x2 w0, w1; w0.x = pg8::cvt_pk_bf16(o0[0], o0[1]); w0.y = pg8::cvt_pk_bf16(o0[2], o0[3]); w1.x = pg8::cvt_pk_bf16(o1[0], o1[1]); w1.y = pg8::cvt_pk_bf16(o1[2], o1[3]);
                        *(u32x2*)pp = w0; *(u32x2*)(pp + 16) = w1;
                    }
                }
            }
    }
};
struct EpiGateA {
    bf16_t* proj;
    __device__ __forceinline__ void operator()(const f32x4 (&acc)[2][2][4][2], const Unit& u, int wr, int wc, int fr, int fq) const {
        const int row0 = u.pm * 256 + wr * 64 + fr, col0 = u.pn * 256 + wc * 32 + 4 * fq;
#pragma unroll
        for (int ai = 0; ai < 2; ++ai)
#pragma unroll
            for (int m = 0; m < 4; ++m)
#pragma unroll
                for (int bj = 0; bj < 2; ++bj)
#pragma unroll
                    for (int n = 0; n < 2; ++n) {
                        bf16_t* pp = proj + (size_t)(row0 + ai * 128 + m * 16) * NP + C_GA + col0 + bj * 128 + n * 16;
                        const u32x2 g = *(const u32x2*)pp; const f32x4 a = acc[ai][bj][m][n];
                        u32x2 w; w.x = pg8::cvt_pk_bf16(lo16(g.x) * a[0], hi16(g.x) * a[1]); w.y = pg8::cvt_pk_bf16(lo16(g.y) * a[2], hi16(g.y) * a[3]);
                        *(u32x2*)pp = w;
                    }
    }
};
struct EpiGateS {
    bf16_t* proj;
    __device__ __forceinline__ void operator()(const f32x4 (&acc)[2][2][4][2], const Unit& u, int wr, int wc, int fr, int fq) const {
        const int row0 = u.pm * 256 + wr * 64 + fr, col0 = u.pn * 256 + wc * 32 + 4 * fq;
#pragma unroll
        for (int ai = 0; ai < 2; ++ai)
#pragma unroll
            for (int m = 0; m < 4; ++m)
#pragma unroll
                for (int bj = 0; bj < 2; ++bj)
#pragma unroll
                    for (int n = 0; n < 2; ++n) {
                        bf16_t* pa = proj + (size_t)(row0 + ai * 128 + m * 16) * NP + C_GA + col0 + bj * 128 + n * 16;
                        bf16_t* ps = pa + (C_GS - C_GA);
                        const u32x2 m1 = *(const u32x2*)pa; const u32x2 g = *(const u32x2*)ps; const f32x4 a = acc[ai][bj][m][n];
                        u32x2 w; w.x = pg8::cvt_pk_bf16(lo16(m1.x) + lo16(g.x) * a[0], hi16(m1.x) + hi16(g.x) * a[1]);
                        w.y = pg8::cvt_pk_bf16(lo16(m1.y) + lo16(g.y) * a[2], hi16(m1.y) + hi16(g.y) * a[3]);
                        *(u32x2*)ps = w;
                    }
    }
};
struct EpiResid {
    const float* xin; float* xout;
    __device__ __forceinline__ void operator()(const f32x4 (&acc)[2][2][4][2], const Unit& u, int wr, int wc, int fr, int fq) const {
        const int row0 = u.pm * 256 + wr * 64 + fr, col0 = u.pn * 256 + wc * 32 + 4 * fq;
#pragma unroll
        for (int ai = 0; ai < 2; ++ai)
#pragma unroll
            for (int m = 0; m < 4; ++m)
#pragma unroll
                for (int bj = 0; bj < 2; ++bj)
#pragma unroll
                    for (int n = 0; n < 2; ++n) {
                        const size_t off = (size_t)(row0 + ai * 128 + m * 16) * 1024 + col0 + bj * 128 + n * 16;
                        *(f32x4*)(xout + off) = *(const f32x4*)(xin + off) + acc[ai][bj][m][n];
                    }
    }
};
struct EpiBf16 {
    bf16_t* O; int ldc;
    __device__ __forceinline__ void operator()(const f32x4 (&acc)[2][2][4][2], const Unit& u, int wr, int wc, int fr, int fq) const {
        const int row0 = u.pm * 256 + wr * 64 + fr, col0 = u.pn * 256 + wc * 32 + 4 * fq;
#pragma unroll
        for (int ai = 0; ai < 2; ++ai)
#pragma unroll
            for (int m = 0; m < 4; ++m)
#pragma unroll
                for (int bj = 0; bj < 2; ++bj)
#pragma unroll
                    for (int n = 0; n < 2; ++n) {
                        const f32x4 a = acc[ai][bj][m][n];
                        u32x2 w; w.x = pg8::cvt_pk_bf16(a[0], a[1]); w.y = pg8::cvt_pk_bf16(a[2], a[3]);
                        *(u32x2*)(O + (size_t)(row0 + ai * 128 + m * 16) * ldc + col0 + bj * 128 + n * 16) = w;
                    }
    }
};

template <int MODE>
__device__ void convT(const float* src, int K, int Nsrc, bf16_t* dst, int Ndst, const float* kscale, float* tile) {
    const int tid = opaque_tid(), kt = K / 64, ntiles = (Ndst / 64) * kt;
    for (int ti = blockIdx.x; ti < ntiles; ti += gridDim.x) {
        const int n0 = (ti / kt) * 64, k0 = (ti % kt) * 64;
        {
            const int nn = tid & 63; const int n = n0 + nn; const int ns = MODE ? inproj_map(n) : n;
#pragma unroll
            for (int i = 0; i < 8; ++i) {
                const int kk = (tid >> 6) + 8 * i;
                float v = (ns >= 0) ? src[(size_t)(k0 + kk) * Nsrc + ns] : 0.f;
                if (kscale) v *= kscale[k0 + kk];
                tile[nn * 65 + kk] = v;
            }
        }
        __syncthreads();
        {
            const int kk = tid & 63;
#pragma unroll
            for (int i = 0; i < 8; ++i) { const int nn = (tid >> 6) + 8 * i; dst[(size_t)(n0 + nn) * K + k0 + kk] = f2bf(tile[nn * 65 + kk]); }
        }
        __syncthreads();
    }
}

__device__ void phase_convert(const Params& p, float* tile) {
    for (int l = 0; l < DEPTH; ++l) {
        unsigned char* wl = p.ws + OFF_W + (size_t)l * SZ_WL;
        bf16_t* win = (bf16_t*)wl; bf16_t* wpa = (bf16_t*)(wl + SZ_WIN); bf16_t* wps = (bf16_t*)(wl + SZ_WIN + SZ_WPA);
        bf16_t* wo = (bf16_t*)(wl + SZ_WIN + SZ_WPA + SZ_WPS); bf16_t* wup = (bf16_t*)(wl + SZ_WIN + SZ_WPA + SZ_WPS + SZ_WO); bf16_t* wdn = (bf16_t*)(wl + SZ_WIN + SZ_WPA + SZ_WPS + SZ_WO + SZ_WUP);
        convT<1>(p.w_in + (size_t)l * 1024 * IN_COLS, 1024, IN_COLS, win, NP, nullptr, tile);
        convT<0>(p.w_proj_attn + (size_t)l * 1024 * 1024, 1024, 1024, wpa, 1024, nullptr, tile);
        convT<0>(p.w_proj_ssd + (size_t)l * 2048 * 1024, 2048, 1024, wps, 1024, p.ssd_norm_w + l * 2048, tile);
        convT<0>(p.w_out + (size_t)l * 1024 * 1024, 1024, 1024, wo, 1024, nullptr, tile);
        convT<0>(p.ffn_w_up + (size_t)l * 1024 * FFN2, 1024, FFN2, wup, FFN2, nullptr, tile);
        convT<0>(p.ffn_w_down + (size_t)l * FFN * 1024, FFN, 1024, wdn, 1024, nullptr, tile);
    }
    float* rope = (float*)(p.ws + OFF_ROPE);
    float* cosA = rope; float* sinA = rope + 4096 * 16; float* cosI = rope + 4096 * 32; float* sinI = rope + 4096 * 40;
    for (int i = blockIdx.x * 512 + opaque_tid(); i < 4096 * 24; i += gridDim.x * 512) {
        int pos, f; float inv;
        if (i < 4096 * 16) { pos = i >> 4; f = i & 15; inv = p.invA[f]; } else { const int j = i - 4096 * 16; pos = j >> 3; f = j & 7; inv = p.invI[f]; }
        const float ang = (float)pos * inv;
        double rev = (double)ang * 0.15915494309189535; rev -= rint(rev);
        const float c = __builtin_amdgcn_cosf((float)rev), s = __builtin_amdgcn_sinf((float)rev);
        if (i < 4096 * 16) { cosA[pos * 16 + f] = c; sinA[pos * 16 + f] = s; } else { cosI[pos * 8 + f] = c; sinI[pos * 8 + f] = s; }
    }
}

template <bool F32OUT>
__device__ void phase_norm(const float* xin, const float* w, bf16_t* hout, float* fout, int nrows) {
    const int tid = opaque_tid(); const int wave = tid >> 6, lane = tid & 63;
    for (int row = blockIdx.x * 8 + wave; row < nrows; row += gridDim.x * 8) {
        const f32x4* xr = (const f32x4*)(xin + (size_t)row * 1024);
        f32x4 v[4]; float ss = 0.f;
#pragma unroll
        for (int i = 0; i < 4; ++i) { v[i] = xr[lane + 64 * i]; ss += v[i][0] * v[i][0] + v[i][1] * v[i][1] + v[i][2] * v[i][2] + v[i][3] * v[i][3]; }
        ss = wave_sum(ss);
        const float rstd = rsqrtf(ss * (1.0f / 1024.0f) + EPS);
#pragma unroll
        for (int i = 0; i < 4; ++i) {
            const f32x4 w4 = ((const f32x4*)w)[lane + 64 * i];
            const f32x4 o = v[i] * rstd * w4;
            if (F32OUT) ((f32x4*)(fout + (size_t)row * 1024))[lane + 64 * i] = o;
            else { u32x2 pk; pk.x = pack2(o[0], o[1]); pk.y = pack2(o[2], o[3]); *(u32x2*)(hout + (size_t)row * 1024 + 4 * (lane + 64 * i)) = pk; }
        }
    }
}

__device__ __forceinline__ unsigned fkey(float s) { s += 0.0f; const unsigned u = __float_as_uint(s); return (u & 0x80000000u) ? ~u : (u | 0x80000000u); }

__device__ void phase_idx_simple(const bf16_t* proj, const float* misc, unsigned* mask, int* sel, unsigned char* shm) {
    const int tid = opaque_tid(); const int wave = tid >> 6, lane = tid & 63;
    float* qs = (float*)(shm + wave * 18432); unsigned* sk = (unsigned*)(shm + wave * 18432 + 2048);
    const unsigned long long lt_mask = (1ull << lane) - 1ull;
    for (int q = blockIdx.x * 8 + wave; q < SLAB; q += gridDim.x * 8) {
        const int bl = q >> 12, t = q & (SEQ - 1), n = t + 1;
        wave_lds_sync();
        {
            const u32x4 raw = *(const u32x4*)(proj + (size_t)q * NP + C_QI + lane * 8);
            f32x4 a, b; a[0] = lo16(raw.x); a[1] = hi16(raw.x); a[2] = lo16(raw.y); a[3] = hi16(raw.y); b[0] = lo16(raw.z); b[1] = hi16(raw.z); b[2] = lo16(raw.w); b[3] = hi16(raw.w);
            *(f32x4*)(qs + lane * 8) = a; *(f32x4*)(qs + lane * 8 + 4) = b;
        }
        float wv[8];
        { const f32x4 w0 = *(const f32x4*)(misc + (size_t)q * 256 + 64), w1 = *(const f32x4*)(misc + (size_t)q * 256 + 68);
#pragma unroll
          for (int j = 0; j < 4; ++j) { wv[j] = w0[j]; wv[4 + j] = w1[j]; } }
        wave_lds_sync();
        const int nr = (n + 63) & ~63;
        for (int s = lane; s < nr; s += 64) {
            if (s < n) {
                const f32x4* kp = (const f32x4*)(misc + (size_t)(bl * SEQ + s) * 256);
                f32x4 kv[16];
#pragma unroll
                for (int i = 0; i < 16; ++i) kv[i] = kp[i];
                float sc = 0.f;
#pragma unroll
                for (int h = 0; h < 8; ++h) {
                    float d = 0.f;
#pragma unroll
                    for (int i = 0; i < 16; ++i) { const f32x4 qv = *(const f32x4*)(qs + h * 64 + i * 4); d += kv[i][0] * qv[0] + kv[i][1] * qv[1] + kv[i][2] * qv[2] + kv[i][3] * qv[3]; }
                    sc += wv[h] * fmaxf(d, 0.f);
                }
                sk[s] = fkey(sc);
            }
        }
        wave_lds_sync();
        unsigned cur = 0u; int need = 1 << 30;
        if (n > 256) {
            for (int bit = 31; bit >= 0; --bit) {
                const unsigned cand = cur | (1u << bit); int cnt = 0;
                for (int s = lane; s < nr; s += 64) { const bool pr = (s < n) && (sk[s] >= cand); cnt += __popcll(__ballot(pr)); }
                if (cnt >= 256) cur = cand;
            }
            int cgt = 0;
            for (int s = lane; s < nr; s += 64) { const bool pr = (s < n) && (sk[s] > cur); cgt += __popcll(__ballot(pr)); }
            need = 256 - cgt;
        }
        int run_eq = 0, run_sel = 0; unsigned long long mybal = 0ull;
        for (int s = lane, c = 0; s < nr; s += 64, ++c) {
            const bool in = s < n; const unsigned k = in ? sk[s] : 0u;
            const bool gt = in && (k > cur), eq = in && (k == cur);
            const unsigned long long beq = __ballot(eq);
            const int rank = run_eq + __popcll(beq & lt_mask);
            const bool se = gt || (eq && rank < need);
            const unsigned long long bs = __ballot(se);
            const int pos = run_sel + __popcll(bs & lt_mask);
            if (se && pos < 256) sel[(size_t)q * 256 + pos] = s;
            run_eq += __popcll(beq); run_sel += __popcll(bs);
            if (lane == c) mybal = bs;
        }
        u32x2 mw; mw.x = (unsigned)mybal; mw.y = (unsigned)(mybal >> 32);
        *(u32x2*)(mask + (size_t)q * 128 + lane * 2) = mw;
        for (int j = run_sel + lane; j < 256; j += 64) sel[(size_t)q * 256 + j] = -1;
    }
}

__device__ void phase_att_simple(bf16_t* proj, const int* sel, unsigned char* shm) {
    const int tid = opaque_tid(); const int wave = tid >> 6, lane = tid & 63, h = wave, kvh = h >> 2;
    float* qf = (float*)(shm + wave * 2560); float* pj = qf + 128; int* kj = (int*)(pj + 256);
    const float scale = 0.08838834764831845f;
    for (int q = blockIdx.x; q < SLAB; q += gridDim.x) {
        const int bl = q >> 12;
        wave_lds_sync();
        { const unsigned raw = *(const unsigned*)(proj + (size_t)q * NP + C_Q + h * 128 + 2 * lane); qf[2 * lane] = lo16(raw); qf[2 * lane + 1] = hi16(raw); }
        int keys[4];
#pragma unroll
        for (int i = 0; i < 4; ++i) { keys[i] = sel[(size_t)q * 256 + lane + 64 * i]; kj[lane + 64 * i] = keys[i]; }
        wave_lds_sync();
        float lg[4]; float mx = -INFINITY;
#pragma unroll
        for (int i = 0; i < 4; ++i) {
            lg[i] = -INFINITY;
            if (keys[i] >= 0) {
                const u32x4* kp = (const u32x4*)(proj + (size_t)(bl * SEQ + keys[i]) * NP + C_K + kvh * 128);
                float d = 0.f;
#pragma unroll
                for (int c = 0; c < 16; ++c) {
                    const u32x4 raw = kp[c]; const f32x4 q0 = *(const f32x4*)(qf + c * 8), q1 = *(const f32x4*)(qf + c * 8 + 4);
                    d += lo16(raw.x) * q0[0] + hi16(raw.x) * q0[1] + lo16(raw.y) * q0[2] + hi16(raw.y) * q0[3] + lo16(raw.z) * q1[0] + hi16(raw.z) * q1[1] + lo16(raw.w) * q1[2] + hi16(raw.w) * q1[3];
                }
                lg[i] = d * scale;
            }
            mx = fmaxf(mx, lg[i]);
        }
        mx = wave_max(mx);
        float sm = 0.f; float pe[4];
#pragma unroll
        for (int i = 0; i < 4; ++i) { pe[i] = (keys[i] >= 0) ? __expf(lg[i] - mx) : 0.f; sm += pe[i]; }
        sm = wave_sum(sm);
        const float inv = 1.0f / sm;
#pragma unroll
        for (int i = 0; i < 4; ++i) pj[lane + 64 * i] = pe[i] * inv;
        wave_lds_sync();
        float a0 = 0.f, a1 = 0.f;
        const bf16_t* vb = proj + (size_t)(bl * SEQ) * NP + C_V + kvh * 128 + 2 * lane;
        for (int j = 0; j < 256; ++j) {
            const int key = kj[j]; if (key < 0) break;
            const float pv = pj[j];
            const unsigned raw = *(const unsigned*)(vb + (size_t)key * NP);
            a0 += pv * lo16(raw); a1 += pv * hi16(raw);
        }
        *(unsigned*)(proj + (size_t)q * NP + C_Q + h * 128 + 2 * lane) = pack2(a0, a1);
    }
}

__device__ void phase_ssd_simple(const Params& p, int l, bf16_t* proj, const float* misc, float* ssq, unsigned char* shm) {
    const int tid = opaque_tid(), lane = tid & 63;
    float* xs = (float*)shm; float* Bs = xs + 64 * 64; float* Cs = Bs + 64 * 128; float* dts = Cs + 64 * 128; float* decs = dts + 64; float* ybuf = decs + 64;
    const float* cw = p.ssd_conv_w + (size_t)l * 4 * 3072; const float* cb = p.ssd_conv_b + (size_t)l * 3072;
    for (int item = blockIdx.x; item < 128; item += gridDim.x) {
        const int bl = item >> 5, head = item & 31, g = head >> 3;
        const float Aneg = -__expf(p.ssd_a_log[l * 32 + head]), dtb = p.ssd_dt_bias[l * 32 + head], Dsk = p.ssd_d[l * 32 + head];
        const int pp = tid >> 3, ng = tid & 7;
        float hs[16];
#pragma unroll
        for (int k = 0; k < 16; ++k) hs[k] = 0.f;
        for (int c = 0; c < 64; ++c) {
            const int t0 = c * 64;
            __syncthreads();
            for (int i = 0; i < 40; ++i) {
                const int idx = tid + 512 * i, tok = idx / 320, cc = idx - tok * 320;
                int ch; float* dstp;
                if (cc < 64) { ch = head * 64 + cc; dstp = xs + tok * 64 + cc; }
                else if (cc < 192) { ch = 2048 + g * 128 + (cc - 64); dstp = Bs + tok * 128 + (cc - 64); }
                else { ch = 2560 + g * 128 + (cc - 192); dstp = Cs + tok * 128 + (cc - 192); }
                float a = cb[ch];
#pragma unroll
                for (int j = 0; j < 4; ++j) { const int tt = t0 + tok - 3 + j; if (tt >= 0) a += cw[j * 3072 + ch] * bf2f(proj[(size_t)(bl * SEQ + tt) * NP + C_XBC + ch]); }
                *dstp = silu_f(a);
            }
            if (tid < 64) {
                const float v = misc[(size_t)(bl * SEQ + t0 + tid) * 256 + 72 + head] + dtb;
                const float dt = (v > 20.f) ? v : log1pf(__expf(v));
                dts[tid] = dt; decs[tid] = __expf(dt * Aneg);
            }
            __syncthreads();
            for (int tok = 0; tok < 64; ++tok) {
                const float xv = xs[tok * 64 + pp], dt = dts[tok], dec = decs[tok], xdt = xv * dt;
                float y = 0.f;
#pragma unroll
                for (int k4 = 0; k4 < 4; ++k4) {
                    const f32x4 b4 = *(const f32x4*)(Bs + tok * 128 + ng * 16 + k4 * 4), c4 = *(const f32x4*)(Cs + tok * 128 + ng * 16 + k4 * 4);
#pragma unroll
                    for (int j = 0; j < 4; ++j) { float& hh = hs[k4 * 4 + j]; hh = hh * dec + xdt * b4[j]; y += c4[j] * hh; }
                }
                y += __shfl_xor(y, 1); y += __shfl_xor(y, 2); y += __shfl_xor(y, 4);
                if (ng == 0) ybuf[tok * 65 + pp] = y + Dsk * xv;
            }
            __syncthreads();
#pragma unroll
            for (int i = 0; i < 8; ++i) {
                const int idx = tid + 512 * i, tok = idx >> 6, p2 = idx & 63;
                bf16_t* zp = proj + (size_t)(bl * SEQ + t0 + tok) * NP + C_Z + head * 64 + p2;
                const float yg = ybuf[tok * 65 + p2] * silu_f(bf2f(*zp));
                *zp = f2bf(yg);
                const float s2 = wave_sum(yg * yg);
                if (lane == 0) ssq[(size_t)(bl * SEQ + t0 + tok) * 32 + head] = s2;
            }
        }
    }
}

__device__ void phase_gnorm(bf16_t* proj, const float* ssq) {
    for (int idx = blockIdx.x * 512 + opaque_tid(); idx < SLAB * 256; idx += gridDim.x * 512) {
        const int t = idx >> 8, c8 = idx & 255, g = c8 >> 6;
        const f32x4 s0 = *(const f32x4*)(ssq + (size_t)t * 32 + g * 8), s1 = *(const f32x4*)(ssq + (size_t)t * 32 + g * 8 + 4);
        const float tot = s0[0] + s0[1] + s0[2] + s0[3] + s1[0] + s1[1] + s1[2] + s1[3];
        const float rstd = rsqrtf(tot * (1.0f / 512.0f) + EPS);
        u32x4* pp = (u32x4*)(proj + (size_t)t * NP + C_Z + c8 * 8);
        u32x4 v = *pp;
        v.x = pack2(lo16(v.x) * rstd, hi16(v.x) * rstd); v.y = pack2(lo16(v.y) * rstd, hi16(v.y) * rstd);
        v.z = pack2(lo16(v.z) * rstd, hi16(v.z) * rstd); v.w = pack2(lo16(v.w) * rstd, hi16(v.w) * rstd);
        *pp = v;
    }
}

__device__ void phase_convglu(const bf16_t* U, bf16_t* GL, const float* cw, const float* cb) {
    for (int idx = blockIdx.x * 512 + opaque_tid(); idx < SLAB * 352; idx += gridDim.x * 512) {
        const int t = idx / 352, f = (idx - t * 352) * 8, pos = t & (SEQ - 1);
        float ga[8], va[8];
#pragma unroll
        for (int e = 0; e < 8; ++e) { ga[e] = cb[f + e]; va[e] = cb[FFN + f + e]; }
#pragma unroll
        for (int j = 0; j < 3; ++j) {
            if (pos - 2 + j >= 0) {
                const bf16_t* up = U + (size_t)(t - 2 + j) * FFN2 + f;
                const u32x4 g4 = *(const u32x4*)up, v4 = *(const u32x4*)(up + FFN);
                const float* wg = cw + j * FFN2 + f; const float* wv = wg + FFN;
                const unsigned gw[4] = {g4.x, g4.y, g4.z, g4.w}, vw[4] = {v4.x, v4.y, v4.z, v4.w};
#pragma unroll
                for (int e = 0; e < 4; ++e) {
                    ga[2 * e] += wg[2 * e] * lo16(gw[e]); ga[2 * e + 1] += wg[2 * e + 1] * hi16(gw[e]);
                    va[2 * e] += wv[2 * e] * lo16(vw[e]); va[2 * e + 1] += wv[2 * e + 1] * hi16(vw[e]);
                }
            }
        }
        u32x4 o;
        o.x = pack2(silu_f(ga[0]) * va[0], silu_f(ga[1]) * va[1]); o.y = pack2(silu_f(ga[2]) * va[2], silu_f(ga[3]) * va[3]);
        o.z = pack2(silu_f(ga[4]) * va[4], silu_f(ga[5]) * va[5]); o.w = pack2(silu_f(ga[6]) * va[6], silu_f(ga[7]) * va[7]);
        *(u32x4*)(GL + (size_t)t * FFN + f) = o;
    }
}

__global__ void __launch_bounds__(512, 2) mega(Params p) {
    extern __shared__ __attribute__((aligned(16))) unsigned char shm[];
    cg::grid_group grid = cg::this_grid();
    LAS unsigned char* lds = (LAS unsigned char*)shm;
    unsigned char* ws = p.ws;
    bf16_t* H = (bf16_t*)(ws + OFF_H); bf16_t* PROJ = (bf16_t*)(ws + OFF_PROJ); float* MISC = (float*)(ws + OFF_MISC);
    unsigned* MASK = (unsigned*)(ws + OFF_MASK); int* SEL = (int*)(ws + OFF_SEL); float* SSQ = (float*)(ws + OFF_SSQ);
    bf16_t* U = PROJ; bf16_t* GL = (bf16_t*)(ws + OFF_GL);
    const float* rope = (const float*)(ws + OFF_ROPE);

    phase_convert(p, (float*)shm);
    grid.sync();
    for (int l = 0; l < DEPTH; ++l) {
        const unsigned char* wl = ws + OFF_W + (size_t)l * SZ_WL;
        const bf16_t* win = (const bf16_t*)wl; const bf16_t* wpa = (const bf16_t*)(wl + SZ_WIN); const bf16_t* wps = (const bf16_t*)(wl + SZ_WIN + SZ_WPA);
        const bf16_t* wo = (const bf16_t*)(wl + SZ_WIN + SZ_WPA + SZ_WPS); const bf16_t* wup = (const bf16_t*)(wl + SZ_WIN + SZ_WPA + SZ_WPS + SZ_WO);
        const bf16_t* wdn = (const bf16_t*)(wl + SZ_WIN + SZ_WPA + SZ_WPS + SZ_WO + SZ_WUP);
        const float* xin = (l == 0) ? p.x : p.out;
        for (int half = 0; half < NSLAB; ++half) {
            const size_t r0 = (size_t)half * SLAB;
            phase_norm<false>(xin + r0 * 1024, p.norm_mix_w + l * 1024, H, nullptr, SLAB);
            grid.sync();
            { EpiInProj E{PROJ, MISC, rope, rope + 4096 * 16, rope + 4096 * 32, rope + 4096 * 40};
              pg8::gemm_phase(lds, H, 1024, win, SLAB, NP, 1024, E); }
            grid.sync();
            phase_idx_simple(PROJ, MISC, MASK, SEL, shm);
            grid.sync();
            phase_att_simple(PROJ, SEL, shm);
            __syncthreads();
            phase_ssd_simple(p, l, PROJ, MISC, SSQ, shm);
            grid.sync();
            phase_gnorm(PROJ, SSQ);
            grid.sync();
            { EpiGateA E{PROJ}; pg8::gemm_phase(lds, PROJ + C_Q, NP, wpa, SLAB, 1024, 1024, E); }
            { EpiGateS E{PROJ}; pg8::gemm_phase(lds, PROJ + C_Z, NP, wps, SLAB, 1024, 2048, E); }
            grid.sync();
            { EpiResid E{xin + r0 * 1024, p.out + r0 * 1024}; pg8::gemm_phase(lds, PROJ + C_GS, NP, wo, SLAB, 1024, 1024, E); }
            grid.sync();
        }
        for (int half = 0; half < NSLAB; ++half) {
            const size_t r0 = (size_t)half * SLAB;
            phase_norm<false>(p.out + r0 * 1024, p.norm_ffn_w + l * 1024, H, nullptr, SLAB);
            grid.sync();
            { EpiBf16 E{U, FFN2}; pg8::gemm_phase(lds, H, 1024, wup, SLAB, FFN2, 1024, E); }
            grid.sync();
            phase_convglu(U, GL, p.ffn_conv_w + (size_t)l * 3 * FFN2, p.ffn_conv_b + (size_t)l * FFN2);
            grid.sync();
            { EpiResid E{p.out + r0 * 1024, p.out + r0 * 1024}; pg8::gemm_phase(lds, GL, FFN, wdn, SLAB, 1024, FFN, E); }
            grid.sync();
        }
    }
    phase_norm<true>(p.out, p.norm_final_w, nullptr, p.out, NTOK);
}

extern "C" void kernel_launch(void* const* d_in, const int* in_sizes, int n_in, void* d_out, int out_size, void* d_ws, size_t ws_size, hipStream_t stream) {
    static int grid_blocks = 0;
    if (!grid_blocks) {
        int dev = 0, cus = 0, per_cu = 0;
        hipGetDevice(&dev);
        hipDeviceGetAttribute(&cus, hipDeviceAttributeMultiprocessorCount, dev);
        hipFuncSetAttribute((const void*)mega, hipFuncAttributeMaxDynamicSharedMemorySize, LDS_BYTES);
        hipOccupancyMaxActiveBlocksPerMultiprocessor(&per_cu, mega, 512, LDS_BYTES);
        if (per_cu < 1) per_cu = 1;
        grid_blocks = cus * 1;
    }
    if (ws_size < OFF_END) { fprintf(stderr, "workspace too small: %zu < %zu\n", ws_size, (size_t)OFF_END); return; }
    Params p{};
    p.x = (const float*)d_in[0]; p.norm_mix_w = (const float*)d_in[1]; p.w_in = (const float*)d_in[2]; p.ssd_conv_w = (const float*)d_in[3]; p.ssd_conv_b = (const float*)d_in[4];
    p.ssd_dt_bias = (const float*)d_in[5]; p.ssd_a_log = (const float*)d_in[6]; p.ssd_d = (const float*)d_in[7]; p.ssd_norm_w = (const float*)d_in[8];
    p.w_proj_attn = (const float*)d_in[9]; p.w_proj_ssd = (const float*)d_in[10]; p.w_out = (const float*)d_in[11]; p.norm_ffn_w = (const float*)d_in[12];
    p.ffn_w_up = (const float*)d_in[13]; p.ffn_conv_w = (const float*)d_in[14]; p.ffn_conv_b = (const float*)d_in[15]; p.ffn_w_down = (const float*)d_in[16]; p.norm_final_w = (const float*)d_in[17];
    p.out = (float*)d_out; p.ws = (unsigned char*)d_ws;
    for (int i = 0; i < 16; ++i) p.invA[i] = powf(500000.0f, -(float)(2 * i) / 32.0f);
    for (int i = 0; i < 8; ++i) p.invI[i] = powf(500000.0f, -(float)(2 * i) / 16.0f);
    void* args[] = {&p};
    hipError_t e = hipLaunchCooperativeKernel((const void*)mega, dim3(grid_blocks), dim3(512), args, LDS_BYTES, stream);
    if (e != hipSuccess) fprintf(stderr, "cooperative launch failed: %s (grid %d)\n", hipGetErrorString(e), grid_blocks);
}
```

```cpp
#include <hip/hip_runtime.h>
#include <hip/hip_cooperative_groups.h>
#include <cstdio>
#include <cmath>
namespace cg = cooperative_groups;

#define LAS __attribute__((address_space(3)))
typedef unsigned short bf16_t;
typedef short bf16x8 __attribute__((ext_vector_type(8)));
typedef float f32x4 __attribute__((ext_vector_type(4)));
typedef unsigned u32x2 __attribute__((ext_vector_type(2)));
typedef unsigned u32x4 __attribute__((ext_vector_type(4)));

constexpr int D_MODEL = 1024, SEQ = 4096, NTOK = 32768, SLAB = 16384, NSLAB = 2, DEPTH = 2;
constexpr int IN_COLS = 9320, NP = 9472;
constexpr int C_Q = 0, C_K = 1024, C_V = 1280, C_QI = 1536, C_MISC = 2048, C_Z = 2304, C_XBC = 4352, C_GA = 7424, C_GS = 8448;
constexpr int FFN = 2816, FFN2 = 5632;
constexpr float EPS = 1e-6f;

constexpr size_t SZ_WIN = (size_t)NP * 1024 * 2, SZ_WPA = (size_t)1024 * 1024 * 2, SZ_WPS = (size_t)1024 * 2048 * 2, SZ_WO = SZ_WPA,
                 SZ_WUP = (size_t)FFN2 * 1024 * 2, SZ_WDN = (size_t)1024 * FFN * 2;
constexpr size_t SZ_WL = SZ_WIN + SZ_WPA + SZ_WPS + SZ_WO + SZ_WUP + SZ_WDN;
constexpr size_t OFF_W = 0;
constexpr size_t OFF_ROPE = OFF_W + 2 * SZ_WL;
constexpr size_t OFF_H = OFF_ROPE + (size_t)4096 * 48 * 4;
constexpr size_t OFF_PROJ = OFF_H + (size_t)SLAB * 1024 * 2;
constexpr size_t OFF_MISC = OFF_PROJ + (size_t)SLAB * NP * 2;
constexpr size_t OFF_MASK = OFF_MISC + (size_t)SLAB * 256 * 4;
constexpr size_t OFF_SEL = OFF_MASK + (size_t)SLAB * 128 * 4;
constexpr size_t OFF_SSQ = OFF_SEL + (size_t)SLAB * 256 * 4;
constexpr size_t OFF_VT = OFF_SSQ + (size_t)SLAB * 32 * 4;
constexpr size_t OFF_END = OFF_VT + (size_t)4 * 2 * 128 * 4096 * 2;
constexpr size_t OFF_GL = OFF_PROJ + (size_t)SLAB * FFN2 * 2;

constexpr int LDS_BYTES = 150528;

struct Params {
    const float* x; const float* norm_mix_w; const float* w_in; const float* ssd_conv_w; const float* ssd_conv_b;
    const float* ssd_dt_bias; const float* ssd_a_log; const float* ssd_d; const float* ssd_norm_w;
    const float* w_proj_attn; const float* w_proj_ssd; const float* w_out; const float* norm_ffn_w;
    const float* ffn_w_up; const float* ffn_conv_w; const float* ffn_conv_b; const float* ffn_w_down; const float* norm_final_w;
    float* out; unsigned char* ws;
    float invA[16]; float invI[8];
};

__device__ __forceinline__ int opaque_tid() { int t = threadIdx.x; asm volatile("" : "+v"(t)); return t; }
__device__ __forceinline__ float bf2f(bf16_t b) { return __uint_as_float(((unsigned)b) << 16); }
__device__ __forceinline__ bf16_t f2bf(float f) { unsigned u = __float_as_uint(f); u += 0x7FFFu + ((u >> 16) & 1u); return (bf16_t)(u >> 16); }
__device__ __forceinline__ unsigned pack2(float lo, float hi) { return (unsigned)f2bf(lo) | ((unsigned)f2bf(hi) << 16); }
__device__ __forceinline__ float lo16(unsigned w) { return __uint_as_float(w << 16); }
__device__ __forceinline__ float hi16(unsigned w) { return __uint_as_float(w & 0xffff0000u); }
__device__ __forceinline__ float silu_f(float v) { return v / (1.0f + __expf(-v)); }
__device__ __forceinline__ float sigmoid_f(float v) { return 1.0f / (1.0f + __expf(-v)); }
__device__ __forceinline__ void wave_lds_sync() { __builtin_amdgcn_fence(__ATOMIC_SEQ_CST, "wavefront"); __builtin_amdgcn_wave_barrier(); }
__device__ __forceinline__ float wave_sum(float v) {
#pragma unroll
    for (int o = 32; o >= 1; o >>= 1) v += __shfl_xor(v, o);
    return v;
}
__device__ __forceinline__ float wave_max(float v) {
#pragma unroll
    for (int o = 32; o >= 1; o >>= 1) v = fmaxf(v, __shfl_xor(v, o));
    return v;
}
__device__ __forceinline__ int permI(int p) { return p < 8 ? p : (p < 16 ? p + 8 : (p < 24 ? p - 8 : p)); }
__device__ __forceinline__ int inproj_map(int n) {
    if (n < C_QI) return n;
    if (n < C_MISC) { const int r = n - C_QI; return C_QI + (r & ~63) + permI(r & 63); }
    if (n < C_Z) { const int c = n - C_MISC; if (c < 64) return 2048 + permI(c); if (c < 72) return 2112 + (c - 64); if (c < 104) return 7240 + (c - 72); return -1; }
    if (n < C_XBC) return 2120 + (n - C_Z);
    if (n < C_GA) return 4168 + (n - C_XBC);
    if (n < C_GS) return 7272 + (n - C_GA);
    return 8296 + (n - C_GS);
}

namespace pg8 {
constexpr int BM = 256, BK = 64, HALF = 128, HTB = HALF * BK * 2, NXCD = 8, WGM = 8;
__device__ __forceinline__ int lds_byte(int r, int c) { const int st = (r >> 4) * 2 + (c >> 5), rr = r & 15, cc = c & 31, ob = rr * 64 + cc * 2; return st * 1024 + (ob ^ (((ob >> 9) & 1) << 5)); }
__device__ __forceinline__ void stage_rc(int b, int& R, int& C) { const int st = b / 1024, sb = b % 1024, swz = sb ^ (((sb >> 9) & 1) << 5); R = (st >> 1) * 16 + swz / 64; C = (st & 1) * 32 + (swz % 64) / 2; }
struct Unit { int pm, pn; };
struct StaticOrder {
    int nM, nN, nwg, G, c;
    __device__ void init(int M, int N, int G_, int c_) { nM = M / BM; nN = N / BM; nwg = nM * nN; G = G_; c = c_; }
    __device__ bool next(int i, Unit& u) const {
        const long L = (long)i * G + c; if (L >= nwg) return false;
        int wgid = (int)L; { const int q = nwg / NXCD, r = nwg % NXCD, xcd = wgid % NXCD, off = wgid / NXCD; wgid = (xcd < r ? xcd * (q + 1) : r * (q + 1) + (xcd - r) * q) + off; }
        const int nig = WGM * nN, gid = wgid / nig, fm = gid * WGM, gsz = (nM - fm) < WGM ? (nM - fm) : WGM;
        u.pm = fm + ((wgid % nig) % gsz); u.pn = (wgid % nig) / gsz; return true;
    }
};
__device__ __forceinline__ unsigned cvt_pk_bf16(float lo, float hi) { unsigned r; asm volatile("v_cvt_pk_bf16_f32 %0, %1, %2" : "=v"(r) : "v"(lo), "v"(hi)); return r; }

template <class Epi>
__device__ __forceinline__ void gemm_phase(LAS unsigned char* lds, const bf16_t* A, int lda, const bf16_t* Bt, int M, int N, int K, const Epi& E) {
    const int tid = opaque_tid(), wid = __builtin_amdgcn_readfirstlane(tid >> 6), lane = tid & 63, wr = wid >> 2, wc = wid & 3, fr = lane & 15, fq = lane >> 4;
    const int nt = K / BK;
    StaticOrder S; S.init(M, N, (int)gridDim.x, (int)blockIdx.x);
    unsigned voffA[2], voffB[2];
#pragma unroll
    for (int i = 0; i < 2; ++i) { int R, C; stage_rc(tid * 16 + i * 8192, R, C); voffA[i] = (unsigned)(R * lda + C) * 2u; voffB[i] = (unsigned)(R * K + C) * 2u; }
    const size_t kstep = (size_t)(BK * 2);
    const size_t hstepA = (size_t)HALF * lda * 2, hstepB = (size_t)HALF * K * 2;
    const size_t tstepA = 2 * hstepA, tstepB = 2 * hstepB;
    const unsigned ldsw = (unsigned)wid * 1024u;
    const int aoff = lds_byte(wr * 64 + fr, fq * 8), boff = lds_byte(wc * 32 + fr, fq * 8);
#define PG8_SA(b, h) (((b) * 2 + (h)) * HTB)
#define PG8_SB(b, h) ((4 + (b) * 2 + (h)) * HTB)
#define PG8_STAGE(bufoff, gbase, voff) do { _Pragma("unroll") for (int _i = 0; _i < 2; ++_i) \
        __builtin_amdgcn_global_load_lds((const unsigned*)((const char*)(gbase) + (voff)[_i]), (LAS unsigned*)(lds + (bufoff) + ldsw + _i * 8192), 16, 0, 0); } while (0)
#define PG8_LDA(dst, b, h) do { _Pragma("unroll") for (int m = 0; m < 4; ++m) _Pragma("unroll") for (int k = 0; k < 2; ++k) dst[m][k] = *(const LAS bf16x8*)(lds + PG8_SA(b, h) + aoff + m * 2048 + k * 1024); } while (0)
#define PG8_LDB(dst, b, h) do { _Pragma("unroll") for (int n = 0; n < 2; ++n) _Pragma("unroll") for (int k = 0; k < 2; ++k) dst[n][k] = *(const LAS bf16x8*)(lds + PG8_SB(b, h) + boff + n * 2048 + k * 1024); } while (0)
#define PG8_MMA(ai, bj, At, Bt_) do { __builtin_amdgcn_s_setprio(1); _Pragma("unroll") for (int m = 0; m < 4; ++m) _Pragma("unroll") for (int n = 0; n < 2; ++n) _Pragma("unroll") for (int k = 0; k < 2; ++k) \
        acc[ai][bj][m][n] = __builtin_amdgcn_mfma_f32_16x16x32_bf16(Bt_[n][k], At[m][k], acc[ai][bj][m][n], 0, 0, 0); __builtin_amdgcn_s_setprio(0); } while (0)
#define PG8_WAIT_V(n) asm volatile("s_waitcnt vmcnt(" #n ")" ::: "memory")
#define PG8_WAIT_L(n) asm volatile("s_waitcnt lgkmcnt(" #n ")" ::: "memory")
#define PG8_BAR __builtin_amdgcn_s_barrier()
#define PG8_SCHED __builtin_amdgcn_sched_barrier(0)
    Unit cur, nxt; int ui = 0;
    if (!S.next(0, cur)) return;
    f32x4 acc[2][2][4][2];
#pragma unroll
    for (int a = 0; a < 2; ++a)
#pragma unroll
        for (int b = 0; b < 2; ++b)
#pragma unroll
            for (int m = 0; m < 4; ++m)
#pragma unroll
                for (int n = 0; n < 2; ++n) acc[a][b][m][n] = (f32x4){0.f, 0.f, 0.f, 0.f};
    bf16x8 At[4][2], B0[2][2], B1[2][2];
    const char* cA = (const char*)A + (size_t)cur.pm * tstepA; const char* cB = (const char*)Bt + (size_t)cur.pn * tstepB;
    PG8_STAGE(PG8_SB(0, 0), cB, voffB); PG8_STAGE(PG8_SA(0, 0), cA, voffA); PG8_STAGE(PG8_SB(0, 1), cB + hstepB, voffB); PG8_STAGE(PG8_SA(0, 1), cA + hstepA, voffA);
    if (wr == 1) PG8_BAR;
    PG8_WAIT_V(4); PG8_BAR;
    PG8_STAGE(PG8_SB(1, 0), cB + kstep, voffB); PG8_STAGE(PG8_SA(1, 0), cA + kstep, voffA); PG8_STAGE(PG8_SB(1, 1), cB + hstepB + kstep, voffB);
    PG8_WAIT_V(6); PG8_BAR;
    for (;;) {
        const bool has_next = S.next(ui + 1, nxt);
        const char* nA = has_next ? (const char*)A + (size_t)nxt.pm * tstepA : cA; const char* nB = has_next ? (const char*)Bt + (size_t)nxt.pn * tstepB : cB;
        for (int t = 0; t < nt; t += 2) {
            const bool last = (t == nt - 2);
            const char* a1 = cA + (size_t)(t + 1) * kstep;
            const char* a2 = last ? nA : cA + (size_t)(t + 2) * kstep; const char* b2 = last ? nB : cB + (size_t)(t + 2) * kstep;
            const char* a3 = a2 + kstep; const char* b3 = b2 + kstep;
            PG8_LDB(B0, 0, 0); PG8_SCHED; PG8_LDA(At, 0, 0); PG8_STAGE(PG8_SA(1, 1), a1 + hstepA, voffA);
            PG8_WAIT_L(8); PG8_BAR; PG8_WAIT_L(0); PG8_MMA(0, 0, At, B0); PG8_BAR; PG8_SCHED;
            PG8_LDB(B1, 0, 1); PG8_STAGE(PG8_SB(0, 0), b2, voffB);
            PG8_BAR; PG8_WAIT_L(0); PG8_MMA(0, 1, At, B1); PG8_BAR;
            PG8_LDA(At, 0, 1); PG8_STAGE(PG8_SA(0, 0), a2, voffA);
            PG8_BAR; PG8_WAIT_L(0); PG8_MMA(1, 0, At, B0); PG8_BAR; PG8_SCHED;
            PG8_STAGE(PG8_SB(0, 1), b2 + hstepB, voffB);
            PG8_WAIT_V(6); PG8_BAR; PG8_MMA(1, 1, At, B1); PG8_BAR;
            PG8_LDB(B0, 1, 0); PG8_SCHED; PG8_LDA(At, 1, 0); PG8_STAGE(PG8_SA(0, 1), a2 + hstepA, voffA);
            PG8_WAIT_L(8); PG8_BAR; PG8_WAIT_L(0); PG8_MMA(0, 0, At, B0); PG8_BAR; PG8_SCHED;
            PG8_LDB(B1, 1, 1); PG8_STAGE(PG8_SB(1, 0), b3, voffB);
            PG8_BAR; PG8_WAIT_L(0); PG8_MMA(0, 1, At, B1); PG8_BAR;
            PG8_LDA(At, 1, 1); PG8_STAGE(PG8_SA(1, 0), a3, voffA);
            PG8_BAR; PG8_WAIT_L(0); PG8_MMA(1, 0, At, B0); PG8_BAR; PG8_SCHED;
            PG8_STAGE(PG8_SB(1, 1), b3 + hstepB, voffB);
            PG8_WAIT_V(6); PG8_BAR; PG8_MMA(1, 1, At, B1); PG8_BAR;
        }
        E(acc, cur, wr, wc, fr, fq);
        if (!has_next) break;
#pragma unroll
        for (int a = 0; a < 2; ++a)
#pragma unroll
            for (int b = 0; b < 2; ++b)
#pragma unroll
                for (int m = 0; m < 4; ++m)
#pragma unroll
                    for (int n = 0; n < 2; ++n) acc[a][b][m][n] = (f32x4){0.f, 0.f, 0.f, 0.f};
        cur = nxt; cA = nA; cB = nB; ++ui;
    }
    PG8_WAIT_V(0);
    if (wr == 0) PG8_BAR;
    PG8_BAR;
#undef PG8_SA
#undef PG8_SB
#undef PG8_STAGE
#undef PG8_LDA
#undef PG8_LDB
#undef PG8_MMA
#undef PG8_WAIT_V
#undef PG8_WAIT_L
#undef PG8_BAR
#undef PG8_SCHED
}
}
using pg8::Unit;

struct EpiInProj {
    bf16_t* proj; float* misc; const float* cosA; const float* sinA; const float* cosI; const float* sinI; bf16_t* vt;
    __device__ __forceinline__ void operator()(const f32x4 (&acc)[2][2][4][2], const Unit& u, int wr, int wc, int fr, int fq) const {
        const int pn = u.pn, row0 = u.pm * 256 + wr * 64 + fr;
        const bool is_misc = (pn == 8), is_sig = (pn >= 29);
#pragma unroll
        for (int ai = 0; ai < 2; ++ai)
#pragma unroll
            for (int m = 0; m < 4; ++m) {
                const int r = row0 + ai * 128 + m * 16, pos = r & (SEQ - 1);
#pragma unroll
                for (int bj = 0; bj < 2; ++bj) {
                    int kind = 0;
                    if (pn <= 4) kind = (wc == 0) ? 1 : 0;
                    else if (pn == 6 || pn == 7) kind = (((wc & 1) == 0) && fq < 2) ? 2 : 0;
                    else if (pn == 8) kind = (bj == 0 && wc == 0 && fq < 2) ? 2 : 0;
                    f32x4 c4 = (f32x4){1.f, 1.f, 1.f, 1.f}, s4 = (f32x4){0.f, 0.f, 0.f, 0.f};
                    if (kind == 1) { c4 = *(const f32x4*)(cosA + pos * 16 + 4 * fq); s4 = *(const f32x4*)(sinA + pos * 16 + 4 * fq); }
                    else if (kind == 2) { c4 = *(const f32x4*)(cosI + pos * 8 + 4 * fq); s4 = *(const f32x4*)(sinI + pos * 8 + 4 * fq); }
                    const f32x4 v0 = acc[ai][bj][m][0], v1 = acc[ai][bj][m][1];
                    f32x4 o0 = v0 * c4 - v1 * s4, o1 = v1 * c4 + v0 * s4;
                    if (is_sig) {
#pragma unroll
                        for (int j = 0; j < 4; ++j) { o0[j] = sigmoid_f(o0[j]); o1[j] = sigmoid_f(o1[j]); }
                    }
                    const int cc = bj * 128 + wc * 32 + 4 * fq;
                    if (is_misc) {
                        float* mp = misc + (size_t)r * 256 + cc;
                        *(f32x4*)mp = o0; *(f32x4*)(mp + 16) = o1;
                        if (bj == 0 && wc < 2) {
                            bf16_t* pp = proj + (size_t)r * NP + C_MISC + cc;
                            u32x2 w0, w1; w0.x = pg8::cvt_pk_bf16(o0[0], o0[1]); w0.y = pg8::cvt_pk_bf16(o0[2], o0[3]); w1.x = pg8::cvt_pk_bf16(o1[0], o1[1]); w1.y = pg8::cvt_pk_bf16(o1[2], o1[3]);
                            *(u32x2*)pp = w0; *(u32x2*)(pp + 16) = w1;
                        }
                    } else {
                        if (pn == 5) {
                            bf16_t* vp = vt + ((size_t)((r >> 12) * 2 + bj) * 128 + wc * 32 + 4 * fq) * SEQ + pos;
#pragma unroll
                            for (int j = 0; j < 4; ++j) { vp[(size_t)j * SEQ] = f2bf(o0[j]); vp[(size_t)(16 + j) * SEQ] = f2bf(o1[j]); }
                        }
                        bf16_t* pp = proj + (size_t)r * NP + pn * 256 + cc;
                        u32x2 w0, w1; w0.x = pg8::cvt_pk_bf16(o0[0], o0[1]); w0.y = pg8::cvt_pk_bf16(o0[2], o0[3]); w1.x = pg8::cvt_pk_bf16(o1[0], o1[1]); w1.y = pg8::cvt_pk_bf16(o1[2], o1[3]);
                        *(u32x2*)pp = w0; *(u32x2*)(pp + 16) = w1;
                    }
                }
            }
    }
};
struct EpiGateA {
    bf16_t* proj;
    __device__ __forceinline__ void operator()(const f32x4 (&acc)[2][2][4][2], const Unit& u, int wr, int wc, int fr, int fq) const {
        const int row0 = u.pm * 256 + wr * 64 + fr, col0 = u.pn * 256 + wc * 32 + 4 * fq;
#pragma unroll
        for (int ai = 0; ai < 2; ++ai)
#pragma unroll
            for (int m = 0; m < 4; ++m)
#pragma unroll
                for (int bj = 0; bj < 2; ++bj)
#pragma unroll
                    for (int n = 0; n < 2; ++n) {
                        bf16_t* pp = proj + (size_t)(row0 + ai * 128 + m * 16) * NP + C_GA + col0 + bj * 128 + n * 16;
                        const u32x2 g = *(const u32x2*)pp; const f32x4 a = acc[ai][bj][m][n];
                        u32x2 w; w.x = pg8::cvt_pk_bf16(lo16(g.x) * a[0], hi16(g.x) * a[1]); w.y = pg8::cvt_pk_bf16(lo16(g.y) * a[2], hi16(g.y) * a[3]);
                        *(u32x2*)pp = w;
                    }
    }
};
struct EpiGateS {
    bf16_t* proj;
    __device__ __forceinline__ void operator()(const f32x4 (&acc)[2][2][4][2], const Unit& u, int wr, int wc, int fr, int fq) const {
        const int row0 = u.pm * 256 + wr * 64 + fr, col0 = u.pn * 256 + wc * 32 + 4 * fq;
#pragma unroll
        for (int ai = 0; ai < 2; ++ai)
#pragma unroll
            for (int m = 0; m < 4; ++m)
#pragma unroll
                for (int bj = 0; bj < 2; ++bj)
#pragma unroll
                    for (int n = 0; n < 2; ++n) {
                        bf16_t* pa = proj + (size_t)(row0 + ai * 128 + m * 16) * NP + C_GA + col0 + bj * 128 + n * 16;
                        bf16_t* ps = pa + (C_GS - C_GA);
                        const u32x2 m1 = *(const u32x2*)pa; const u32x2 g = *(const u32x2*)ps; const f32x4 a = acc[ai][bj][m][n];
                        u32x2 w; w.x = pg8::cvt_pk_bf16(lo16(m1.x) + lo16(g.x) * a[0], hi16(m1.x) + hi16(g.x) * a[1]);
                        w.y = pg8::cvt_pk_bf16(lo16(m1.y) + lo16(g.y) * a[2], hi16(m1.y) + hi16(g.y) * a[3]);
                        *(u32x2*)ps = w;
                    }
    }
};
struct EpiResid {
    const float* xin; float* xout;
    __device__ __forceinline__ void operator()(const f32x4 (&acc)[2][2][4][2], const Unit& u, int wr, int wc, int fr, int fq) const {
        const int row0 = u.pm * 256 + wr * 64 + fr, col0 = u.pn * 256 + wc * 32 + 4 * fq;
#pragma unroll
        for (int ai = 0; ai < 2; ++ai)
#pragma unroll
            for (int m = 0; m < 4; ++m)
#pragma unroll
                for (int bj = 0; bj < 2; ++bj)
#pragma unroll
                    for (int n = 0; n < 2; ++n) {
                        const size_t off = (size_t)(row0 + ai * 128 + m * 16) * 1024 + col0 + bj * 128 + n * 16;
                        *(f32x4*)(xout + off) = *(const f32x4*)(xin + off) + acc[ai][bj][m][n];
                    }
    }
};
struct EpiBf16 {
    bf16_t* O; int ldc;
    __device__ __forceinline__ void operator()(const f32x4 (&acc)[2][2][4][2], const Unit& u, int wr, int wc, int fr, int fq) const {
        const int row0 = u.pm * 256 + wr * 64 + fr, col0 = u.pn * 256 + wc * 32 + 4 * fq;
#pragma unroll
        for (int ai = 0; ai < 2; ++ai)
#pragma unroll
            for (int m = 0; m < 4; ++m)
#pragma unroll
                for (int bj = 0; bj < 2; ++bj)
#pragma unroll
                    for (int n = 0; n < 2; ++n) {
                        const f32x4 a = acc[ai][bj][m][n];
                        u32x2 w; w.x = pg8::cvt_pk_bf16(a[0], a[1]); w.y = pg8::cvt_pk_bf16(a[2], a[3]);
                        *(u32x2*)(O + (size_t)(row0 + ai * 128 + m * 16) * ldc + col0 + bj * 128 + n * 16) = w;
                    }
    }
};

template <int MODE>
__device__ __forceinline__ void convT(const float* src, int K, int Nsrc, bf16_t* dst, int Ndst, const float* kscale, float* tile) {
    const int tid = opaque_tid(), kt = K / 64, ntiles = (Ndst / 64) * kt;
    for (int ti = blockIdx.x; ti < ntiles; ti += gridDim.x) {
        const int n0 = (ti / kt) * 64, k0 = (ti % kt) * 64;
        {
            const int nn = tid & 63; const int n = n0 + nn; const int ns = MODE ? inproj_map(n) : n;
#pragma unroll
            for (int i = 0; i < 8; ++i) {
                const int kk = (tid >> 6) + 8 * i;
                float v = (ns >= 0) ? src[(size_t)(k0 + kk) * Nsrc + ns] : 0.f;
                if (kscale) v *= kscale[k0 + kk];
                tile[nn * 65 + kk] = v;
            }
        }
        __syncthreads();
        {
            const int kk = tid & 63;
#pragma unroll
            for (int i = 0; i < 8; ++i) { const int nn = (tid >> 6) + 8 * i; dst[(size_t)(n0 + nn) * K + k0 + kk] = f2bf(tile[nn * 65 + kk]); }
        }
        __syncthreads();
    }
}

__device__ __forceinline__ void phase_convert(const Params& p, float* tile) {
    for (int l = 0; l < DEPTH; ++l) {
        unsigned char* wl = p.ws + OFF_W + (size_t)l * SZ_WL;
        bf16_t* win = (bf16_t*)wl; bf16_t* wpa = (bf16_t*)(wl + SZ_WIN); bf16_t* wps = (bf16_t*)(wl + SZ_WIN + SZ_WPA);
        bf16_t* wo = (bf16_t*)(wl + SZ_WIN + SZ_WPA + SZ_WPS); bf16_t* wup = (bf16_t*)(wl + SZ_WIN + SZ_WPA + SZ_WPS + SZ_WO); bf16_t* wdn = (bf16_t*)(wl + SZ_WIN + SZ_WPA + SZ_WPS + SZ_WO + SZ_WUP);
        convT<1>(p.w_in + (size_t)l * 1024 * IN_COLS, 1024, IN_COLS, win, NP, nullptr, tile);
        convT<0>(p.w_proj_attn + (size_t)l * 1024 * 1024, 1024, 1024, wpa, 1024, nullptr, tile);
        convT<0>(p.w_proj_ssd + (size_t)l * 2048 * 1024, 2048, 1024, wps, 1024, p.ssd_norm_w + l * 2048, tile);
        convT<0>(p.w_out + (size_t)l * 1024 * 1024, 1024, 1024, wo, 1024, nullptr, tile);
        convT<0>(p.ffn_w_up + (size_t)l * 1024 * FFN2, 1024, FFN2, wup, FFN2, nullptr, tile);
        convT<0>(p.ffn_w_down + (size_t)l * FFN * 1024, FFN, 1024, wdn, 1024, nullptr, tile);
    }
    float* rope = (float*)(p.ws + OFF_ROPE);
    float* cosA = rope; float* sinA = rope + 4096 * 16; float* cosI = rope + 4096 * 32; float* sinI = rope + 4096 * 40;
    for (int i = blockIdx.x * 512 + opaque_tid(); i < 4096 * 24; i += gridDim.x * 512) {
        int pos, f; float inv;
        if (i < 4096 * 16) { pos = i >> 4; f = i & 15; inv = p.invA[f]; } else { const int j = i - 4096 * 16; pos = j >> 3; f = j & 7; inv = p.invI[f]; }
        const float ang = (float)pos * inv;
        double rev = (double)ang * 0.15915494309189535; rev -= rint(rev);
        const float c = __builtin_amdgcn_cosf((float)rev), s = __builtin_amdgcn_sinf((float)rev);
        if (i < 4096 * 16) { cosA[pos * 16 + f] = c; sinA[pos * 16 + f] = s; } else { cosI[pos * 8 + f] = c; sinI[pos * 8 + f] = s; }
    }
}

template <bool F32OUT>
__device__ __forceinline__ void phase_norm(const float* xin, const float* w, bf16_t* hout, float* fout, int nrows) {
    const int tid = opaque_tid(); const int wave = tid >> 6, lane = tid & 63;
    for (int row = blockIdx.x * 8 + wave; row < nrows; row += gridDim.x * 8) {
        const f32x4* xr = (const f32x4*)(xin + (size_t)row * 1024);
        f32x4 v[4]; float ss = 0.f;
#pragma unroll
        for (int i = 0; i < 4; ++i) { v[i] = xr[lane + 64 * i]; ss += v[i][0] * v[i][0] + v[i][1] * v[i][1] + v[i][2] * v[i][2] + v[i][3] * v[i][3]; }
        ss = wave_sum(ss);
        const float rstd = rsqrtf(ss * (1.0f / 1024.0f) + EPS);
#pragma unroll
        for (int i = 0; i < 4; ++i) {
            const f32x4 w4 = ((const f32x4*)w)[lane + 64 * i];
            const f32x4 o = v[i] * rstd * w4;
            if (F32OUT) ((f32x4*)(fout + (size_t)row * 1024))[lane + 64 * i] = o;
            else { u32x2 pk; pk.x = pack2(o[0], o[1]); pk.y = pack2(o[2], o[3]); *(u32x2*)(hout + (size_t)row * 1024 + 4 * (lane + 64 * i)) = pk; }
        }
    }
}

__device__ __forceinline__ unsigned fkey(float s) { s += 0.0f; const unsigned u = __float_as_uint(s); return (u & 0x80000000u) ? ~u : (u | 0x80000000u); }

__device__ __forceinline__ void phase_idx_simple(const bf16_t* proj, const float* misc, unsigned* mask, int* sel, unsigned char* shm) {
    const int tid = opaque_tid(); const int wave = tid >> 6, lane = tid & 63;
    float* qs = (float*)(shm + wave * 18432); unsigned* sk = (unsigned*)(shm + wave * 18432 + 2048);
    const unsigned long long lt_mask = (1ull << lane) - 1ull;
    for (int q = blockIdx.x * 8 + wave; q < SLAB; q += gridDim.x * 8) {
        const int bl = q >> 12, t = q & (SEQ - 1), n = t + 1;
        wave_lds_sync();
        {
            const u32x4 raw = *(const u32x4*)(proj + (size_t)q * NP + C_QI + lane * 8);
            f32x4 a, b; a[0] = lo16(raw.x); a[1] = hi16(raw.x); a[2] = lo16(raw.y); a[3] = hi16(raw.y); b[0] = lo16(raw.z); b[1] = hi16(raw.z); b[2] = lo16(raw.w); b[3] = hi16(raw.w);
            *(f32x4*)(qs + lane * 8) = a; *(f32x4*)(qs + lane * 8 + 4) = b;
        }
        float wv[8];
        { const f32x4 w0 = *(const f32x4*)(misc + (size_t)q * 256 + 64), w1 = *(const f32x4*)(misc + (size_t)q * 256 + 68);
#pragma unroll
          for (int j = 0; j < 4; ++j) { wv[j] = w0[j]; wv[4 + j] = w1[j]; } }
        wave_lds_sync();
        const int nr = (n + 63) & ~63;
        for (int s = lane; s < nr; s += 64) {
            if (s < n) {
                const f32x4* kp = (const f32x4*)(misc + (size_t)(bl * SEQ + s) * 256);
                f32x4 kv[16];
#pragma unroll
                for (int i = 0; i < 16; ++i) kv[i] = kp[i];
                float sc = 0.f;
#pragma unroll
                for (int h = 0; h < 8; ++h) {
                    float d = 0.f;
#pragma unroll
                    for (int i = 0; i < 16; ++i) { const f32x4 qv = *(const f32x4*)(qs + h * 64 + i * 4); d += kv[i][0] * qv[0] + kv[i][1] * qv[1] + kv[i][2] * qv[2] + kv[i][3] * qv[3]; }
                    sc += wv[h] * fmaxf(d, 0.f);
                }
                sk[s] = fkey(sc);
            }
        }
        wave_lds_sync();
        unsigned cur = 0u; int need = 1 << 30;
        if (n > 256) {
            for (int bit = 31; bit >= 0; --bit) {
                const unsigned cand = cur | (1u << bit); int cnt = 0;
                for (int s = lane; s < nr; s += 64) { const bool pr = (s < n) && (sk[s] >= cand); cnt += __popcll(__ballot(pr)); }
                if (cnt >= 256) cur = cand;
            }
            int cgt = 0;
            for (int s = lane; s < nr; s += 64) { const bool pr = (s < n) && (sk[s] > cur); cgt += __popcll(__ballot(pr)); }
            need = 256 - cgt;
        }
        int run_eq = 0, run_sel = 0; unsigned long long mybal = 0ull;
        for (int s = lane, c = 0; s < nr; s += 64, ++c) {
            const bool in = s < n; const unsigned k = in ? sk[s] : 0u;
            const bool gt = in && (k > cur), eq = in && (k == cur);
            const unsigned long long beq = __ballot(eq);
            const int rank = run_eq + __popcll(beq & lt_mask);
            const bool se = gt || (eq && rank < need);
            const unsigned long long bs = __ballot(se);
            const int pos = run_sel + __popcll(bs & lt_mask);
            if (se && pos < 256) sel[(size_t)q * 256 + pos] = s;
            run_eq += __popcll(beq); run_sel += __popcll(bs);
            if (lane == c) mybal = bs;
        }
        u32x2 mw; mw.x = (unsigned)mybal; mw.y = (unsigned)(mybal >> 32);
        *(u32x2*)(mask + (size_t)q * 128 + lane * 2) = mw;
        for (int j = run_sel + lane; j < 256; j += 64) sel[(size_t)q * 256 + j] = -1;
    }
}

__device__ __forceinline__ void phase_att_simple(bf16_t* proj, const int* sel, unsigned char* shm) {
    const int tid = opaque_tid(); const int wave = tid >> 6, lane = tid & 63, h = wave, kvh = h >> 2;
    float* qf = (float*)(shm + wave * 2560); float* pj = qf + 128; int* kj = (int*)(pj + 256);
    const float scale = 0.08838834764831845f;
    for (int q = blockIdx.x; q < SLAB; q += gridDim.x) {
        const int bl = q >> 12;
        wave_lds_sync();
        { const unsigned raw = *(const unsigned*)(proj + (size_t)q * NP + C_Q + h * 128 + 2 * lane); qf[2 * lane] = lo16(raw); qf[2 * lane + 1] = hi16(raw); }
        int keys[4];
#pragma unroll
        for (int i = 0; i < 4; ++i) { keys[i] = sel[(size_t)q * 256 + lane + 64 * i]; kj[lane + 64 * i] = keys[i]; }
        wave_lds_sync();
        float lg[4]; float mx = -INFINITY;
#pragma unroll
        for (int i = 0; i < 4; ++i) {
            lg[i] = -INFINITY;
            if (keys[i] >= 0) {
                const u32x4* kp = (const u32x4*)(proj + (size_t)(bl * SEQ + keys[i]) * NP + C_K + kvh * 128);
                float d = 0.f;
#pragma unroll
                for (int c = 0; c < 16; ++c) {
                    const u32x4 raw = kp[c]; const f32x4 q0 = *(const f32x4*)(qf + c * 8), q1 = *(const f32x4*)(qf + c * 8 + 4);
                    d += lo16(raw.x) * q0[0] + hi16(raw.x) * q0[1] + lo16(raw.y) * q0[2] + hi16(raw.y) * q0[3] + lo16(raw.z) * q1[0] + hi16(raw.z) * q1[1] + lo16(raw.w) * q1[2] + hi16(raw.w) * q1[3];
                }
                lg[i] = d * scale;
            }
            mx = fmaxf(mx, lg[i]);
        }
        mx = wave_max(mx);
        float sm = 0.f; float pe[4];
#pragma unroll
        for (int i = 0; i < 4; ++i) { pe[i] = (keys[i] >= 0) ? __expf(lg[i] - mx) : 0.f; sm += pe[i]; }
        sm = wave_sum(sm);
        const float inv = 1.0f / sm;
#pragma unroll
        for (int i = 0; i < 4; ++i) pj[lane + 64 * i] = pe[i] * inv;
        wave_lds_sync();
        float a0 = 0.f, a1 = 0.f;
        const bf16_t* vb = proj + (size_t)(bl * SEQ) * NP + C_V + kvh * 128 + 2 * lane;
        for (int j0 = 0; j0 < 256; j0 += 16) {
            if (kj[j0] < 0) break;
            unsigned raw[16]; float pv[16];
#pragma unroll
            for (int u = 0; u < 16; ++u) { const int key = max(kj[j0 + u], 0); pv[u] = pj[j0 + u]; raw[u] = *(const unsigned*)(vb + (size_t)key * NP); }
#pragma unroll
            for (int u = 0; u < 16; ++u) { a0 += pv[u] * lo16(raw[u]); a1 += pv[u] * hi16(raw[u]); }
        }
        *(unsigned*)(proj + (size_t)q * NP + C_Q + h * 128 + 2 * lane) = pack2(a0, a1);
    }
}


typedef short bf16x4 __attribute__((ext_vector_type(4)));
__device__ __forceinline__ void phase_idx(const bf16_t* proj, const float* misc, unsigned* mask, unsigned char* shm) {
    const int tid = opaque_tid(), wave = __builtin_amdgcn_readfirstlane(tid >> 6), lane = tid & 63, fr = lane & 15, fq = lane >> 4;
    int* cntbuf = (int*)shm;
    int* cbuf2 = cntbuf + 256;
    for (int it = blockIdx.x; it < 256; it += gridDim.x) {
        for (int pass = 0; pass < 4; ++pass) {
            const int i = (pass == 0) ? it : (pass == 1) ? 511 - it : (pass == 2) ? 512 + it : 1023 - it;
            const int qt = 255 - (i >> 2), bl = i & 3;
            const int q0 = qt * 16, nch = (q0 + 15) / 64 + 1, t = q0 + fr;
            const size_t qrow = (size_t)bl * SEQ + q0 + fr;
            int lb = wave * 64 + fq * 4; asm volatile("" : "+v"(lb));
            u32x4 key[4][4];
            u32x4* klds = (u32x4*)(shm + 18688) + tid;
#define KGET(dst, ip, tt) do { if ((ip) < 4) dst = key[(ip) < 4 ? (ip) : 0][tt]; else dst = klds[(((ip) - 4) * 4 + (tt)) * 512]; } while (0)
            {
                float wv[8];
                { const f32x4 w0 = *(const f32x4*)(misc + qrow * 256 + 64), w1 = *(const f32x4*)(misc + qrow * 256 + 68);
#pragma unroll
                  for (int j = 0; j < 4; ++j) { wv[j] = w0[j]; wv[4 + j] = w1[j]; } }
#pragma unroll
                for (int u = 0; u < 2; ++u) { const int ch = tid + 512 * u, r = ch >> 6, cc = ch & 63;
                    *(u32x4*)(shm + 2048 + r * 1040 + cc * 16) = *(const u32x4*)(proj + ((size_t)bl * SEQ + q0 + r) * NP + C_QI + cc * 8); }
                __syncthreads();
                const unsigned char* ql = shm + 2048 + fr * 1040 + fq * 16;
#pragma unroll
                for (int ip = 0; ip < 8; ++ip) {
                    int c = wave + 8 * ip; asm volatile("" : "+s"(c));
                    if (c < nch) {
                        const int trel = t - (c - wave) * 64 - lb;
                        const bf16_t* kp0 = proj + ((size_t)bl * SEQ + c * 64 + fr) * NP + C_MISC + fq * 8;
#pragma unroll
                        for (int tp = 0; tp < 2; ++tp) {
                            bf16x8 kf[2][2];
#pragma unroll
                            for (int u = 0; u < 2; ++u) { const bf16_t* kp = kp0 + (size_t)((tp * 2 + u) * 16) * NP; kf[u][0] = *(const bf16x8*)kp; kf[u][1] = *(const bf16x8*)(kp + 32); }
                            f32x4 sc[2];
                            sc[0] = (f32x4){0.f, 0.f, 0.f, 0.f}; sc[1] = (f32x4){0.f, 0.f, 0.f, 0.f};
#pragma unroll
                            for (int h = 0; h < 8; ++h) {
                                const bf16x8 q0f = *(const bf16x8*)(ql + h * 128), q1f = *(const bf16x8*)(ql + h * 128 + 64);
#pragma unroll
                                for (int u = 0; u < 2; ++u) {
                                    f32x4 d = __builtin_amdgcn_mfma_f32_16x16x32_bf16(kf[u][0], q0f, (f32x4){0.f, 0.f, 0.f, 0.f}, 0, 0, 0);
                                    d = __builtin_amdgcn_mfma_f32_16x16x32_bf16(kf[u][1], q1f, d, 0, 0, 0);
#pragma unroll
                                    for (int j = 0; j < 4; ++j) sc[u][j] += wv[h] * fmaxf(d[j], 0.f);
                                }
                                if ((h & 3) == 3) asm volatile("" ::: "memory");
                            }
#pragma unroll
                            for (int u = 0; u < 2; ++u) {
                                u32x4 kk;
#pragma unroll
                                for (int j = 0; j < 4; ++j) kk[j] = ((tp * 2 + u) * 16 + j <= trel) ? fkey(sc[u][j]) : 0u;
                                if (ip < 4) key[ip < 4 ? ip : 0][tp * 2 + u] = kk; else klds[((ip - 4) * 4 + tp * 2 + u) * 512] = kk;
                            }
                        }
                    } else if (ip < 4) {
#pragma unroll
                        for (int tt = 0; tt < 4; ++tt) key[ip < 4 ? ip : 0][tt] = (u32x4){0u, 0u, 0u, 0u};
                    }
                    asm volatile("" ::: "memory");
                }
            }
            __syncthreads();
            unsigned cur = 0u;
            for (int bit = 31; bit >= 0; --bit) {
                const unsigned cand = cur | (1u << bit);
                int cnt = 0;
#pragma unroll
                for (int ip = 0; ip < 8; ++ip)
                    if (wave + 8 * ip < nch) {
#pragma unroll
                        for (int tt = 0; tt < 4; ++tt) { u32x4 kv; KGET(kv, ip, tt);
#pragma unroll
                            for (int j = 0; j < 4; ++j) cnt += (kv[j] >= cand) ? 1 : 0; }
                    }
                cnt += __shfl_xor(cnt, 16); cnt += __shfl_xor(cnt, 32);
                int* cb = cntbuf + (bit & 1) * 128;
                if (fq == 0) cb[fr * 8 + wave] = cnt;
                __syncthreads();
                const int4 a = *(const int4*)(cb + fr * 8), b = *(const int4*)(cb + fr * 8 + 4);
                const int tot = a.x + a.y + a.z + a.w + b.x + b.y + b.z + b.w;
                if (tot >= 256) cur = cand;
            }
            int cg = 0, ce = 0;
#pragma unroll
            for (int ip = 0; ip < 8; ++ip)
                if (wave + 8 * ip < nch) {
#pragma unroll
                    for (int tt = 0; tt < 4; ++tt) { u32x4 kv; KGET(kv, ip, tt);
#pragma unroll
                        for (int j = 0; j < 4; ++j) { cg += (kv[j] > cur) ? 1 : 0; ce += (kv[j] == cur) ? 1 : 0; } }
                }
            cg += __shfl_xor(cg, 16); cg += __shfl_xor(cg, 32); ce += __shfl_xor(ce, 16); ce += __shfl_xor(ce, 32);
            if (fq == 0) { cbuf2[fr * 8 + wave] = cg; cbuf2[128 + fr * 8 + wave] = ce; }
            __syncthreads();
            int need, ceq;
            { const int4 a = *(const int4*)(cbuf2 + fr * 8), b = *(const int4*)(cbuf2 + fr * 8 + 4);
              need = 256 - (a.x + a.y + a.z + a.w + b.x + b.y + b.z + b.w);
              const int4 c4 = *(const int4*)(cbuf2 + 128 + fr * 8), d4 = *(const int4*)(cbuf2 + 128 + fr * 8 + 4);
              ceq = c4.x + c4.y + c4.z + c4.w + d4.x + d4.y + d4.z + d4.w; }
            const bool ties = (cur != 0u) && (ceq > need);
            unsigned J = 4095u;
            if (__syncthreads_or(ties ? 1 : 0)) {
                unsigned Jt = 0u;
                for (int bit = 11; bit >= 0; --bit) {
                    const unsigned cand = Jt | (1u << bit);
                    const int crel = (int)cand - lb;
                    int cnt = 0;
#pragma unroll
                    for (int ip = 0; ip < 8; ++ip)
                        if (wave + 8 * ip < nch) {
#pragma unroll
                            for (int tt = 0; tt < 4; ++tt) { u32x4 kv; KGET(kv, ip, tt);
#pragma unroll
                                for (int j = 0; j < 4; ++j) cnt += (kv[j] == cur && (ip * 512 + tt * 16 + j) < crel) ? 1 : 0; }
                        }
                    cnt += __shfl_xor(cnt, 16); cnt += __shfl_xor(cnt, 32);
                    int* cb = cntbuf + (bit & 1) * 128;
                    if (fq == 0) cb[fr * 8 + wave] = cnt;
                    __syncthreads();
                    const int4 a = *(const int4*)(cb + fr * 8), b = *(const int4*)(cb + fr * 8 + 4);
                    const int tot = a.x + a.y + a.z + a.w + b.x + b.y + b.z + b.w;
                    if (tot < need) Jt = cand;
                }
                if (ties) J = Jt;
            }
#pragma unroll
            for (int ip = 0; ip < 8; ++ip) {
                const int c = wave + 8 * ip;
                if (c < nch) {
                    unsigned lo = 0u, hi = 0u;
                    const int jrel = (int)J - lb;
#pragma unroll
                    for (int tt = 0; tt < 4; ++tt) { u32x4 kv; KGET(kv, ip, tt);
#pragma unroll
                        for (int j = 0; j < 4; ++j) {
                            const unsigned k = kv[j];
                            const bool se = (k > cur) || (k == cur && cur != 0u && (ip * 512 + tt * 16 + j) <= jrel);
                            const unsigned b = se ? 1u : 0u;
                            if (tt < 2) lo |= b << (tt * 16 + j); else hi |= b << ((tt - 2) * 16 + j);
                        } }
                    lo <<= (lb & 15); hi <<= (lb & 15);
                    lo |= __shfl_xor(lo, 16); lo |= __shfl_xor(lo, 32); hi |= __shfl_xor(hi, 16); hi |= __shfl_xor(hi, 32);
                    if (fq == 0) { u32x2 mw; mw.x = lo; mw.y = hi; *(u32x2*)(mask + qrow * 128 + c * 2) = mw; }
                }
            }
            __syncthreads();
        }
    }
#undef KGET
}

__device__ __forceinline__ void phase_att(bf16_t* proj, const bf16_t* vt, const unsigned* mask, unsigned char* shm) {
    const int tid = opaque_tid(), wave = tid >> 6, lane = tid & 63, fr = lane & 15, fq = lane >> 4;
    const int qs = wave & 3, hp = wave >> 2;
    constexpr int KROW = 272, VROW = 144, KBYTES = 64 * KROW, VBYTES = 128 * VROW, BUF = KBYTES + VBYTES;
    const float sc2 = 0.08838834764831845f * 1.4426950408889634f;
    for (int it = blockIdx.x; it < 256; it += gridDim.x) {
        for (int pass = 0; pass < 2; ++pass) {
            const int i = (pass == 0) ? it : 511 - it;
            const int qb = 63 - (i >> 3), sub = i & 7, bl = sub >> 1, kvh = sub & 1, nkt = qb + 1;
            const size_t qrow = (size_t)bl * SEQ + qb * 64 + qs * 16 + fr;
            bf16x8 qf[2][4];
#pragma unroll
            for (int hh = 0; hh < 2; ++hh)
#pragma unroll
                for (int ks = 0; ks < 4; ++ks) qf[hh][ks] = *(const bf16x8*)(proj + qrow * NP + C_Q + (kvh * 4 + hp * 2 + hh) * 128 + ks * 32 + fq * 8);
            f32x4 o[2][8];
#pragma unroll
            for (int hh = 0; hh < 2; ++hh)
#pragma unroll
                for (int dt = 0; dt < 8; ++dt) o[hh][dt] = (f32x4){0.f, 0.f, 0.f, 0.f};
            float mrow[2] = {-1e30f, -1e30f}, lrow[2] = {0.f, 0.f};
            const int kr0 = tid >> 4, kc = tid & 15;
            const int vr0 = tid >> 3, vc = tid & 7;
            const bf16_t* kg = proj + ((size_t)bl * SEQ + kr0) * NP + C_K + kvh * 128 + kc * 8;
            const bf16_t* vg = vt + ((size_t)(bl * 2 + kvh) * 128 + vr0) * SEQ + vc * 8;
            const int klds = kr0 * KROW + kc * 16, vlds = KBYTES + vr0 * VROW + vc * 16;
            u32x4 kreg[2], vreg[2];
            __syncthreads();
            kreg[0] = *(const u32x4*)kg; kreg[1] = *(const u32x4*)(kg + (size_t)32 * NP);
            vreg[0] = *(const u32x4*)vg; vreg[1] = *(const u32x4*)(vg + (size_t)64 * SEQ);
            *(u32x4*)(shm + klds) = kreg[0]; *(u32x4*)(shm + klds + 32 * KROW) = kreg[1];
            *(u32x4*)(shm + vlds) = vreg[0]; *(u32x4*)(shm + vlds + 64 * VROW) = vreg[1];
            __syncthreads();
            for (int kt = 0; kt < nkt; ++kt) {
                const unsigned char* buf = shm + (kt & 1) * BUF;
                const bool more = (kt + 1 < nkt);
                if (more) {
                    const bf16_t* kg2 = kg + (size_t)(kt + 1) * 64 * NP; const bf16_t* vg2 = vg + (kt + 1) * 64;
                    kreg[0] = *(const u32x4*)kg2; kreg[1] = *(const u32x4*)(kg2 + (size_t)32 * NP);
                    vreg[0] = *(const u32x4*)vg2; vreg[1] = *(const u32x4*)(vg2 + (size_t)64 * SEQ);
                }
                const u32x2 mk = *(const u32x2*)(mask + qrow * 128 + kt * 2);
                const unsigned mlo = mk.x >> (fq * 4), mhi = mk.y >> (fq * 4);
                f32x4 s[2][4];
#pragma unroll
                for (int nt = 0; nt < 4; ++nt) {
                    s[0][nt] = (f32x4){0.f, 0.f, 0.f, 0.f}; s[1][nt] = (f32x4){0.f, 0.f, 0.f, 0.f};
#pragma unroll
                    for (int ks = 0; ks < 4; ++ks) {
                        const bf16x8 kf = *(const bf16x8*)(buf + (nt * 16 + fr) * KROW + (ks * 32 + fq * 8) * 2);
                        s[0][nt] = __builtin_amdgcn_mfma_f32_16x16x32_bf16(kf, qf[0][ks], s[0][nt], 0, 0, 0);
                        s[1][nt] = __builtin_amdgcn_mfma_f32_16x16x32_bf16(kf, qf[1][ks], s[1][nt], 0, 0, 0);
                    }
                }
                bf16x8 pf[2][2];
#pragma unroll
                for (int hh = 0; hh < 2; ++hh) {
                    float mx = -1e30f;
#pragma unroll
                    for (int nt = 0; nt < 4; ++nt)
#pragma unroll
                        for (int j = 0; j < 4; ++j) {
                            const unsigned w = (nt < 2) ? mlo : mhi; const bool se = (w >> ((nt & 1) * 16 + j)) & 1u;
                            const float tv = s[hh][nt][j] * sc2; s[hh][nt][j] = tv;
                            mx = fmaxf(mx, se ? tv : -1e30f);
                        }
                    mx = fmaxf(mx, __shfl_xor(mx, 16)); mx = fmaxf(mx, __shfl_xor(mx, 32));
                    const float mnew = fmaxf(mrow[hh], mx);
                    const float alpha = __builtin_amdgcn_exp2f(mrow[hh] - mnew);
                    mrow[hh] = mnew;
                    float ls = 0.f;
#pragma unroll
                    for (int nt = 0; nt < 4; ++nt)
#pragma unroll
                        for (int j = 0; j < 4; ++j) {
                            const unsigned w = (nt < 2) ? mlo : mhi; const bool se = (w >> ((nt & 1) * 16 + j)) & 1u;
                            const float pv = se ? __builtin_amdgcn_exp2f(s[hh][nt][j] - mnew) : 0.f;
                            s[hh][nt][j] = pv; ls += pv;
                        }
                    lrow[hh] = lrow[hh] * alpha + ls;
#pragma unroll
                    for (int dt = 0; dt < 8; ++dt) o[hh][dt] *= alpha;
#pragma unroll
                    for (int kk = 0; kk < 2; ++kk) {
                        u32x4 pk;
                        pk.x = pg8::cvt_pk_bf16(s[hh][2 * kk][0], s[hh][2 * kk][1]); pk.y = pg8::cvt_pk_bf16(s[hh][2 * kk][2], s[hh][2 * kk][3]);
                        pk.z = pg8::cvt_pk_bf16(s[hh][2 * kk + 1][0], s[hh][2 * kk + 1][1]); pk.w = pg8::cvt_pk_bf16(s[hh][2 * kk + 1][2], s[hh][2 * kk + 1][3]);
                        pf[hh][kk] = __builtin_bit_cast(bf16x8, pk);
                    }
                }
#pragma unroll
                for (int kk = 0; kk < 2; ++kk)
#pragma unroll
                    for (int dt = 0; dt < 8; ++dt) {
                        const unsigned char* vp = buf + KBYTES + (dt * 16 + fr) * VROW + (kk * 32 + fq * 4) * 2;
                        const bf16x4 v0 = *(const bf16x4*)vp, v1 = *(const bf16x4*)(vp + 32);
                        const bf16x8 vf = __builtin_shufflevector(v0, v1, 0, 1, 2, 3, 4, 5, 6, 7);
                        o[0][dt] = __builtin_amdgcn_mfma_f32_16x16x32_bf16(vf, pf[0][kk], o[0][dt], 0, 0, 0);
                        o[1][dt] = __builtin_amdgcn_mfma_f32_16x16x32_bf16(vf, pf[1][kk], o[1][dt], 0, 0, 0);
                    }
                if (more) {
                    unsigned char* nb = shm + ((kt + 1) & 1) * BUF;
                    *(u32x4*)(nb + klds) = kreg[0]; *(u32x4*)(nb + klds + 32 * KROW) = kreg[1];
                    *(u32x4*)(nb + vlds) = vreg[0]; *(u32x4*)(nb + vlds + 64 * VROW) = vreg[1];
                }
                __syncthreads();
            }
#pragma unroll
            for (int hh = 0; hh < 2; ++hh) {
                float lt = lrow[hh]; lt += __shfl_xor(lt, 16); lt += __shfl_xor(lt, 32);
                const float inv = 1.0f / lt;
                bf16_t* op = proj + qrow * NP + C_Q + (kvh * 4 + hp * 2 + hh) * 128 + fq * 4;
#pragma unroll
                for (int dt = 0; dt < 8; ++dt) {
                    u32x2 w; w.x = pg8::cvt_pk_bf16(o[hh][dt][0] * inv, o[hh][dt][1] * inv); w.y = pg8::cvt_pk_bf16(o[hh][dt][2] * inv, o[hh][dt][3] * inv);
                    *(u32x2*)(op + dt * 16) = w;
                }
            }
        }
    }
}

__device__ __forceinline__ void phase_ssd_simple(const Params& p, int l, bf16_t* proj, const float* misc, float* ssq, unsigned char* shm) {
    const int tid = opaque_tid(), lane = tid & 63;
    float* xs = (float*)shm; float* Bs = xs + 64 * 64; float* Cs = Bs + 64 * 128; float* dts = Cs + 64 * 128; float* decs = dts + 64; float* ybuf = decs + 64;
    const float* cw = p.ssd_conv_w + (size_t)l * 4 * 3072; const float* cb = p.ssd_conv_b + (size_t)l * 3072;
    for (int item = blockIdx.x; item < 128; item += gridDim.x) {
        const int bl = item >> 5, head = item & 31, g = head >> 3;
        const float Aneg = -__expf(p.ssd_a_log[l * 32 + head]), dtb = p.ssd_dt_bias[l * 32 + head], Dsk = p.ssd_d[l * 32 + head];
        const int pp = tid >> 3, ng = tid & 7;
        float hs[16];
#pragma unroll
        for (int k = 0; k < 16; ++k) hs[k] = 0.f;
        for (int c = 0; c < 64; ++c) {
            const int t0 = c * 64;
            __syncthreads();
            for (int i = 0; i < 40; ++i) {
                const int idx = tid + 512 * i, tok = idx / 320, cc = idx - tok * 320;
                int ch; float* dstp;
                if (cc < 64) { ch = head * 64 + cc; dstp = xs + tok * 64 + cc; }
                else if (cc < 192) { ch = 2048 + g * 128 + (cc - 64); dstp = Bs + tok * 128 + (cc - 64); }
                else { ch = 2560 + g * 128 + (cc - 192); dstp = Cs + tok * 128 + (cc - 192); }
                float a = cb[ch];
#pragma unroll
                for (int j = 0; j < 4; ++j) { const int tt = t0 + tok - 3 + j; if (tt >= 0) a += cw[j * 3072 + ch] * bf2f(proj[(size_t)(bl * SEQ + tt) * NP + C_XBC + ch]); }
                *dstp = silu_f(a);
            }
            if (tid < 64) {
                const float v = misc[(size_t)(bl * SEQ + t0 + tid) * 256 + 72 + head] + dtb;
                const float dt = (v > 20.f) ? v : log1pf(__expf(v));
                dts[tid] = dt; decs[tid] = __expf(dt * Aneg);
            }
            __syncthreads();
            for (int tok = 0; tok < 64; ++tok) {
                const float xv = xs[tok * 64 + pp], dt = dts[tok], dec = decs[tok], xdt = xv * dt;
                float y = 0.f;
#pragma unroll
                for (int k4 = 0; k4 < 4; ++k4) {
                    const f32x4 b4 = *(const f32x4*)(Bs + tok * 128 + ng * 16 + k4 * 4), c4 = *(const f32x4*)(Cs + tok * 128 + ng * 16 + k4 * 4);
#pragma unroll
                    for (int j = 0; j < 4; ++j) { float& hh = hs[k4 * 4 + j]; hh = hh * dec + xdt * b4[j]; y += c4[j] * hh; }
                }
                y += __shfl_xor(y, 1); y += __shfl_xor(y, 2); y += __shfl_xor(y, 4);
                if (ng == 0) ybuf[tok * 65 + pp] = y + Dsk * xv;
            }
            __syncthreads();
#pragma unroll
            for (int i = 0; i < 8; ++i) {
                const int idx = tid + 512 * i, tok = idx >> 6, p2 = idx & 63;
                bf16_t* zp = proj + (size_t)(bl * SEQ + t0 + tok) * NP + C_Z + head * 64 + p2;
                const float yg = ybuf[tok * 65 + p2] * silu_f(bf2f(*zp));
                *zp = f2bf(yg);
                const float s2 = wave_sum(yg * yg);
                if (lane == 0) ssq[(size_t)(bl * SEQ + t0 + tok) * 32 + head] = s2;
            }
        }
    }
}

__device__ __forceinline__ void phase_gnorm(bf16_t* proj, const float* ssq) {
    for (int idx = blockIdx.x * 512 + opaque_tid(); idx < SLAB * 256; idx += gridDim.x * 512) {
        const int t = idx >> 8, c8 = idx & 255, g = c8 >> 6;
        const f32x4 s0 = *(const f32x4*)(ssq + (size_t)t * 32 + g * 8), s1 = *(const f32x4*)(ssq + (size_t)t * 32 + g * 8 + 4);
        const float tot = s0[0] + s0[1] + s0[2] + s0[3] + s1[0] + s1[1] + s1[2] + s1[3];
        const float rstd = rsqrtf(tot * (1.0f / 512.0f) + EPS);
        u32x4* pp = (u32x4*)(proj + (size_t)t * NP + C_Z + c8 * 8);
        u32x4 v = *pp;
        v.x = pack2(lo16(v.x) * rstd, hi16(v.x) * rstd); v.y = pack2(lo16(v.y) * rstd, hi16(v.y) * rstd);
        v.z = pack2(lo16(v.z) * rstd, hi16(v.z) * rstd); v.w = pack2(lo16(v.w) * rstd, hi16(v.w) * rstd);
        *pp = v;
    }
}

__device__ __forceinline__ void phase_convglu(const bf16_t* U, bf16_t* GL, const float* cw, const float* cb) {
    for (int idx = blockIdx.x * 512 + opaque_tid(); idx < SLAB * 352; idx += gridDim.x * 512) {
        const int t = idx / 352, f = (idx - t * 352) * 8, pos = t & (SEQ - 1);
        float ga[8], va[8];
#pragma unroll
        for (int e = 0; e < 8; ++e) { ga[e] = cb[f + e]; va[e] = cb[FFN + f + e]; }
#pragma unroll
        for (int j = 0; j < 3; ++j) {
            if (pos - 2 + j >= 0) {
                const bf16_t* up = U + (size_t)(t - 2 + j) * FFN2 + f;
                const u32x4 g4 = *(const u32x4*)up, v4 = *(const u32x4*)(up + FFN);
                const float* wg = cw + j * FFN2 + f; const float* wv = wg + FFN;
                const unsigned gw[4] = {g4.x, g4.y, g4.z, g4.w}, vw[4] = {v4.x, v4.y, v4.z, v4.w};
#pragma unroll
                for (int e = 0; e < 4; ++e) {
                    ga[2 * e] += wg[2 * e] * lo16(gw[e]); ga[2 * e + 1] += wg[2 * e + 1] * hi16(gw[e]);
                    va[2 * e] += wv[2 * e] * lo16(vw[e]); va[2 * e + 1] += wv[2 * e + 1] * hi16(vw[e]);
                }
            }
        }
        u32x4 o;
        o.x = pack2(silu_f(ga[0]) * va[0], silu_f(ga[1]) * va[1]); o.y = pack2(silu_f(ga[2]) * va[2], silu_f(ga[3]) * va[3]);
        o.z = pack2(silu_f(ga[4]) * va[4], silu_f(ga[5]) * va[5]); o.w = pack2(silu_f(ga[6]) * va[6], silu_f(ga[7]) * va[7]);
        *(u32x4*)(GL + (size_t)t * FFN + f) = o;
    }
}

__global__ void __launch_bounds__(512, 2) mega(Params p) {
    extern __shared__ __attribute__((aligned(16))) unsigned char shm[];
    cg::grid_group grid = cg::this_grid();
    LAS unsigned char* lds = (LAS unsigned char*)shm;
    unsigned char* ws = p.ws;
    bf16_t* H = (bf16_t*)(ws + OFF_H); bf16_t* PROJ = (bf16_t*)(ws + OFF_PROJ); float* MISC = (float*)(ws + OFF_MISC);
    unsigned* MASK = (unsigned*)(ws + OFF_MASK); int* SEL = (int*)(ws + OFF_SEL); float* SSQ = (float*)(ws + OFF_SSQ);
    bf16_t* VT = (bf16_t*)(ws + OFF_VT); bf16_t* U = PROJ; bf16_t* GL = (bf16_t*)(ws + OFF_GL);
    const float* rope = (const float*)(ws + OFF_ROPE);

    phase_convert(p, (float*)shm);
    grid.sync();
    for (int l = 0; l < DEPTH; ++l) {
        const unsigned char* wl = ws + OFF_W + (size_t)l * SZ_WL;
        const bf16_t* win = (const bf16_t*)wl; const bf16_t* wpa = (const bf16_t*)(wl + SZ_WIN); const bf16_t* wps = (const bf16_t*)(wl + SZ_WIN + SZ_WPA);
        const bf16_t* wo = (const bf16_t*)(wl + SZ_WIN + SZ_WPA + SZ_WPS); const bf16_t* wup = (const bf16_t*)(wl + SZ_WIN + SZ_WPA + SZ_WPS + SZ_WO);
        const bf16_t* wdn = (const bf16_t*)(wl + SZ_WIN + SZ_WPA + SZ_WPS + SZ_WO + SZ_WUP);
        const float* xin = (l == 0) ? p.x : p.out;
        for (int half = 0; half < NSLAB; ++half) {
            const size_t r0 = (size_t)half * SLAB;
            phase_norm<false>(xin + r0 * 1024, p.norm_mix_w + l * 1024, H, nullptr, SLAB);
            grid.sync();
            { EpiInProj E{PROJ, MISC, rope, rope + 4096 * 16, rope + 4096 * 32, rope + 4096 * 40, VT};
              pg8::gemm_phase(lds, H, 1024, win, SLAB, NP, 1024, E); }
            grid.sync();
            phase_idx(PROJ, MISC, MASK, shm);
            grid.sync();
            phase_att(PROJ, VT, MASK, shm);
            __syncthreads();
            phase_ssd_simple(p, l, PROJ, MISC, SSQ, shm);
            grid.sync();
            phase_gnorm(PROJ, SSQ);
            grid.sync();
            { EpiGateA E{PROJ}; pg8::gemm_phase(lds, PROJ + C_Q, NP, wpa, SLAB, 1024, 1024, E); }
            { EpiGateS E{PROJ}; pg8::gemm_phase(lds, PROJ + C_Z, NP, wps, SLAB, 1024, 2048, E); }
            grid.sync();
            { EpiResid E{xin + r0 * 1024, p.out + r0 * 1024}; pg8::gemm_phase(lds, PROJ + C_GS, NP, wo, SLAB, 1024, 1024, E); }
            grid.sync();
        }
        for (int half = 0; half < NSLAB; ++half) {
            const size_t r0 = (size_t)half * SLAB;
            phase_norm<false>(p.out + r0 * 1024, p.norm_ffn_w + l * 1024, H, nullptr, SLAB);
            grid.sync();
            { EpiBf16 E{U, FFN2}; pg8::gemm_phase(lds, H, 1024, wup, SLAB, FFN2, 1024, E); }
            grid.sync();
            phase_convglu(U, GL, p.ffn_conv_w + (size_t)l * 3 * FFN2, p.ffn_conv_b + (size_t)l * FFN2);
            grid.sync();
            { EpiResid E{p.out + r0 * 1024, p.out + r0 * 1024}; pg8::gemm_phase(lds, GL, FFN, wdn, SLAB, 1024, FFN, E); }
            grid.sync();
        }
    }
    phase_norm<true>(p.out, p.norm_final_w, nullptr, p.out, NTOK);
}

extern "C" void kernel_launch(void* const* d_in, const int* in_sizes, int n_in, void* d_out, int out_size, void* d_ws, size_t ws_size, hipStream_t stream) {
    static int grid_blocks = 0;
    if (!grid_blocks) {
        int dev = 0, cus = 0, per_cu = 0;
        hipGetDevice(&dev);
        hipDeviceGetAttribute(&cus, hipDeviceAttributeMultiprocessorCount, dev);
        hipFuncSetAttribute((const void*)mega, hipFuncAttributeMaxDynamicSharedMemorySize, LDS_BYTES);
        hipOccupancyMaxActiveBlocksPerMultiprocessor(&per_cu, mega, 512, LDS_BYTES);
        if (per_cu < 1) per_cu = 1;
        grid_blocks = cus * 1;
    }
    if (ws_size < OFF_END) { fprintf(stderr, "workspace too small: %zu < %zu\n", ws_size, (size_t)OFF_END); return; }
    Params p{};
    p.x = (const float*)d_in[0]; p.norm_mix_w = (const float*)d_in[1]; p.w_in = (const float*)d_in[2]; p.ssd_conv_w = (const float*)d_in[3]; p.ssd_conv_b = (const float*)d_in[4];
    p.ssd_dt_bias = (const float*)d_in[5]; p.ssd_a_log = (const float*)d_in[6]; p.ssd_d = (const float*)d_in[7]; p.ssd_norm_w = (const float*)d_in[8];
    p.w_proj_attn = (const float*)d_in[9]; p.w_proj_ssd = (const float*)d_in[10]; p.w_out = (const float*)d_in[11]; p.norm_ffn_w = (const float*)d_in[12];
    p.ffn_w_up = (const float*)d_in[13]; p.ffn_conv_w = (const float*)d_in[14]; p.ffn_conv_b = (const float*)d_in[15]; p.ffn_w_down = (const float*)d_in[16]; p.norm_final_w = (const float*)d_in[17];
    p.out = (float*)d_out; p.ws = (unsigned char*)d_ws;
    for (int i = 0; i < 16; ++i) p.invA[i] = powf(500000.0f, -(float)(2 * i) / 32.0f);
    for (int i = 0; i < 8; ++i) p.invI[i] = powf(500000.0f, -(float)(2 * i) / 16.0f);
    void* args[] = {&p};
    hipError_t e = hipLaunchCooperativeKernel((const void*)mega, dim3(grid_blocks), dim3(512), args, LDS_BYTES, stream);
    if (e != hipSuccess) fprintf(stderr, "cooperative launch failed: %s (grid %d)\n", hipGetErrorString(e), grid_blocks);
}
```

```cpp
#include <hip/hip_runtime.h>
#include <hip/hip_cooperative_groups.h>
#include <cstdio>
#include <cmath>
namespace cg = cooperative_groups;

#define LAS __attribute__((address_space(3)))
typedef unsigned short bf16_t;
typedef short bf16x8 __attribute__((ext_vector_type(8)));
typedef float f32x4 __attribute__((ext_vector_type(4)));
typedef unsigned u32x2 __attribute__((ext_vector_type(2)));
typedef unsigned u32x4 __attribute__((ext_vector_type(4)));

constexpr int D_MODEL = 1024, SEQ = 4096, NTOK = 32768, SLAB = 16384, NSLAB = 2, DEPTH = 2;
constexpr int IN_COLS = 9320, NP = 9472;
constexpr int C_Q = 0, C_K = 1024, C_V = 1280, C_QI = 1536, C_MISC = 2048, C_Z = 2304, C_XBC = 4352, C_GA = 7424, C_GS = 8448;
constexpr int FFN = 2816, FFN2 = 5632;
constexpr float EPS = 1e-6f;

constexpr size_t SZ_WIN = (size_t)NP * 1024 * 2, SZ_WPA = (size_t)1024 * 1024 * 2, SZ_WPS = (size_t)1024 * 2048 * 2, SZ_WO = SZ_WPA,
                 SZ_WUP = (size_t)FFN2 * 1024 * 2, SZ_WDN = (size_t)1024 * FFN * 2;
constexpr size_t SZ_WL = SZ_WIN + SZ_WPA + SZ_WPS + SZ_WO + SZ_WUP + SZ_WDN;
constexpr size_t OFF_W = 0;
constexpr size_t OFF_ROPE = OFF_W + 2 * SZ_WL;
constexpr size_t OFF_H = OFF_ROPE + (size_t)4096 * 48 * 4;
constexpr size_t OFF_PROJ = OFF_H + (size_t)SLAB * 1024 * 2;
constexpr size_t OFF_MISC = OFF_PROJ + (size_t)SLAB * NP * 2;
constexpr size_t OFF_MASK = OFF_MISC + (size_t)SLAB * 256 * 4;
constexpr size_t OFF_SEL = OFF_MASK + (size_t)SLAB * 128 * 4;
constexpr size_t OFF_SSQ = OFF_SEL + (size_t)SLAB * 256 * 4;
constexpr size_t OFF_VT = OFF_SSQ + (size_t)SLAB * 64 * 4;
constexpr size_t OFF_END = OFF_VT + (size_t)4 * 2 * 128 * 4096 * 2;
constexpr size_t OFF_GL = OFF_PROJ + (size_t)SLAB * FFN2 * 2;

constexpr int LDS_BYTES = 150528;

struct Params {
    const float* x; const float* norm_mix_w; const float* w_in; const float* ssd_conv_w; const float* ssd_conv_b;
    const float* ssd_dt_bias; const float* ssd_a_log; const float* ssd_d; const float* ssd_norm_w;
    const float* w_proj_attn; const float* w_proj_ssd; const float* w_out; const float* norm_ffn_w;
    const float* ffn_w_up; const float* ffn_conv_w; const float* ffn_conv_b; const float* ffn_w_down; const float* norm_final_w;
    float* out; unsigned char* ws;
    float invA[16]; float invI[8];
};
typedef const __attribute__((address_space(4))) Params* KParams;

__device__ __forceinline__ int opaque_tid(int wv) { int t; asm volatile("v_mbcnt_lo_u32_b32 %0, -1, 0\n\tv_mbcnt_hi_u32_b32 %0, -1, %0" : "=v"(t)); return wv * 64 + t; }
__device__ __forceinline__ float bf2f(bf16_t b) { return __uint_as_float(((unsigned)b) << 16); }
__device__ __forceinline__ bf16_t f2bf(float f) { unsigned u = __float_as_uint(f); u += 0x7FFFu + ((u >> 16) & 1u); return (bf16_t)(u >> 16); }
__device__ __forceinline__ unsigned pack2(float lo, float hi) { return (unsigned)f2bf(lo) | ((unsigned)f2bf(hi) << 16); }
__device__ __forceinline__ float lo16(unsigned w) { return __uint_as_float(w << 16); }
__device__ __forceinline__ float hi16(unsigned w) { return __uint_as_float(w & 0xffff0000u); }
__device__ __forceinline__ float silu_f(float v) { return v / (1.0f + __expf(-v)); }
__device__ __forceinline__ float sigmoid_f(float v) { return 1.0f / (1.0f + __expf(-v)); }
__device__ __forceinline__ void wave_lds_sync() { __builtin_amdgcn_fence(__ATOMIC_SEQ_CST, "wavefront"); __builtin_amdgcn_wave_barrier(); }
__device__ __forceinline__ float wave_sum(float v) {
#pragma unroll
    for (int o = 32; o >= 1; o >>= 1) v += __shfl_xor(v, o);
    return v;
}
__device__ __forceinline__ float wave_max(float v) {
#pragma unroll
    for (int o = 32; o >= 1; o >>= 1) v = fmaxf(v, __shfl_xor(v, o));
    return v;
}
__device__ __forceinline__ int permI(int p) { return p < 8 ? p : (p < 16 ? p + 8 : (p < 24 ? p - 8 : p)); }
__device__ __forceinline__ int inproj_map(int n) {
    if (n < C_QI) return n;
    if (n < C_MISC) { const int r = n - C_QI; return C_QI + (r & ~63) + permI(r & 63); }
    if (n < C_Z) { const int c = n - C_MISC; if (c < 64) return 2048 + permI(c); if (c < 72) return 2112 + (c - 64); if (c < 104) return 7240 + (c - 72); return -1; }
    if (n < C_XBC) return 2120 + (n - C_Z);
    if (n < C_GA) return 4168 + (n - C_XBC);
    if (n < C_GS) return 7272 + (n - C_GA);
    return 8296 + (n - C_GS);
}

namespace pg8 {
constexpr int BM = 256, BK = 64, HALF = 128, HTB = HALF * BK * 2, NXCD = 8, WGM = 8;
__device__ __forceinline__ int lds_byte(int r, int c) { const int st = (r >> 4) * 2 + (c >> 5), rr = r & 15, cc = c & 31, ob = rr * 64 + cc * 2; return st * 1024 + (ob ^ (((ob >> 9) & 1) << 5)); }
__device__ __forceinline__ void stage_rc(int b, int& R, int& C) { const int st = b / 1024, sb = b % 1024, swz = sb ^ (((sb >> 9) & 1) << 5); R = (st >> 1) * 16 + swz / 64; C = (st & 1) * 32 + (swz % 64) / 2; }
struct Unit { int pm, pn; };
struct StaticOrder {
    int nM, nN, nwg, G, c;
    __device__ void init(int M, int N, int G_, int c_) { nM = M / BM; nN = N / BM; nwg = nM * nN; G = G_; c = c_; }
    __device__ bool next(int i, Unit& u) const {
        const long L = (long)i * G + c; if (L >= nwg) return false;
        int wgid = (int)L; { const int q = nwg / NXCD, r = nwg % NXCD, xcd = wgid % NXCD, off = wgid / NXCD; wgid = (xcd < r ? xcd * (q + 1) : r * (q + 1) + (xcd - r) * q) + off; }
        const int nig = WGM * nN, gid = wgid / nig, fm = gid * WGM, gsz = (nM - fm) < WGM ? (nM - fm) : WGM;
        u.pm = fm + ((wgid % nig) % gsz); u.pn = (wgid % nig) / gsz; return true;
    }
};
__device__ __forceinline__ unsigned cvt_pk_bf16(float lo, float hi) { unsigned r; asm volatile("v_cvt_pk_bf16_f32 %0, %1, %2" : "=v"(r) : "v"(lo), "v"(hi)); return r; }

template <class Epi>
__device__ __forceinline__ void gemm_phase(int wv, LAS unsigned char* lds, const bf16_t* A, int lda, const bf16_t* Bt, int M, int N, int K, const Epi& E) {
    const int tid = opaque_tid(wv), wid = __builtin_amdgcn_readfirstlane(tid >> 6), lane = tid & 63, wr = wid >> 2, wc = wid & 3, fr = lane & 15, fq = lane >> 4;
    const int nt = K / BK;
    StaticOrder S; S.init(M, N, (int)gridDim.x, (int)blockIdx.x);
    unsigned voffA[2], voffB[2];
#pragma unroll
    for (int i = 0; i < 2; ++i) { int R, C; stage_rc(tid * 16 + i * 8192, R, C); voffA[i] = (unsigned)(R * lda + C) * 2u; voffB[i] = (unsigned)(R * K + C) * 2u; }
    const size_t kstep = (size_t)(BK * 2);
    const size_t hstepA = (size_t)HALF * lda * 2, hstepB = (size_t)HALF * K * 2;
    const size_t tstepA = 2 * hstepA, tstepB = 2 * hstepB;
    const unsigned ldsw = (unsigned)wid * 1024u;
    const int aoff = lds_byte(wr * 64 + fr, fq * 8), boff = lds_byte(wc * 32 + fr, fq * 8);
#define PG8_SA(b, h) (((b) * 2 + (h)) * HTB)
#define PG8_SB(b, h) ((4 + (b) * 2 + (h)) * HTB)
#define PG8_STAGE(bufoff, gbase, voff) do { _Pragma("unroll") for (int _i = 0; _i < 2; ++_i) \
        __builtin_amdgcn_global_load_lds((const unsigned*)((const char*)(gbase) + (voff)[_i]), (LAS unsigned*)(lds + (bufoff) + ldsw + _i * 8192), 16, 0, 0); } while (0)
#define PG8_LDA(dst, b, h) do { _Pragma("unroll") for (int m = 0; m < 4; ++m) _Pragma("unroll") for (int k = 0; k < 2; ++k) dst[m][k] = *(const LAS bf16x8*)(lds + PG8_SA(b, h) + aoff + m * 2048 + k * 1024); } while (0)
#define PG8_LDB(dst, b, h) do { _Pragma("unroll") for (int n = 0; n < 2; ++n) _Pragma("unroll") for (int k = 0; k < 2; ++k) dst[n][k] = *(const LAS bf16x8*)(lds + PG8_SB(b, h) + boff + n * 2048 + k * 1024); } while (0)
#define PG8_MMA(ai, bj, At, Bt_) do { __builtin_amdgcn_s_setprio(1); _Pragma("unroll") for (int m = 0; m < 4; ++m) _Pragma("unroll") for (int n = 0; n < 2; ++n) _Pragma("unroll") for (int k = 0; k < 2; ++k) \
        acc[ai][bj][m][n] = __builtin_amdgcn_mfma_f32_16x16x32_bf16(Bt_[n][k], At[m][k], acc[ai][bj][m][n], 0, 0, 0); __builtin_amdgcn_s_setprio(0); } while (0)
#define PG8_WAIT_V(n) asm volatile("s_waitcnt vmcnt(" #n ")" ::: "memory")
#define PG8_WAIT_L(n) asm volatile("s_waitcnt lgkmcnt(" #n ")" ::: "memory")
#define PG8_BAR __builtin_amdgcn_s_barrier()
#define PG8_SCHED __builtin_amdgcn_sched_barrier(0)
    Unit cur, nxt; int ui = 0;
    if (!S.next(0, cur)) return;
    f32x4 acc[2][2][4][2];
#pragma unroll
    for (int a = 0; a < 2; ++a)
#pragma unroll
        for (int b = 0; b < 2; ++b)
#pragma unroll
            for (int m = 0; m < 4; ++m)
#pragma unroll
                for (int n = 0; n < 2; ++n) acc[a][b][m][n] = (f32x4){0.f, 0.f, 0.f, 0.f};
    bf16x8 At[4][2], B0[2][2], B1[2][2];
    const char* cA = (const char*)A + (size_t)cur.pm * tstepA; const char* cB = (const char*)Bt + (size_t)cur.pn * tstepB;
    PG8_STAGE(PG8_SB(0, 0), cB, voffB); PG8_STAGE(PG8_SA(0, 0), cA, voffA); PG8_STAGE(PG8_SB(0, 1), cB + hstepB, voffB); PG8_STAGE(PG8_SA(0, 1), cA + hstepA, voffA);
    if (wr == 1) PG8_BAR;
    PG8_WAIT_V(4); PG8_BAR;
    PG8_STAGE(PG8_SB(1, 0), cB + kstep, voffB); PG8_STAGE(PG8_SA(1, 0), cA + kstep, voffA); PG8_STAGE(PG8_SB(1, 1), cB + hstepB + kstep, voffB);
    PG8_WAIT_V(6); PG8_BAR;
    for (;;) {
        const bool has_next = S.next(ui + 1, nxt);
        const char* nA = has_next ? (const char*)A + (size_t)nxt.pm * tstepA : cA; const char* nB = has_next ? (const char*)Bt + (size_t)nxt.pn * tstepB : cB;
        for (int t = 0; t < nt; t += 2) {
            const bool last = (t == nt - 2);
            const char* a1 = cA + (size_t)(t + 1) * kstep;
            const char* a2 = last ? nA : cA + (size_t)(t + 2) * kstep; const char* b2 = last ? nB : cB + (size_t)(t + 2) * kstep;
            const char* a3 = a2 + kstep; const char* b3 = b2 + kstep;
            PG8_LDB(B0, 0, 0); PG8_SCHED; PG8_LDA(At, 0, 0); PG8_STAGE(PG8_SA(1, 1), a1 + hstepA, voffA);
            PG8_WAIT_L(8); PG8_BAR; PG8_WAIT_L(0); PG8_MMA(0, 0, At, B0); PG8_BAR; PG8_SCHED;
            PG8_LDB(B1, 0, 1); PG8_STAGE(PG8_SB(0, 0), b2, voffB);
            PG8_BAR; PG8_WAIT_L(0); PG8_MMA(0, 1, At, B1); PG8_BAR;
            PG8_LDA(At, 0, 1); PG8_STAGE(PG8_SA(0, 0), a2, voffA);
            PG8_BAR; PG8_WAIT_L(0); PG8_MMA(1, 0, At, B0); PG8_BAR; PG8_SCHED;
            PG8_STAGE(PG8_SB(0, 1), b2 + hstepB, voffB);
            PG8_WAIT_V(6); PG8_BAR; PG8_MMA(1, 1, At, B1); PG8_BAR;
            PG8_LDB(B0, 1, 0); PG8_SCHED; PG8_LDA(At, 1, 0); PG8_STAGE(PG8_SA(0, 1), a2 + hstepA, voffA);
            PG8_WAIT_L(8); PG8_BAR; PG8_WAIT_L(0); PG8_MMA(0, 0, At, B0); PG8_BAR; PG8_SCHED;
            PG8_LDB(B1, 1, 1); PG8_STAGE(PG8_SB(1, 0), b3, voffB);
            PG8_BAR; PG8_WAIT_L(0); PG8_MMA(0, 1, At, B1); PG8_BAR;
            PG8_LDA(At, 1, 1); PG8_STAGE(PG8_SA(1, 0), a3, voffA);
            PG8_BAR; PG8_WAIT_L(0); PG8_MMA(1, 0, At, B0); PG8_BAR; PG8_SCHED;
            PG8_STAGE(PG8_SB(1, 1), b3 + hstepB, voffB);
            PG8_WAIT_V(6); PG8_BAR; PG8_MMA(1, 1, At, B1); PG8_BAR;
        }
        E(acc, cur, wr, wc, fr, fq);
        if (!has_next) break;
#pragma unroll
        for (int a = 0; a < 2; ++a)
#pragma unroll
            for (int b = 0; b < 2; ++b)
#pragma unroll
                for (int m = 0; m < 4; ++m)
#pragma unroll
                    for (int n = 0; n < 2; ++n) acc[a][b][m][n] = (f32x4){0.f, 0.f, 0.f, 0.f};
        cur = nxt; cA = nA; cB = nB; ++ui;
    }
    PG8_WAIT_V(0);
    if (wr == 0) PG8_BAR;
    PG8_BAR;
#undef PG8_SA
#undef PG8_SB
#undef PG8_STAGE
#undef PG8_LDA
#undef PG8_LDB
#undef PG8_MMA
#undef PG8_WAIT_V
#undef PG8_WAIT_L
#undef PG8_BAR
#undef PG8_SCHED
}
}
using pg8::Unit;

struct EpiInProj {
    bf16_t* proj; float* misc; const float* cosA; const float* sinA; const float* cosI; const float* sinI; bf16_t* vt;
    __device__ __forceinline__ void operator()(const f32x4 (&acc)[2][2][4][2], const Unit& u, int wr, int wc, int fr, int fq) const {
        const int pn = u.pn, row0 = u.pm * 256 + wr * 64 + fr;
        const bool is_misc = (pn == 8), is_sig = (pn >= 29);
#pragma unroll
        for (int ai = 0; ai < 2; ++ai)
#pragma unroll
            for (int m = 0; m < 4; ++m) {
                const int r = row0 + ai * 128 + m * 16, pos = r & (SEQ - 1);
#pragma unroll
                for (int bj = 0; bj < 2; ++bj) {
                    int kind = 0;
                    if (pn <= 4) kind = (wc == 0) ? 1 : 0;
                    else if (pn == 6 || pn == 7) kind = (((wc & 1) == 0) && fq < 2) ? 2 : 0;
                    else if (pn == 8) kind = (bj == 0 && wc == 0 && fq < 2) ? 2 : 0;
                    f32x4 c4 = (f32x4){1.f, 1.f, 1.f, 1.f}, s4 = (f32x4){0.f, 0.f, 0.f, 0.f};
                    if (kind == 1) { c4 = *(const f32x4*)(cosA + pos * 16 + 4 * fq); s4 = *(const f32x4*)(sinA + pos * 16 + 4 * fq); }
                    else if (kind == 2) { c4 = *(const f32x4*)(cosI + pos * 8 + 4 * fq); s4 = *(const f32x4*)(sinI + pos * 8 + 4 * fq); }
                    const f32x4 v0 = acc[ai][bj][m][0], v1 = acc[ai][bj][m][1];
                    f32x4 o0 = v0 * c4 - v1 * s4, o1 = v1 * c4 + v0 * s4;
                    if (is_sig) {
#pragma unroll
                        for (int j = 0; j < 4; ++j) { o0[j] = sigmoid_f(o0[j]); o1[j] = sigmoid_f(o1[j]); }
                    }
                    const int cc = bj * 128 + wc * 32 + 4 * fq;
                    if (is_misc) {
                        float* mp = misc + (size_t)r * 256 + cc;
                        *(f32x4*)mp = o0; *(f32x4*)(mp + 16) = o1;
                        if (bj == 0 && wc < 2) {
                            bf16_t* pp = proj + (size_t)r * NP + C_MISC + cc;
                            u32x2 w0, w1; w0.x = pg8::cvt_pk_bf16(o0[0], o0[1]); w0.y = pg8::cvt_pk_bf16(o0[2], o0[3]); w1.x = pg8::cvt_pk_bf16(o1[0], o1[1]); w1.y = pg8::cvt_pk_bf16(o1[2], o1[3]);
                            *(u32x2*)pp = w0; *(u32x2*)(pp + 16) = w1;
                        }
                    } else {
                        if (pn == 5) {
                            bf16_t* vp = vt + ((size_t)((r >> 12) * 2 + bj) * 128 + wc * 32 + 4 * fq) * SEQ + pos;
#pragma unroll
                            for (int j = 0; j < 4; ++j) { vp[(size_t)j * SEQ] = f2bf(o0[j]); vp[(size_t)(16 + j) * SEQ] = f2bf(o1[j]); }
                        }
                        bf16_t* pp = proj + (size_t)r * NP + pn * 256 + cc;
                        u32x2 w0, w1; w0.x = pg8::cvt_pk_bf16(o0[0], o0[1]); w0.y = pg8::cvt_pk_bf16(o0[2], o0[3]); w1.x = pg8::cvt_pk_bf16(o1[0], o1[1]); w1.y = pg8::cvt_pk_bf16(o1[2], o1[3]);
                        *(u32x2*)pp = w0; *(u32x2*)(pp + 16) = w1;
                    }
                }
            }
    }
};
struct EpiGateA {
    bf16_t* proj;
    __device__ __forceinline__ void operator()(const f32x4 (&acc)[2][2][4][2], const Unit& u, int wr, int wc, int fr, int fq) const {
        const int row0 = u.pm * 256 + wr * 64 + fr, col0 = u.pn * 256 + wc * 32 + 4 * fq;
#pragma unroll
        for (int ai = 0; ai < 2; ++ai)
#pragma unroll
            for (int m = 0; m < 4; ++m)
#pragma unroll
                for (int bj = 0; bj < 2; ++bj)
#pragma unroll
                    for (int n = 0; n < 2; ++n) {
                        bf16_t* pp = proj + (size_t)(row0 + ai * 128 + m * 16) * NP + C_GA + col0 + bj * 128 + n * 16;
                        const u32x2 g = *(const u32x2*)pp; const f32x4 a = acc[ai][bj][m][n];
                        u32x2 w; w.x = pg8::cvt_pk_bf16(lo16(g.x) * a[0], hi16(g.x) * a[1]); w.y = pg8::cvt_pk_bf16(lo16(g.y) * a[2], hi16(g.y) * a[3]);
                        *(u32x2*)pp = w;
                    }
    }
};
struct EpiGateS {
    bf16_t* proj;
    __device__ __forceinline__ void operator()(const f32x4 (&acc)[2][2][4][2], const Unit& u, int wr, int wc, int fr, int fq) const {
        const int row0 = u.pm * 256 + wr * 64 + fr, col0 = u.pn * 256 + wc * 32 + 4 * fq;
#pragma unroll
        for (int ai = 0; ai < 2; ++ai)
#pragma unroll
            for (int m = 0; m < 4; ++m)
#pragma unroll
                for (int bj = 0; bj < 2; ++bj)
#pragma unroll
                    for (int n = 0; n < 2; ++n) {
                        bf16_t* pa = proj + (size_t)(row0 + ai * 128 + m * 16) * NP + C_GA + col0 + bj * 128 + n * 16;
                        bf16_t* ps = pa + (C_GS - C_GA);
                        const u32x2 m1 = *(const u32x2*)pa; const u32x2 g = *(const u32x2*)ps; const f32x4 a = acc[ai][bj][m][n];
                        u32x2 w; w.x = pg8::cvt_pk_bf16(lo16(m1.x) + lo16(g.x) * a[0], hi16(m1.x) + hi16(g.x) * a[1]);
                        w.y = pg8::cvt_pk_bf16(lo16(m1.y) + lo16(g.y) * a[2], hi16(m1.y) + hi16(g.y) * a[3]);
                        *(u32x2*)ps = w;
                    }
    }
};
struct EpiResid {
    const float* xin; float* xout;
    __device__ __forceinline__ void operator()(const f32x4 (&acc)[2][2][4][2], const Unit& u, int wr, int wc, int fr, int fq) const {
        const int row0 = u.pm * 256 + wr * 64 + fr, col0 = u.pn * 256 + wc * 32 + 4 * fq;
#pragma unroll
        for (int ai = 0; ai < 2; ++ai)
#pragma unroll
            for (int m = 0; m < 4; ++m)
#pragma unroll
                for (int bj = 0; bj < 2; ++bj)
#pragma unroll
                    for (int n = 0; n < 2; ++n) {
                        const size_t off = (size_t)(row0 + ai * 128 + m * 16) * 1024 + col0 + bj * 128 + n * 16;
                        *(f32x4*)(xout + off) = *(const f32x4*)(xin + off) + acc[ai][bj][m][n];
                    }
    }
};
struct EpiBf16 {
    bf16_t* O; int ldc;
    __device__ __forceinline__ void operator()(const f32x4 (&acc)[2][2][4][2], const Unit& u, int wr, int wc, int fr, int fq) const {
        const int row0 = u.pm * 256 + wr * 64 + fr, col0 = u.pn * 256 + wc * 32 + 4 * fq;
#pragma unroll
        for (int ai = 0; ai < 2; ++ai)
#pragma unroll
            for (int m = 0; m < 4; ++m)
#pragma unroll
                for (int bj = 0; bj < 2; ++bj)
#pragma unroll
                    for (int n = 0; n < 2; ++n) {
                        const f32x4 a = acc[ai][bj][m][n];
                        u32x2 w; w.x = pg8::cvt_pk_bf16(a[0], a[1]); w.y = pg8::cvt_pk_bf16(a[2], a[3]);
                        *(u32x2*)(O + (size_t)(row0 + ai * 128 + m * 16) * ldc + col0 + bj * 128 + n * 16) = w;
                    }
    }
};

template <int MODE>
__device__ __forceinline__ void convT(int wv, const float* src, int K, int Nsrc, bf16_t* dst, int Ndst, const float* kscale, float* tile) {
    const int tid = opaque_tid(wv), kt = K / 64, ntiles = (Ndst / 64) * kt;
    for (int ti = blockIdx.x; ti < ntiles; ti += gridDim.x) {
        const int n0 = (ti / kt) * 64, k0 = (ti % kt) * 64;
        {
            const int nn = tid & 63; const int n = n0 + nn; const int ns = MODE ? inproj_map(n) : n;
#pragma unroll
            for (int i = 0; i < 8; ++i) {
                const int kk = (tid >> 6) + 8 * i;
                float v = (ns >= 0) ? src[(size_t)(k0 + kk) * Nsrc + ns] : 0.f;
                if (kscale) v *= kscale[k0 + kk];
                tile[nn * 65 + kk] = v;
            }
        }
        __syncthreads();
        {
            const int kk = tid & 63;
#pragma unroll
            for (int i = 0; i < 8; ++i) { const int nn = (tid >> 6) + 8 * i; dst[(size_t)(n0 + nn) * K + k0 + kk] = f2bf(tile[nn * 65 + kk]); }
        }
        __syncthreads();
    }
}

__device__ __forceinline__ void phase_convert(int wv, KParams p, float* tile) {
    for (int l = 0; l < DEPTH; ++l) {
        unsigned char* wl = p->ws + OFF_W + (size_t)l * SZ_WL;
        bf16_t* win = (bf16_t*)wl; bf16_t* wpa = (bf16_t*)(wl + SZ_WIN); bf16_t* wps = (bf16_t*)(wl + SZ_WIN + SZ_WPA);
        bf16_t* wo = (bf16_t*)(wl + SZ_WIN + SZ_WPA + SZ_WPS); bf16_t* wup = (bf16_t*)(wl + SZ_WIN + SZ_WPA + SZ_WPS + SZ_WO); bf16_t* wdn = (bf16_t*)(wl + SZ_WIN + SZ_WPA + SZ_WPS + SZ_WO + SZ_WUP);
        convT<1>(wv, p->w_in + (size_t)l * 1024 * IN_COLS, 1024, IN_COLS, win, NP, nullptr, tile);
        convT<0>(wv, p->w_proj_attn + (size_t)l * 1024 * 1024, 1024, 1024, wpa, 1024, nullptr, tile);
        convT<0>(wv, p->w_proj_ssd + (size_t)l * 2048 * 1024, 2048, 1024, wps, 1024, p->ssd_norm_w + l * 2048, tile);
        convT<0>(wv, p->w_out + (size_t)l * 1024 * 1024, 1024, 1024, wo, 1024, nullptr, tile);
        convT<0>(wv, p->ffn_w_up + (size_t)l * 1024 * FFN2, 1024, FFN2, wup, FFN2, nullptr, tile);
        convT<0>(wv, p->ffn_w_down + (size_t)l * FFN * 1024, FFN, 1024, wdn, 1024, nullptr, tile);
    }
    float* rope = (float*)(p->ws + OFF_ROPE);
    float* cosA = rope; float* sinA = rope + 4096 * 16; float* cosI = rope + 4096 * 32; float* sinI = rope + 4096 * 40;
    for (int i = blockIdx.x * 512 + opaque_tid(wv); i < 4096 * 24; i += gridDim.x * 512) {
        int pos, f; float inv;
        if (i < 4096 * 16) { pos = i >> 4; f = i & 15; inv = p->invA[f]; } else { const int j = i - 4096 * 16; pos = j >> 3; f = j & 7; inv = p->invI[f]; }
        const float ang = (float)pos * inv;
        double rev = (double)ang * 0.15915494309189535; rev -= rint(rev);
        const float c = __builtin_amdgcn_cosf((float)rev), s = __builtin_amdgcn_sinf((float)rev);
        if (i < 4096 * 16) { cosA[pos * 16 + f] = c; sinA[pos * 16 + f] = s; } else { cosI[pos * 8 + f] = c; sinI[pos * 8 + f] = s; }
    }
}

template <bool F32OUT>
__device__ __forceinline__ void phase_norm(int wv, const float* xin, const float* w, bf16_t* hout, float* fout, int nrows) {
    const int tid = opaque_tid(wv); const int wave = tid >> 6, lane = tid & 63;
    for (int row = blockIdx.x * 8 + wave; row < nrows; row += gridDim.x * 8) {
        const f32x4* xr = (const f32x4*)(xin + (size_t)row * 1024);
        f32x4 v[4]; float ss = 0.f;
#pragma unroll
        for (int i = 0; i < 4; ++i) { v[i] = xr[lane + 64 * i]; ss += v[i][0] * v[i][0] + v[i][1] * v[i][1] + v[i][2] * v[i][2] + v[i][3] * v[i][3]; }
        ss = wave_sum(ss);
        const float rstd = rsqrtf(ss * (1.0f / 1024.0f) + EPS);
#pragma unroll
        for (int i = 0; i < 4; ++i) {
            const f32x4 w4 = ((const f32x4*)w)[lane + 64 * i];
            const f32x4 o = v[i] * rstd * w4;
            if (F32OUT) ((f32x4*)(fout + (size_t)row * 1024))[lane + 64 * i] = o;
            else { u32x2 pk; pk.x = pack2(o[0], o[1]); pk.y = pack2(o[2], o[3]); *(u32x2*)(hout + (size_t)row * 1024 + 4 * (lane + 64 * i)) = pk; }
        }
    }
}

__device__ __forceinline__ unsigned fkey(float s) { s += 0.0f; const unsigned u = __float_as_uint(s); return (u & 0x80000000u) ? ~u : (u | 0x80000000u); }

__device__ __forceinline__ void phase_idx_simple(int wv, const bf16_t* proj, const float* misc, unsigned* mask, int* sel, unsigned char* shm) {
    const int tid = opaque_tid(wv); const int wave = tid >> 6, lane = tid & 63;
    float* qs = (float*)(shm + wave * 18432); unsigned* sk = (unsigned*)(shm + wave * 18432 + 2048);
    const unsigned long long lt_mask = (1ull << lane) - 1ull;
    for (int q = blockIdx.x * 8 + wave; q < SLAB; q += gridDim.x * 8) {
        const int bl = q >> 12, t = q & (SEQ - 1), n = t + 1;
        wave_lds_sync();
        {
            const u32x4 raw = *(const u32x4*)(proj + (size_t)q * NP + C_QI + lane * 8);
            f32x4 a, b; a[0] = lo16(raw.x); a[1] = hi16(raw.x); a[2] = lo16(raw.y); a[3] = hi16(raw.y); b[0] = lo16(raw.z); b[1] = hi16(raw.z); b[2] = lo16(raw.w); b[3] = hi16(raw.w);
            *(f32x4*)(qs + lane * 8) = a; *(f32x4*)(qs + lane * 8 + 4) = b;
        }
        float wv[8];
        { const f32x4 w0 = *(const f32x4*)(misc + (size_t)q * 256 + 64), w1 = *(const f32x4*)(misc + (size_t)q * 256 + 68);
#pragma unroll
          for (int j = 0; j < 4; ++j) { wv[j] = w0[j]; wv[4 + j] = w1[j]; } }
        wave_lds_sync();
        const int nr = (n + 63) & ~63;
        for (int s = lane; s < nr; s += 64) {
            if (s < n) {
                const f32x4* kp = (const f32x4*)(misc + (size_t)(bl * SEQ + s) * 256);
                f32x4 kv[16];
#pragma unroll
                for (int i = 0; i < 16; ++i) kv[i] = kp[i];
                float sc = 0.f;
#pragma unroll
                for (int h = 0; h < 8; ++h) {
                    float d = 0.f;
#pragma unroll
                    for (int i = 0; i < 16; ++i) { const f32x4 qv = *(const f32x4*)(qs + h * 64 + i * 4); d += kv[i][0] * qv[0] + kv[i][1] * qv[1] + kv[i][2] * qv[2] + kv[i][3] * qv[3]; }
                    sc += wv[h] * fmaxf(d, 0.f);
                }
                sk[s] = fkey(sc);
            }
        }
        wave_lds_sync();
        unsigned cur = 0u; int need = 1 << 30;
        if (n > 256) {
            for (int bit = 31; bit >= 0; --bit) {
                const unsigned cand = cur | (1u << bit); int cnt = 0;
                for (int s = lane; s < nr; s += 64) { const bool pr = (s < n) && (sk[s] >= cand); cnt += __popcll(__ballot(pr)); }
                if (cnt >= 256) cur = cand;
            }
            int cgt = 0;
            for (int s = lane; s < nr; s += 64) { const bool pr = (s < n) && (sk[s] > cur); cgt += __popcll(__ballot(pr)); }
            need = 256 - cgt;
        }
        int run_eq = 0, run_sel = 0; unsigned long long mybal = 0ull;
        for (int s = lane, c = 0; s < nr; s += 64, ++c) {
            const bool in = s < n; const unsigned k = in ? sk[s] : 0u;
            const bool gt = in && (k > cur), eq = in && (k == cur);
            const unsigned long long beq = __ballot(eq);
            const int rank = run_eq + __popcll(beq & lt_mask);
            const bool se = gt || (eq && rank < need);
            const unsigned long long bs = __ballot(se);
            const int pos = run_sel + __popcll(bs & lt_mask);
            if (se && pos < 256) sel[(size_t)q * 256 + pos] = s;
            run_eq += __popcll(beq); run_sel += __popcll(bs);
            if (lane == c) mybal = bs;
        }
        u32x2 mw; mw.x = (unsigned)mybal; mw.y = (unsigned)(mybal >> 32);
        *(u32x2*)(mask + (size_t)q * 128 + lane * 2) = mw;
        for (int j = run_sel + lane; j < 256; j += 64) sel[(size_t)q * 256 + j] = -1;
    }
}

__device__ __forceinline__ void phase_att_simple(int wv, bf16_t* proj, const int* sel, unsigned char* shm) {
    const int tid = opaque_tid(wv); const int wave = tid >> 6, lane = tid & 63, h = wave, kvh = h >> 2;
    float* qf = (float*)(shm + wave * 2560); float* pj = qf + 128; int* kj = (int*)(pj + 256);
    const float scale = 0.08838834764831845f;
    for (int q = blockIdx.x; q < SLAB; q += gridDim.x) {
        const int bl = q >> 12;
        wave_lds_sync();
        { const unsigned raw = *(const unsigned*)(proj + (size_t)q * NP + C_Q + h * 128 + 2 * lane); qf[2 * lane] = lo16(raw); qf[2 * lane + 1] = hi16(raw); }
        int keys[4];
#pragma unroll
        for (int i = 0; i < 4; ++i) { keys[i] = sel[(size_t)q * 256 + lane + 64 * i]; kj[lane + 64 * i] = keys[i]; }
        wave_lds_sync();
        float lg[4]; float mx = -INFINITY;
#pragma unroll
        for (int i = 0; i < 4; ++i) {
            lg[i] = -INFINITY;
            if (keys[i] >= 0) {
                const u32x4* kp = (const u32x4*)(proj + (size_t)(bl * SEQ + keys[i]) * NP + C_K + kvh * 128);
                float d = 0.f;
#pragma unroll
                for (int c = 0; c < 16; ++c) {
                    const u32x4 raw = kp[c]; const f32x4 q0 = *(const f32x4*)(qf + c * 8), q1 = *(const f32x4*)(qf + c * 8 + 4);
                    d += lo16(raw.x) * q0[0] + hi16(raw.x) * q0[1] + lo16(raw.y) * q0[2] + hi16(raw.y) * q0[3] + lo16(raw.z) * q1[0] + hi16(raw.z) * q1[1] + lo16(raw.w) * q1[2] + hi16(raw.w) * q1[3];
                }
                lg[i] = d * scale;
            }
            mx = fmaxf(mx, lg[i]);
        }
        mx = wave_max(mx);
        float sm = 0.f; float pe[4];
#pragma unroll
        for (int i = 0; i < 4; ++i) { pe[i] = (keys[i] >= 0) ? __expf(lg[i] - mx) : 0.f; sm += pe[i]; }
        sm = wave_sum(sm);
        const float inv = 1.0f / sm;
#pragma unroll
        for (int i = 0; i < 4; ++i) pj[lane + 64 * i] = pe[i] * inv;
        wave_lds_sync();
        float a0 = 0.f, a1 = 0.f;
        const bf16_t* vb = proj + (size_t)(bl * SEQ) * NP + C_V + kvh * 128 + 2 * lane;
        for (int j0 = 0; j0 < 256; j0 += 16) {
            if (kj[j0] < 0) break;
            unsigned raw[16]; float pv[16];
#pragma unroll
            for (int u = 0; u < 16; ++u) { const int key = max(kj[j0 + u], 0); pv[u] = pj[j0 + u]; raw[u] = *(const unsigned*)(vb + (size_t)key * NP); }
#pragma unroll
            for (int u = 0; u < 16; ++u) { a0 += pv[u] * lo16(raw[u]); a1 += pv[u] * hi16(raw[u]); }
        }
        *(unsigned*)(proj + (size_t)q * NP + C_Q + h * 128 + 2 * lane) = pack2(a0, a1);
    }
}


typedef short bf16x4 __attribute__((ext_vector_type(4)));
__device__ __forceinline__ void phase_idx(int wv, const bf16_t* proj, const float* misc, unsigned* mask, unsigned char* shm) {
    const int tid = opaque_tid(wv), wave = __builtin_amdgcn_readfirstlane(tid >> 6), lane = tid & 63, fr = lane & 15, fq = lane >> 4;
    int* cntbuf = (int*)shm;
    int* cbuf2 = cntbuf + 256;
    for (int it = blockIdx.x; it < 256; it += gridDim.x) {
        for (int pass = 0; pass < 4; ++pass) {
            const int i = (pass == 0) ? it : (pass == 1) ? 511 - it : (pass == 2) ? 512 + it : 1023 - it;
            const int qt = 255 - (i >> 2), bl = i & 3;
            const int q0 = qt * 16, nch = (q0 + 15) / 64 + 1, t = q0 + fr;
            const size_t qrow = (size_t)bl * SEQ + q0 + fr;
            int lb = wave * 64 + fq * 4; asm volatile("" : "+v"(lb));
            u32x4 key[4][4];
            u32x4* klds = (u32x4*)(shm + 18688) + tid;
#define KGET(dst, ip, tt) do { if ((ip) < 4) dst = key[(ip) < 4 ? (ip) : 0][tt]; else dst = klds[(((ip) - 4) * 4 + (tt)) * 512]; } while (0)
            {
                float wv[8];
                { const f32x4 w0 = *(const f32x4*)(misc + qrow * 256 + 64), w1 = *(const f32x4*)(misc + qrow * 256 + 68);
#pragma unroll
                  for (int j = 0; j < 4; ++j) { wv[j] = w0[j]; wv[4 + j] = w1[j]; } }
#pragma unroll
                for (int u = 0; u < 2; ++u) { const int ch = tid + 512 * u, r = ch >> 6, cc = ch & 63;
                    *(u32x4*)(shm + 2048 + r * 1040 + cc * 16) = *(const u32x4*)(proj + ((size_t)bl * SEQ + q0 + r) * NP + C_QI + cc * 8); }
                __syncthreads();
                const unsigned char* ql = shm + 2048 + fr * 1040 + fq * 16;
#pragma unroll
                for (int ip = 0; ip < 8; ++ip) {
                    int c = wave + 8 * ip; asm volatile("" : "+s"(c));
                    if (c < nch) {
                        const int trel = t - (c - wave) * 64 - lb;
                        const bf16_t* kp0 = proj + ((size_t)bl * SEQ + c * 64 + fr) * NP + C_MISC + fq * 8;
#pragma unroll
                        for (int tp = 0; tp < 2; ++tp) {
                            bf16x8 kf[2][2];
#pragma unroll
                            for (int u = 0; u < 2; ++u) { const bf16_t* kp = kp0 + (size_t)((tp * 2 + u) * 16) * NP; kf[u][0] = *(const bf16x8*)kp; kf[u][1] = *(const bf16x8*)(kp + 32); }
                            f32x4 sc[2];
                            sc[0] = (f32x4){0.f, 0.f, 0.f, 0.f}; sc[1] = (f32x4){0.f, 0.f, 0.f, 0.f};
#pragma unroll
                            for (int h = 0; h < 8; ++h) {
                                const bf16x8 q0f = *(const bf16x8*)(ql + h * 128), q1f = *(const bf16x8*)(ql + h * 128 + 64);
#pragma unroll
                                for (int u = 0; u < 2; ++u) {
                                    f32x4 d = __builtin_amdgcn_mfma_f32_16x16x32_bf16(kf[u][0], q0f, (f32x4){0.f, 0.f, 0.f, 0.f}, 0, 0, 0);
                                    d = __builtin_amdgcn_mfma_f32_16x16x32_bf16(kf[u][1], q1f, d, 0, 0, 0);
#pragma unroll
                                    for (int j = 0; j < 4; ++j) sc[u][j] += wv[h] * fmaxf(d[j], 0.f);
                                }
                                if ((h & 3) == 3) asm volatile("" ::: "memory");
                            }
#pragma unroll
                            for (int u = 0; u < 2; ++u) {
                                u32x4 kk;
#pragma unroll
                                for (int j = 0; j < 4; ++j) kk[j] = ((tp * 2 + u) * 16 + j <= trel) ? fkey(sc[u][j]) : 0u;
                                if (ip < 4) key[ip < 4 ? ip : 0][tp * 2 + u] = kk; else klds[((ip - 4) * 4 + tp * 2 + u) * 512] = kk;
                            }
                        }
                    } else if (ip < 4) {
#pragma unroll
                        for (int tt = 0; tt < 4; ++tt) key[ip < 4 ? ip : 0][tt] = (u32x4){0u, 0u, 0u, 0u};
                    }
                    asm volatile("" ::: "memory");
                }
            }
            __syncthreads();
            unsigned cur = 0u;
            for (int bit = 31; bit >= 0; --bit) {
                const unsigned cand = cur | (1u << bit);
                int cnt = 0;
#pragma unroll
                for (int ip = 0; ip < 8; ++ip)
                    if (wave + 8 * ip < nch) {
#pragma unroll
                        for (int tt = 0; tt < 4; ++tt) { u32x4 kv; KGET(kv, ip, tt);
#pragma unroll
                            for (int j = 0; j < 4; ++j) cnt += (kv[j] >= cand) ? 1 : 0; }
                    }
                cnt += __shfl_xor(cnt, 16); cnt += __shfl_xor(cnt, 32);
                int* cb = cntbuf + (bit & 1) * 128;
                if (fq == 0) cb[fr * 8 + wave] = cnt;
                __syncthreads();
                const int4 a = *(const int4*)(cb + fr * 8), b = *(const int4*)(cb + fr * 8 + 4);
                const int tot = a.x + a.y + a.z + a.w + b.x + b.y + b.z + b.w;
                if (tot >= 256) cur = cand;
            }
            int cg = 0, ce = 0;
#pragma unroll
            for (int ip = 0; ip < 8; ++ip)
                if (wave + 8 * ip < nch) {
#pragma unroll
                    for (int tt = 0; tt < 4; ++tt) { u32x4 kv; KGET(kv, ip, tt);
#pragma unroll
                        for (int j = 0; j < 4; ++j) { cg += (kv[j] > cur) ? 1 : 0; ce += (kv[j] == cur) ? 1 : 0; } }
                }
            cg += __shfl_xor(cg, 16); cg += __shfl_xor(cg, 32); ce += __shfl_xor(ce, 16); ce += __shfl_xor(ce, 32);
            if (fq == 0) { cbuf2[fr * 8 + wave] = cg; cbuf2[128 + fr * 8 + wave] = ce; }
            __syncthreads();
            int need, ceq;
            { const int4 a = *(const int4*)(cbuf2 + fr * 8), b = *(const int4*)(cbuf2 + fr * 8 + 4);
              need = 256 - (a.x + a.y + a.z + a.w + b.x + b.y + b.z + b.w);
              const int4 c4 = *(const int4*)(cbuf2 + 128 + fr * 8), d4 = *(const int4*)(cbuf2 + 128 + fr * 8 + 4);
              ceq = c4.x + c4.y + c4.z + c4.w + d4.x + d4.y + d4.z + d4.w; }
            const bool ties = (cur != 0u) && (ceq > need);
            unsigned J = 4095u;
            if (__syncthreads_or(ties ? 1 : 0)) {
                unsigned Jt = 0u;
                for (int bit = 11; bit >= 0; --bit) {
                    const unsigned cand = Jt | (1u << bit);
                    const int crel = (int)cand - lb;
                    int cnt = 0;
#pragma unroll
                    for (int ip = 0; ip < 8; ++ip)
                        if (wave + 8 * ip < nch) {
#pragma unroll
                            for (int tt = 0; tt < 4; ++tt) { u32x4 kv; KGET(kv, ip, tt);
#pragma unroll
                                for (int j = 0; j < 4; ++j) cnt += (kv[j] == cur && (ip * 512 + tt * 16 + j) < crel) ? 1 : 0; }
                        }
                    cnt += __shfl_xor(cnt, 16); cnt += __shfl_xor(cnt, 32);
                    int* cb = cntbuf + (bit & 1) * 128;
                    if (fq == 0) cb[fr * 8 + wave] = cnt;
                    __syncthreads();
                    const int4 a = *(const int4*)(cb + fr * 8), b = *(const int4*)(cb + fr * 8 + 4);
                    const int tot = a.x + a.y + a.z + a.w + b.x + b.y + b.z + b.w;
                    if (tot < need) Jt = cand;
                }
                if (ties) J = Jt;
            }
#pragma unroll
            for (int ip = 0; ip < 8; ++ip) {
                const int c = wave + 8 * ip;
                if (c < nch) {
                    unsigned lo = 0u, hi = 0u;
                    const int jrel = (int)J - lb;
#pragma unroll
                    for (int tt = 0; tt < 4; ++tt) { u32x4 kv; KGET(kv, ip, tt);
#pragma unroll
                        for (int j = 0; j < 4; ++j) {
                            const unsigned k = kv[j];
                            const bool se = (k > cur) || (k == cur && cur != 0u && (ip * 512 + tt * 16 + j) <= jrel);
                            const unsigned b = se ? 1u : 0u;
                            if (tt < 2) lo |= b << (tt * 16 + j); else hi |= b << ((tt - 2) * 16 + j);
                        } }
                    lo <<= (lb & 15); hi <<= (lb & 15);
                    lo |= __shfl_xor(lo, 16); lo |= __shfl_xor(lo, 32); hi |= __shfl_xor(hi, 16); hi |= __shfl_xor(hi, 32);
                    if (fq == 0) { u32x2 mw; mw.x = lo; mw.y = hi; *(u32x2*)(mask + qrow * 128 + c * 2) = mw; }
                }
            }
            __syncthreads();
        }
    }
#undef KGET
}

__device__ __forceinline__ void phase_att(int wv, bf16_t* proj, const bf16_t* vt, const unsigned* mask, unsigned char* shm) {
    const int tid = opaque_tid(wv), wave = tid >> 6, lane = tid & 63, fr = lane & 15, fq = lane >> 4;
    const int qs = wave & 3, hp = wave >> 2;
    constexpr int KROW = 272, VROW = 144, KBYTES = 64 * KROW, VBYTES = 128 * VROW, BUF = KBYTES + VBYTES;
    const float sc2 = 0.08838834764831845f * 1.4426950408889634f;
    for (int it = blockIdx.x; it < 256; it += gridDim.x) {
        for (int pass = 0; pass < 2; ++pass) {
            const int i = (pass == 0) ? it : 511 - it;
            const int qb = 63 - (i >> 3), sub = i & 7, bl = sub >> 1, kvh = sub & 1, nkt = qb + 1;
            const size_t qrow = (size_t)bl * SEQ + qb * 64 + qs * 16 + fr;
            bf16x8 qf[2][4];
#pragma unroll
            for (int hh = 0; hh < 2; ++hh)
#pragma unroll
                for (int ks = 0; ks < 4; ++ks) qf[hh][ks] = *(const bf16x8*)(proj + qrow * NP + C_Q + (kvh * 4 + hp * 2 + hh) * 128 + ks * 32 + fq * 8);
            f32x4 o[2][8];
#pragma unroll
            for (int hh = 0; hh < 2; ++hh)
#pragma unroll
                for (int dt = 0; dt < 8; ++dt) o[hh][dt] = (f32x4){0.f, 0.f, 0.f, 0.f};
            float mrow[2] = {-1e30f, -1e30f}, lrow[2] = {0.f, 0.f};
            const int kr0 = tid >> 4, kc = tid & 15;
            const int vr0 = tid >> 3, vc = tid & 7;
            const bf16_t* kg = proj + ((size_t)bl * SEQ + kr0) * NP + C_K + kvh * 128 + kc * 8;
            const bf16_t* vg = vt + ((size_t)(bl * 2 + kvh) * 128 + vr0) * SEQ + vc * 8;
            const int klds = kr0 * KROW + kc * 16, vlds = KBYTES + vr0 * VROW + vc * 16;
            u32x4 kreg[2], vreg[2];
            __syncthreads();
            kreg[0] = *(const u32x4*)kg; kreg[1] = *(const u32x4*)(kg + (size_t)32 * NP);
            vreg[0] = *(const u32x4*)vg; vreg[1] = *(const u32x4*)(vg + (size_t)64 * SEQ);
            *(u32x4*)(shm + klds) = kreg[0]; *(u32x4*)(shm + klds + 32 * KROW) = kreg[1];
            *(u32x4*)(shm + vlds) = vreg[0]; *(u32x4*)(shm + vlds + 64 * VROW) = vreg[1];
            __syncthreads();
            for (int kt = 0; kt < nkt; ++kt) {
                const unsigned char* buf = shm + (kt & 1) * BUF;
                const bool more = (kt + 1 < nkt);
                if (more) {
                    const bf16_t* kg2 = kg + (size_t)(kt + 1) * 64 * NP; const bf16_t* vg2 = vg + (kt + 1) * 64;
                    kreg[0] = *(const u32x4*)kg2; kreg[1] = *(const u32x4*)(kg2 + (size_t)32 * NP);
                    vreg[0] = *(const u32x4*)vg2; vreg[1] = *(const u32x4*)(vg2 + (size_t)64 * SEQ);
                }
                const u32x2 mk = *(const u32x2*)(mask + qrow * 128 + kt * 2);
                const unsigned mlo = mk.x >> (fq * 4), mhi = mk.y >> (fq * 4);
                f32x4 s[2][4];
#pragma unroll
                for (int nt = 0; nt < 4; ++nt) {
                    s[0][nt] = (f32x4){0.f, 0.f, 0.f, 0.f}; s[1][nt] = (f32x4){0.f, 0.f, 0.f, 0.f};
#pragma unroll
                    for (int ks = 0; ks < 4; ++ks) {
                        const bf16x8 kf = *(const bf16x8*)(buf + (nt * 16 + fr) * KROW + (ks * 32 + fq * 8) * 2);
                        s[0][nt] = __builtin_amdgcn_mfma_f32_16x16x32_bf16(kf, qf[0][ks], s[0][nt], 0, 0, 0);
                        s[1][nt] = __builtin_amdgcn_mfma_f32_16x16x32_bf16(kf, qf[1][ks], s[1][nt], 0, 0, 0);
                    }
                }
                bf16x8 pf[2][2];
#pragma unroll
                for (int hh = 0; hh < 2; ++hh) {
                    float mx = -1e30f;
#pragma unroll
                    for (int nt = 0; nt < 4; ++nt)
#pragma unroll
                        for (int j = 0; j < 4; ++j) {
                            const unsigned w = (nt < 2) ? mlo : mhi; const bool se = (w >> ((nt & 1) * 16 + j)) & 1u;
                            const float tv = s[hh][nt][j] * sc2; s[hh][nt][j] = tv;
                            mx = fmaxf(mx, se ? tv : -1e30f);
                        }
                    mx = fmaxf(mx, __shfl_xor(mx, 16)); mx = fmaxf(mx, __shfl_xor(mx, 32));
                    const float mnew = fmaxf(mrow[hh], mx);
                    const float alpha = __builtin_amdgcn_exp2f(mrow[hh] - mnew);
                    mrow[hh] = mnew;
                    float ls = 0.f;
#pragma unroll
                    for (int nt = 0; nt < 4; ++nt)
#pragma unroll
                        for (int j = 0; j < 4; ++j) {
                            const unsigned w = (nt < 2) ? mlo : mhi; const bool se = (w >> ((nt & 1) * 16 + j)) & 1u;
                            const float pv = se ? __builtin_amdgcn_exp2f(s[hh][nt][j] - mnew) : 0.f;
                            s[hh][nt][j] = pv; ls += pv;
                        }
                    lrow[hh] = lrow[hh] * alpha + ls;
#pragma unroll
                    for (int dt = 0; dt < 8; ++dt) o[hh][dt] *= alpha;
#pragma unroll
                    for (int kk = 0; kk < 2; ++kk) {
                        u32x4 pk;
                        pk.x = pg8::cvt_pk_bf16(s[hh][2 * kk][0], s[hh][2 * kk][1]); pk.y = pg8::cvt_pk_bf16(s[hh][2 * kk][2], s[hh][2 * kk][3]);
                        pk.z = pg8::cvt_pk_bf16(s[hh][2 * kk + 1][0], s[hh][2 * kk + 1][1]); pk.w = pg8::cvt_pk_bf16(s[hh][2 * kk + 1][2], s[hh][2 * kk + 1][3]);
                        pf[hh][kk] = __builtin_bit_cast(bf16x8, pk);
                    }
                }
#pragma unroll
                for (int kk = 0; kk < 2; ++kk)
#pragma unroll
                    for (int dt = 0; dt < 8; ++dt) {
                        const unsigned char* vp = buf + KBYTES + (dt * 16 + fr) * VROW + (kk * 32 + fq * 4) * 2;
                        const bf16x4 v0 = *(const bf16x4*)vp, v1 = *(const bf16x4*)(vp + 32);
                        const bf16x8 vf = __builtin_shufflevector(v0, v1, 0, 1, 2, 3, 4, 5, 6, 7);
                        o[0][dt] = __builtin_amdgcn_mfma_f32_16x16x32_bf16(vf, pf[0][kk], o[0][dt], 0, 0, 0);
                        o[1][dt] = __builtin_amdgcn_mfma_f32_16x16x32_bf16(vf, pf[1][kk], o[1][dt], 0, 0, 0);
                    }
                if (more) {
                    unsigned char* nb = shm + ((kt + 1) & 1) * BUF;
                    *(u32x4*)(nb + klds) = kreg[0]; *(u32x4*)(nb + klds + 32 * KROW) = kreg[1];
                    *(u32x4*)(nb + vlds) = vreg[0]; *(u32x4*)(nb + vlds + 64 * VROW) = vreg[1];
                }
                __syncthreads();
            }
#pragma unroll
            for (int hh = 0; hh < 2; ++hh) {
                float lt = lrow[hh]; lt += __shfl_xor(lt, 16); lt += __shfl_xor(lt, 32);
                const float inv = 1.0f / lt;
                bf16_t* op = proj + qrow * NP + C_Q + (kvh * 4 + hp * 2 + hh) * 128 + fq * 4;
#pragma unroll
                for (int dt = 0; dt < 8; ++dt) {
                    u32x2 w; w.x = pg8::cvt_pk_bf16(o[hh][dt][0] * inv, o[hh][dt][1] * inv); w.y = pg8::cvt_pk_bf16(o[hh][dt][2] * inv, o[hh][dt][3] * inv);
                    *(u32x2*)(op + dt * 16) = w;
                }
            }
        }
    }
}

__device__ __forceinline__ void phase_ssd_simple(int wv, KParams p, int l, bf16_t* proj, const float* misc, float* ssq, unsigned char* shm) {
    const int tid = opaque_tid(wv), lane = tid & 63;
    float* xs = (float*)shm; float* Bs = xs + 64 * 64; float* Cs = Bs + 64 * 128; float* dts = Cs + 64 * 128; float* decs = dts + 64; float* ybuf = decs + 64;
    const float* cw = p->ssd_conv_w + (size_t)l * 4 * 3072; const float* cb = p->ssd_conv_b + (size_t)l * 3072;
    for (int item = blockIdx.x; item < 128; item += gridDim.x) {
        const int bl = item >> 5, head = item & 31, g = head >> 3;
        const float Aneg = -__expf(p->ssd_a_log[l * 32 + head]), dtb = p->ssd_dt_bias[l * 32 + head], Dsk = p->ssd_d[l * 32 + head];
        const int pp = tid >> 3, ng = tid & 7;
        float hs[16];
#pragma unroll
        for (int k = 0; k < 16; ++k) hs[k] = 0.f;
        for (int c = 0; c < 64; ++c) {
            const int t0 = c * 64;
            __syncthreads();
            for (int i = 0; i < 40; ++i) {
                const int idx = tid + 512 * i, tok = idx / 320, cc = idx - tok * 320;
                int ch; float* dstp;
                if (cc < 64) { ch = head * 64 + cc; dstp = xs + tok * 64 + cc; }
                else if (cc < 192) { ch = 2048 + g * 128 + (cc - 64); dstp = Bs + tok * 128 + (cc - 64); }
                else { ch = 2560 + g * 128 + (cc - 192); dstp = Cs + tok * 128 + (cc - 192); }
                float a = cb[ch];
#pragma unroll
                for (int j = 0; j < 4; ++j) { const int tt = t0 + tok - 3 + j; if (tt >= 0) a += cw[j * 3072 + ch] * bf2f(proj[(size_t)(bl * SEQ + tt) * NP + C_XBC + ch]); }
                *dstp = silu_f(a);
            }
            if (tid < 64) {
                const float v = misc[(size_t)(bl * SEQ + t0 + tid) * 256 + 72 + head] + dtb;
                const float dt = (v > 20.f) ? v : log1pf(__expf(v));
                dts[tid] = dt; decs[tid] = __expf(dt * Aneg);
            }
            __syncthreads();
            for (int tok = 0; tok < 64; ++tok) {
                const float xv = xs[tok * 64 + pp], dt = dts[tok], dec = decs[tok], xdt = xv * dt;
                float y = 0.f;
#pragma unroll
                for (int k4 = 0; k4 < 4; ++k4) {
                    const f32x4 b4 = *(const f32x4*)(Bs + tok * 128 + ng * 16 + k4 * 4), c4 = *(const f32x4*)(Cs + tok * 128 + ng * 16 + k4 * 4);
#pragma unroll
                    for (int j = 0; j < 4; ++j) { float& hh = hs[k4 * 4 + j]; hh = hh * dec + xdt * b4[j]; y += c4[j] * hh; }
                }
                y += __shfl_xor(y, 1); y += __shfl_xor(y, 2); y += __shfl_xor(y, 4);
                if (ng == 0) ybuf[tok * 65 + pp] = y + Dsk * xv;
            }
            __syncthreads();
#pragma unroll
            for (int i = 0; i < 8; ++i) {
                const int idx = tid + 512 * i, tok = idx >> 6, p2 = idx & 63;
                bf16_t* zp = proj + (size_t)(bl * SEQ + t0 + tok) * NP + C_Z + head * 64 + p2;
                const float yg = ybuf[tok * 65 + p2] * silu_f(bf2f(*zp));
                *zp = f2bf(yg);
                const float s2 = wave_sum(yg * yg);
                if (lane == 0) ssq[(size_t)(bl * SEQ + t0 + tok) * 32 + head] = s2;
            }
        }
    }
}


__device__ __forceinline__ void phase_ssd(int wv, KParams p, int l, bf16_t* proj, const float* misc, float* ssq, unsigned char* shm) {
    const int tid = opaque_tid(wv), wave = __builtin_amdgcn_readfirstlane(tid >> 6), lane = tid & 63, fr = lane & 15, fq = lane >> 4;
    constexpr int ROW = 272;
    unsigned char* Cr = shm; unsigned char* Br = Cr + 128 * ROW; unsigned char* BT = Br + 128 * ROW;
    unsigned char* XdT = BT + 128 * ROW; unsigned char* XwT = XdT + 32 * ROW; unsigned char* Hb = XwT + 32 * ROW;
    float* dts = (float*)(Hb + 32 * ROW); float* as_ = dts + 128; float* acs = as_ + 128;
    const float* cw = p->ssd_conv_w + (size_t)l * 4 * 3072; const float* cb = p->ssd_conv_b + (size_t)l * 3072;
    for (int item = blockIdx.x; item < 256; item += gridDim.x) {
        const int bl = item >> 6, head = (item >> 1) & 31, ph = item & 1, g = head >> 3;
        const float Aneg = -__expf(p->ssd_a_log[l * 32 + head]), dtb = p->ssd_dt_bias[l * 32 + head], Dsk = p->ssd_d[l * 32 + head];
        const int cg = tid / 14, sub = tid - cg * 14;
        const bool active = (cg < 36) && (sub < 13);
        const int l0 = sub * 10, l1 = (l0 + 10 < 128) ? l0 + 10 : 128;
        int ch = 0;
        if (cg < 4) ch = head * 64 + ph * 32 + cg * 8; else if (cg < 20) ch = 2048 + g * 128 + (cg - 4) * 8; else if (cg < 36) ch = 2560 + g * 128 + (cg - 20) * 8;
        float wt[4][8], bias[8];
#pragma unroll
        for (int e = 0; e < 8; ++e) { bias[e] = cb[ch + e];
#pragma unroll
            for (int j = 0; j < 4; ++j) wt[j][e] = cw[j * 3072 + ch + e]; }
        f32x4 Hacc[2]; Hacc[0] = (f32x4){0.f, 0.f, 0.f, 0.f}; Hacc[1] = (f32x4){0.f, 0.f, 0.f, 0.f};
        __syncthreads();
        for (int i = tid; i < 32 * ROW / 4; i += 512) ((unsigned*)Hb)[i] = 0u;
        for (int c = 0; c < 32; ++c) {
            const int t0 = c * 128;
            const size_t rbase = (size_t)bl * SEQ + t0;
            if (tid < 128) {
                const float v = misc[(rbase + tid) * 256 + 72 + head] + dtb;
                const float dt = (v > 20.f) ? v : log1pf(__expf(v));
                dts[tid] = dt; as_[tid] = dt * Aneg;
            }
            __syncthreads();
            if (tid < 128) { float sacc = 0.f; for (int k = 0; k <= tid; ++k) sacc += as_[k]; acs[tid] = sacc; }
            __syncthreads();
            if (active) {
                const float atot = acs[127];
                const bf16_t* xb = proj + rbase * NP + C_XBC + ch;
                u32x4 rw0 = (u32x4){0u, 0u, 0u, 0u}, rw1 = rw0, rw2 = rw0;
                if (t0 + l0 - 3 >= 0) rw0 = *(const u32x4*)(xb + (ptrdiff_t)(l0 - 3) * NP);
                if (t0 + l0 - 2 >= 0) rw1 = *(const u32x4*)(xb + (ptrdiff_t)(l0 - 2) * NP);
                if (t0 + l0 - 1 >= 0) rw2 = *(const u32x4*)(xb + (ptrdiff_t)(l0 - 1) * NP);
                for (int ll = l0; ll < l1; ++ll) {
                    const u32x4 rw3 = *(const u32x4*)(xb + (ptrdiff_t)ll * NP);
                    float v[8];
                    const unsigned a0[4] = {rw0.x, rw0.y, rw0.z, rw0.w}, a1[4] = {rw1.x, rw1.y, rw1.z, rw1.w}, a2[4] = {rw2.x, rw2.y, rw2.z, rw2.w}, a3[4] = {rw3.x, rw3.y, rw3.z, rw3.w};
#pragma unroll
                    for (int e = 0; e < 4; ++e) {
                        float lo = bias[2 * e] + wt[0][2 * e] * lo16(a0[e]) + wt[1][2 * e] * lo16(a1[e]) + wt[2][2 * e] * lo16(a2[e]) + wt[3][2 * e] * lo16(a3[e]);
                        float hi = bias[2 * e + 1] + wt[0][2 * e + 1] * hi16(a0[e]) + wt[1][2 * e + 1] * hi16(a1[e]) + wt[2][2 * e + 1] * hi16(a2[e]) + wt[3][2 * e + 1] * hi16(a3[e]);
                        v[2 * e] = silu_f(lo); v[2 * e + 1] = silu_f(hi);
                    }
                    if (cg < 4) {
                        const float dt = dts[ll], wdec = dt * __expf(atot - acs[ll]);
#pragma unroll
                        for (int e = 0; e < 8; ++e) {
                            *(bf16_t*)(XdT + (cg * 8 + e) * ROW + ll * 2) = f2bf(v[e] * dt);
                            *(bf16_t*)(XwT + (cg * 8 + e) * ROW + ll * 2) = f2bf(v[e] * wdec);
                        }
                    } else {
                        u32x4 pk; pk.x = pack2(v[0], v[1]); pk.y = pack2(v[2], v[3]); pk.z = pack2(v[4], v[5]); pk.w = pack2(v[6], v[7]);
                        if (cg < 20) {
                            *(u32x4*)(Br + ll * ROW + (cg - 4) * 16) = pk;
#pragma unroll
                            for (int e = 0; e < 8; ++e) *(bf16_t*)(BT + ((cg - 4) * 8 + e) * ROW + ll * 2) = f2bf(v[e]);
                        } else {
                            *(u32x4*)(Cr + ll * ROW + (cg - 20) * 16) = pk;
                        }
                    }
                    rw0 = rw1; rw1 = rw2; rw2 = rw3;
                }
            }
            __syncthreads();
            {
                const int lt = wave;
                const float acs_l = acs[lt * 16 + fr], dinv = Dsk / dts[lt * 16 + fr];
                bf16x8 cf[4];
#pragma unroll
                for (int ks = 0; ks < 4; ++ks) cf[ks] = *(const bf16x8*)(Cr + (lt * 16 + fr) * ROW + (ks * 32 + fq * 8) * 2);
                f32x4 yacc[2];
#pragma unroll
                for (int pt = 0; pt < 2; ++pt) {
                    yacc[pt] = (f32x4){0.f, 0.f, 0.f, 0.f};
#pragma unroll
                    for (int ks = 0; ks < 4; ++ks) {
                        const bf16x8 hf = *(const bf16x8*)(Hb + (pt * 16 + fr) * ROW + (ks * 32 + fq * 8) * 2);
                        yacc[pt] = __builtin_amdgcn_mfma_f32_16x16x32_bf16(hf, cf[ks], yacc[pt], 0, 0, 0);
                    }
                    yacc[pt] *= __expf(acs_l);
                }
                const int lloc = fr - fq * 4;
                for (int kk = 0; 2 * kk <= lt; ++kk) {
                    u32x4 pk;
#pragma unroll
                    for (int hf2 = 0; hf2 < 2; ++hf2) {
                        const int st = 2 * kk + hf2;
                        f32x4 cbt = (f32x4){0.f, 0.f, 0.f, 0.f};
                        if (st <= lt) {
#pragma unroll
                            for (int ks = 0; ks < 4; ++ks) {
                                const bf16x8 bfr = *(const bf16x8*)(Br + (st * 16 + fr) * ROW + (ks * 32 + fq * 8) * 2);
                                cbt = __builtin_amdgcn_mfma_f32_16x16x32_bf16(bfr, cf[ks], cbt, 0, 0, 0);
                            }
                        }
                        const int stc = (st <= 7) ? st : 7;
                        const f32x4 av = *(const f32x4*)(acs + stc * 16 + fq * 4);
                        float mv[4];
#pragma unroll
                        for (int r = 0; r < 4; ++r) {
                            const int dl = (lt - st) * 16 + lloc - r;
                            float m = (dl >= 0) ? cbt[r] * __expf(acs_l - av[r]) : 0.f;
                            if (dl == 0) m += dinv;
                            mv[r] = m;
                        }
                        if (hf2 == 0) { pk.x = pg8::cvt_pk_bf16(mv[0], mv[1]); pk.y = pg8::cvt_pk_bf16(mv[2], mv[3]); }
                        else { pk.z = pg8::cvt_pk_bf16(mv[0], mv[1]); pk.w = pg8::cvt_pk_bf16(mv[2], mv[3]); }
                    }
                    const bf16x8 pf = __builtin_bit_cast(bf16x8, pk);
#pragma unroll
                    for (int pt = 0; pt < 2; ++pt) {
                        const unsigned char* xp = XdT + (pt * 16 + fr) * ROW + (kk * 32 + fq * 4) * 2;
                        const bf16x4 v0 = *(const bf16x4*)xp, v1 = *(const bf16x4*)(xp + 32);
                        const bf16x8 xf = __builtin_shufflevector(v0, v1, 0, 1, 2, 3, 4, 5, 6, 7);
                        yacc[pt] = __builtin_amdgcn_mfma_f32_16x16x32_bf16(xf, pf, yacc[pt], 0, 0, 0);
                    }
                }
                float sq = 0.f;
                bf16_t* zp = proj + (rbase + lt * 16 + fr) * NP + C_Z + head * 64 + ph * 32 + fq * 4;
#pragma unroll
                for (int pt = 0; pt < 2; ++pt) {
                    const u32x2 zr = *(const u32x2*)(zp + pt * 16);
                    const float y0 = yacc[pt][0] * silu_f(lo16(zr.x)), y1 = yacc[pt][1] * silu_f(hi16(zr.x)), y2 = yacc[pt][2] * silu_f(lo16(zr.y)), y3 = yacc[pt][3] * silu_f(hi16(zr.y));
                    sq += y0 * y0 + y1 * y1 + y2 * y2 + y3 * y3;
                    u32x2 w; w.x = pg8::cvt_pk_bf16(y0, y1); w.y = pg8::cvt_pk_bf16(y2, y3);
                    *(u32x2*)(zp + pt * 16) = w;
                }
                sq += __shfl_xor(sq, 16); sq += __shfl_xor(sq, 32);
                if (fq == 0) ssq[(rbase + lt * 16 + fr) * 64 + head * 2 + ph] = sq;
                const float dec = __expf(acs[127]);
                Hacc[0] *= dec; Hacc[1] *= dec;
#pragma unroll
                for (int ks = 0; ks < 4; ++ks) {
                    const bf16x8 btf = *(const bf16x8*)(BT + (wave * 16 + fr) * ROW + (ks * 32 + fq * 8) * 2);
#pragma unroll
                    for (int pt = 0; pt < 2; ++pt) {
                        const bf16x8 xwf = *(const bf16x8*)(XwT + (pt * 16 + fr) * ROW + (ks * 32 + fq * 8) * 2);
                        Hacc[pt] = __builtin_amdgcn_mfma_f32_16x16x32_bf16(xwf, btf, Hacc[pt], 0, 0, 0);
                    }
                }
            }
            __syncthreads();
#pragma unroll
            for (int pt = 0; pt < 2; ++pt)
#pragma unroll
                for (int r = 0; r < 4; ++r) *(bf16_t*)(Hb + (pt * 16 + fq * 4 + r) * ROW + (wave * 16 + fr) * 2) = f2bf(Hacc[pt][r]);
        }
    }
}

__device__ __forceinline__ void phase_gnorm(int wv, bf16_t* proj, const float* ssq) {
    for (int idx = blockIdx.x * 512 + opaque_tid(wv); idx < SLAB * 256; idx += gridDim.x * 512) {
        const int t = idx >> 8, c8 = idx & 255, g = c8 >> 6;
        const f32x4 s0 = *(const f32x4*)(ssq + (size_t)t * 64 + g * 16), s1 = *(const f32x4*)(ssq + (size_t)t * 64 + g * 16 + 4);
        const f32x4 s2 = *(const f32x4*)(ssq + (size_t)t * 64 + g * 16 + 8), s3 = *(const f32x4*)(ssq + (size_t)t * 64 + g * 16 + 12);
        const float tot = s0[0] + s0[1] + s0[2] + s0[3] + s1[0] + s1[1] + s1[2] + s1[3] + s2[0] + s2[1] + s2[2] + s2[3] + s3[0] + s3[1] + s3[2] + s3[3];
        const float rstd = rsqrtf(tot * (1.0f / 512.0f) + EPS);
        u32x4* pp = (u32x4*)(proj + (size_t)t * NP + C_Z + c8 * 8);
        u32x4 v = *pp;
        v.x = pack2(lo16(v.x) * rstd, hi16(v.x) * rstd); v.y = pack2(lo16(v.y) * rstd, hi16(v.y) * rstd);
        v.z = pack2(lo16(v.z) * rstd, hi16(v.z) * rstd); v.w = pack2(lo16(v.w) * rstd, hi16(v.w) * rstd);
        *pp = v;
    }
}

__device__ __forceinline__ void phase_convglu(int wv, const bf16_t* U, bf16_t* GL, const float* cw, const float* cb) {
    for (int idx = blockIdx.x * 512 + opaque_tid(wv); idx < SLAB * 352; idx += gridDim.x * 512) {
        const int t = idx / 352, f = (idx - t * 352) * 8, pos = t & (SEQ - 1);
        float ga[8], va[8];
#pragma unroll
        for (int e = 0; e < 8; ++e) { ga[e] = cb[f + e]; va[e] = cb[FFN + f + e]; }
#pragma unroll
        for (int j = 0; j < 3; ++j) {
            if (pos - 2 + j >= 0) {
                const bf16_t* up = U + (size_t)(t - 2 + j) * FFN2 + f;
                const u32x4 g4 = *(const u32x4*)up, v4 = *(const u32x4*)(up + FFN);
                const float* wg = cw + j * FFN2 + f; const float* wv = wg + FFN;
                const unsigned gw[4] = {g4.x, g4.y, g4.z, g4.w}, vw[4] = {v4.x, v4.y, v4.z, v4.w};
#pragma unroll
                for (int e = 0; e < 4; ++e) {
                    ga[2 * e] += wg[2 * e] * lo16(gw[e]); ga[2 * e + 1] += wg[2 * e + 1] * hi16(gw[e]);
                    va[2 * e] += wv[2 * e] * lo16(vw[e]); va[2 * e + 1] += wv[2 * e + 1] * hi16(vw[e]);
                }
            }
        }
        u32x4 o;
        o.x = pack2(silu_f(ga[0]) * va[0], silu_f(ga[1]) * va[1]); o.y = pack2(silu_f(ga[2]) * va[2], silu_f(ga[3]) * va[3]);
        o.z = pack2(silu_f(ga[4]) * va[4], silu_f(ga[5]) * va[5]); o.w = pack2(silu_f(ga[6]) * va[6], silu_f(ga[7]) * va[7]);
        *(u32x4*)(GL + (size_t)t * FFN + f) = o;
    }
}

__device__ __forceinline__ KParams kparams() { KParams k = (KParams)__builtin_amdgcn_kernarg_segment_ptr(); asm volatile("" : "+s"(k)); return k; }
#define WSP(T, off) ((T*)(kparams()->ws + (off)))

__global__ void __launch_bounds__(512, 2) mega(Params p_unused) {
    extern __shared__ __attribute__((aligned(16))) unsigned char shm[];
    cg::grid_group grid = cg::this_grid();
    const int wv = __builtin_amdgcn_readfirstlane((int)(threadIdx.x >> 6));
    LAS unsigned char* lds = (LAS unsigned char*)shm;

    phase_convert(wv, kparams(), (float*)shm);
    grid.sync();
    for (int l = 0; l < DEPTH; ++l) {
        for (int half = 0; half < NSLAB; ++half) {
            const size_t r0 = (size_t)half * SLAB;
            { KParams k = kparams(); const float* xin = (l == 0) ? k->x : k->out;
              phase_norm<false>(wv, xin + r0 * 1024, k->norm_mix_w + l * 1024, WSP(bf16_t, OFF_H), nullptr, SLAB); }
            grid.sync();
            { const float* rope = WSP(const float, OFF_ROPE);
              EpiInProj E{WSP(bf16_t, OFF_PROJ), WSP(float, OFF_MISC), rope, rope + 4096 * 16, rope + 4096 * 32, rope + 4096 * 40, WSP(bf16_t, OFF_VT)};
              pg8::gemm_phase(wv, lds, WSP(const bf16_t, OFF_H), 1024, WSP(const bf16_t, OFF_W + (size_t)l * SZ_WL), SLAB, NP, 1024, E); }
            grid.sync();
            phase_idx(wv, WSP(const bf16_t, OFF_PROJ), WSP(const float, OFF_MISC), WSP(unsigned, OFF_MASK), shm);
            grid.sync();
            phase_att(wv, WSP(bf16_t, OFF_PROJ), WSP(const bf16_t, OFF_VT), WSP(const unsigned, OFF_MASK), shm);
            __syncthreads();
            { phase_ssd(wv, kparams(), l, WSP(bf16_t, OFF_PROJ), WSP(const float, OFF_MISC), WSP(float, OFF_SSQ), shm); }
            grid.sync();
            phase_gnorm(wv, WSP(bf16_t, OFF_PROJ), WSP(const float, OFF_SSQ));
            grid.sync();
            { EpiGateA E{WSP(bf16_t, OFF_PROJ)}; pg8::gemm_phase(wv, lds, WSP(const bf16_t, OFF_PROJ) + C_Q, NP, WSP(const bf16_t, OFF_W + (size_t)l * SZ_WL + SZ_WIN), SLAB, 1024, 1024, E); }
            { EpiGateS E{WSP(bf16_t, OFF_PROJ)}; pg8::gemm_phase(wv, lds, WSP(const bf16_t, OFF_PROJ) + C_Z, NP, WSP(const bf16_t, OFF_W + (size_t)l * SZ_WL + SZ_WIN + SZ_WPA), SLAB, 1024, 2048, E); }
            grid.sync();
            { KParams k = kparams(); const float* xin = (l == 0) ? k->x : k->out;
              EpiResid E{xin + r0 * 1024, k->out + r0 * 1024};
              pg8::gemm_phase(wv, lds, WSP(const bf16_t, OFF_PROJ) + C_GS, NP, WSP(const bf16_t, OFF_W + (size_t)l * SZ_WL + SZ_WIN + SZ_WPA + SZ_WPS), SLAB, 1024, 1024, E); }
            grid.sync();
        }
        for (int half = 0; half < NSLAB; ++half) {
            const size_t r0 = (size_t)half * SLAB;
            { KParams k = kparams(); phase_norm<false>(wv, k->out + r0 * 1024, k->norm_ffn_w + l * 1024, WSP(bf16_t, OFF_H), nullptr, SLAB); }
            grid.sync();
            { EpiBf16 E{WSP(bf16_t, OFF_PROJ), FFN2};
              pg8::gemm_phase(wv, lds, WSP(const bf16_t, OFF_H), 1024, WSP(const bf16_t, OFF_W + (size_t)l * SZ_WL + SZ_WIN + SZ_WPA + SZ_WPS + SZ_WO), SLAB, FFN2, 1024, E); }
            grid.sync();
            { KParams k = kparams(); phase_convglu(wv, WSP(const bf16_t, OFF_PROJ), WSP(bf16_t, OFF_GL), k->ffn_conv_w + (size_t)l * 3 * FFN2, k->ffn_conv_b + (size_t)l * FFN2); }
            grid.sync();
            { KParams k = kparams(); EpiResid E{k->out + r0 * 1024, k->out + r0 * 1024};
              pg8::gemm_phase(wv, lds, WSP(const bf16_t, OFF_GL), FFN, WSP(const bf16_t, OFF_W + (size_t)l * SZ_WL + SZ_WIN + SZ_WPA + SZ_WPS + SZ_WO + SZ_WUP), SLAB, 1024, FFN, E); }
            grid.sync();
        }
    }
    { KParams k = kparams(); phase_norm<true>(wv, k->out, k->norm_final_w, nullptr, k->out, NTOK); }
}

extern "C" void kernel_launch(void* const* d_in, const int* in_sizes, int n_in, void* d_out, int out_size, void* d_ws, size_t ws_size, hipStream_t stream) {
    static int grid_blocks = 0;
    if (!grid_blocks) {
        int dev = 0, cus = 0, per_cu = 0;
        hipGetDevice(&dev);
        hipDeviceGetAttribute(&cus, hipDeviceAttributeMultiprocessorCount, dev);
        hipFuncSetAttribute((const void*)mega, hipFuncAttributeMaxDynamicSharedMemorySize, LDS_BYTES);
        hipOccupancyMaxActiveBlocksPerMultiprocessor(&per_cu, mega, 512, LDS_BYTES);
        if (per_cu < 1) per_cu = 1;
        grid_blocks = cus * 1;
    }
    if (ws_size < OFF_END) { fprintf(stderr, "workspace too small: %zu < %zu\n", ws_size, (size_t)OFF_END); return; }
    Params p{};
    p.x = (const float*)d_in[0]; p.norm_mix_w = (const float*)d_in[1]; p.w_in = (const float*)d_in[2]; p.ssd_conv_w = (const float*)d_in[3]; p.ssd_conv_b = (const float*)d_in[4];
    p.ssd_dt_bias = (const float*)d_in[5]; p.ssd_a_log = (const float*)d_in[6]; p.ssd_d = (const float*)d_in[7]; p.ssd_norm_w = (const float*)d_in[8];
    p.w_proj_attn = (const float*)d_in[9]; p.w_proj_ssd = (const float*)d_in[10]; p.w_out = (const float*)d_in[11]; p.norm_ffn_w = (const float*)d_in[12];
    p.ffn_w_up = (const float*)d_in[13]; p.ffn_conv_w = (const float*)d_in[14]; p.ffn_conv_b = (const float*)d_in[15]; p.ffn_w_down = (const float*)d_in[16]; p.norm_final_w = (const float*)d_in[17];
    p.out = (float*)d_out; p.ws = (unsigned char*)d_ws;
    for (int i = 0; i < 16; ++i) p.invA[i] = powf(500000.0f, -(float)(2 * i) / 32.0f);
    for (int i = 0; i < 8; ++i) p.invI[i] = powf(500000.0f, -(float)(2 * i) / 16.0f);
    void* args[] = {&p};
    hipError_t e = hipLaunchCooperativeKernel((const void*)mega, dim3(grid_blocks), dim3(512), args, LDS_BYTES, stream);
    if (e != hipSuccess) fprintf(stderr, "cooperative launch failed: %s (grid %d)\n", hipGetErrorString(e), grid_blocks);
}
```

```cpp
#include <hip/hip_runtime.h>
#include <hip/hip_cooperative_groups.h>
#include <cstdio>
#include <cmath>
namespace cg = cooperative_groups;

#define LAS __attribute__((address_space(3)))
typedef unsigned short bf16_t;
typedef short bf16x8 __attribute__((ext_vector_type(8)));
typedef float f32x4 __attribute__((ext_vector_type(4)));
typedef unsigned u32x2 __attribute__((ext_vector_type(2)));
typedef unsigned u32x4 __attribute__((ext_vector_type(4)));

constexpr int D_MODEL = 1024, SEQ = 4096, NTOK = 32768, SLAB = 16384, NSLAB = 2, DEPTH = 2;
constexpr int IN_COLS = 9320, NP = 9472;
constexpr int C_Q = 0, C_K = 1024, C_V = 1280, C_QI = 1536, C_MISC = 2048, C_Z = 2304, C_XBC = 4352, C_GA = 7424, C_GS = 8448;
constexpr int FFN = 2816, FFN2 = 5632;
constexpr float EPS = 1e-6f;

constexpr size_t SZ_WIN = (size_t)NP * 1024 * 2, SZ_WPA = (size_t)1024 * 1024 * 2, SZ_WPS = (size_t)1024 * 2048 * 2, SZ_WO = SZ_WPA,
                 SZ_WUP = (size_t)FFN2 * 1024 * 2, SZ_WDN = (size_t)1024 * FFN * 2;
constexpr size_t SZ_WL = SZ_WIN + SZ_WPA + SZ_WPS + SZ_WO + SZ_WUP + SZ_WDN;
constexpr size_t OFF_W = 0;
constexpr size_t OFF_ROPE = OFF_W + 2 * SZ_WL;
constexpr size_t OFF_H = OFF_ROPE + (size_t)4096 * 48 * 4;
constexpr size_t OFF_PROJ = OFF_H + (size_t)SLAB * 1024 * 2;
constexpr size_t OFF_MISC = OFF_PROJ + (size_t)SLAB * NP * 2;
constexpr size_t OFF_MASK = OFF_MISC + (size_t)SLAB * 256 * 4;
constexpr size_t OFF_SEL = OFF_MASK + (size_t)SLAB * 128 * 4;
constexpr size_t OFF_SSQ = OFF_SEL + (size_t)SLAB * 256 * 4;
constexpr size_t OFF_VT = OFF_SSQ + (size_t)SLAB * 64 * 4;
constexpr size_t OFF_BTG = OFF_VT + (size_t)4 * 2 * 128 * 4096 * 2;
constexpr size_t OFF_END = OFF_BTG + (size_t)4 * 512 * 4096 * 2;
static_assert(OFF_END <= (size_t)536870912, "workspace budget");
constexpr size_t OFF_GL = OFF_PROJ + (size_t)SLAB * FFN2 * 2;

constexpr int LDS_BYTES = 150528;
#ifndef PROBE
#define PROBE 0
#endif
#define TIC(k) do { if (PROBE == (k)) tst = __builtin_amdgcn_s_memrealtime(); } while (0)
#define TOC(k) do { if (PROBE == (k)) tacc += __builtin_amdgcn_s_memrealtime() - tst; } while (0)

struct Params {
    const float* x; const float* norm_mix_w; const float* w_in; const float* ssd_conv_w; const float* ssd_conv_b;
    const float* ssd_dt_bias; const float* ssd_a_log; const float* ssd_d; const float* ssd_norm_w;
    const float* w_proj_attn; const float* w_proj_ssd; const float* w_out; const float* norm_ffn_w;
    const float* ffn_w_up; const float* ffn_conv_w; const float* ffn_conv_b; const float* ffn_w_down; const float* norm_final_w;
    float* out; unsigned char* ws;
    float invA[16]; float invI[8];
};
typedef const __attribute__((address_space(4))) Params* KParams;

__device__ __forceinline__ int opaque_tid(int wv) { int t; asm volatile("v_mbcnt_lo_u32_b32 %0, -1, 0\n\tv_mbcnt_hi_u32_b32 %0, -1, %0" : "=v"(t)); return wv * 64 + t; }
__device__ __forceinline__ float bf2f(bf16_t b) { return __uint_as_float(((unsigned)b) << 16); }
__device__ __forceinline__ bf16_t f2bf(float f) { unsigned u = __float_as_uint(f); u += 0x7FFFu + ((u >> 16) & 1u); return (bf16_t)(u >> 16); }
__device__ __forceinline__ unsigned pack2(float lo, float hi) { return (unsigned)f2bf(lo) | ((unsigned)f2bf(hi) << 16); }
__device__ __forceinline__ float lo16(unsigned w) { return __uint_as_float(w << 16); }
__device__ __forceinline__ float hi16(unsigned w) { return __uint_as_float(w & 0xffff0000u); }
__device__ __forceinline__ float silu_f(float v) { return v * __builtin_amdgcn_rcpf(1.0f + __expf(-v)); }
__device__ __forceinline__ float sigmoid_f(float v) { return __builtin_amdgcn_rcpf(1.0f + __expf(-v)); }
__device__ __forceinline__ void wave_lds_sync() { __builtin_amdgcn_fence(__ATOMIC_SEQ_CST, "wavefront"); __builtin_amdgcn_wave_barrier(); }
__device__ __forceinline__ float wave_sum(float v) {
#pragma unroll
    for (int o = 32; o >= 1; o >>= 1) v += __shfl_xor(v, o);
    return v;
}
__device__ __forceinline__ float wave_max(float v) {
#pragma unroll
    for (int o = 32; o >= 1; o >>= 1) v = fmaxf(v, __shfl_xor(v, o));
    return v;
}
__device__ __forceinline__ int permA(int s) { return 16 * ((s >> 2) & 1) + 4 * (s >> 3) + (s & 3); }
__device__ __forceinline__ int permI(int s) { return s < 16 ? 8 * ((s >> 2) & 1) + 4 * (s >> 3) + (s & 3) : s; }
__device__ __forceinline__ int perm32(int rho) { const int n = rho >> 4, i = rho & 15; return 8 * (i >> 2) + 4 * n + (i & 3); }
__device__ __forceinline__ int inproj_map(int n) {
    if (n < C_V) { const int sd = n & 127; return (sd < 32) ? (n & ~127) + permA(sd) : n; }
    if (n < C_QI) return n;
    if (n < C_MISC) { const int r = n - C_QI; return C_QI + (r & ~63) + permI(r & 63); }
    if (n < C_Z) { const int c = n - C_MISC; if (c < 64) return 2048 + permI(c); if (c < 72) return 2112 + (c - 64); if (c < 104) return 7240 + (c - 72); return -1; }
    if (n < C_XBC) return 2120 + (n - C_Z);
    if (n < C_GA) return 4168 + (n - C_XBC);
    if (n < C_GS) return 7272 + (n - C_GA);
    return 8296 + (n - C_GS);
}

namespace pg8 {
constexpr int BM = 256, BK = 64, HALF = 128, HTB = HALF * BK * 2, NXCD = 8, WGM = 8;
__device__ __forceinline__ int lds_byte(int r, int c) { const int st = (r >> 4) * 2 + (c >> 5), rr = r & 15, cc = c & 31, ob = rr * 64 + cc * 2; return st * 1024 + (ob ^ (((ob >> 9) & 1) << 5)); }
__device__ __forceinline__ void stage_rc(int b, int& R, int& C) { const int st = b / 1024, sb = b % 1024, swz = sb ^ (((sb >> 9) & 1) << 5); R = (st >> 1) * 16 + swz / 64; C = (st & 1) * 32 + (swz % 64) / 2; }
struct Unit { int pm, pn; };
struct StaticOrder {
    int nM, nN, nwg, G, c;
    __device__ void init(int M, int N, int G_, int c_) { nM = M / BM; nN = N / BM; nwg = nM * nN; G = G_; c = c_; }
    __device__ bool next(int i, Unit& u) const {
        const long L = (long)i * G + c; if (L >= nwg) return false;
        int wgid = (int)L; { const int q = nwg / NXCD, r = nwg % NXCD, xcd = wgid % NXCD, off = wgid / NXCD; wgid = (xcd < r ? xcd * (q + 1) : r * (q + 1) + (xcd - r) * q) + off; }
        const int nig = WGM * nN, gid = wgid / nig, fm = gid * WGM, gsz = (nM - fm) < WGM ? (nM - fm) : WGM;
        u.pm = fm + ((wgid % nig) % gsz); u.pn = (wgid % nig) / gsz; return true;
    }
};
__device__ __forceinline__ unsigned cvt_pk_bf16(float lo, float hi) { unsigned r; asm volatile("v_cvt_pk_bf16_f32 %0, %1, %2" : "=v"(r) : "v"(lo), "v"(hi)); return r; }

template <class Epi>
__device__ __forceinline__ void gemm_phase(int wv, LAS unsigned char* lds, const bf16_t* A, int lda, const bf16_t* Bt, int M, int N, int K, const Epi& E) {
    const int tid = opaque_tid(wv), wid = __builtin_amdgcn_readfirstlane(tid >> 6), lane = tid & 63, wr = wid >> 2, wc = wid & 3, fr = lane & 15, fq = lane >> 4;
    const int nt = K / BK;
    StaticOrder S; S.init(M, N, (int)gridDim.x, (int)blockIdx.x);
    unsigned voffA[2], voffB[2];
#pragma unroll
    for (int i = 0; i < 2; ++i) { int R, C; stage_rc(tid * 16 + i * 8192, R, C); voffA[i] = (unsigned)(R * lda + C) * 2u; voffB[i] = (unsigned)(R * K + C) * 2u; }
    const size_t kstep = (size_t)(BK * 2);
    const size_t hstepA = (size_t)HALF * lda * 2, hstepB = (size_t)HALF * K * 2;
    const size_t tstepA = 2 * hstepA, tstepB = 2 * hstepB;
    const unsigned ldsw = (unsigned)wid * 1024u;
    const int aoff = lds_byte(wr * 64 + fr, fq * 8), boff = lds_byte(wc * 32 + fr, fq * 8);
#define PG8_SA(b, h) (((b) * 2 + (h)) * HTB)
#define PG8_SB(b, h) ((4 + (b) * 2 + (h)) * HTB)
#define PG8_STAGE(bufoff, gbase, voff) do { _Pragma("unroll") for (int _i = 0; _i < 2; ++_i) \
        __builtin_amdgcn_global_load_lds((const unsigned*)((const char*)(gbase) + (voff)[_i]), (LAS unsigned*)(lds + (bufoff) + ldsw + _i * 8192), 16, 0, 0); } while (0)
#define PG8_LDA(dst, b, h) do { _Pragma("unroll") for (int m = 0; m < 4; ++m) _Pragma("unroll") for (int k = 0; k < 2; ++k) dst[m][k] = *(const LAS bf16x8*)(lds + PG8_SA(b, h) + aoff + m * 2048 + k * 1024); } while (0)
#define PG8_LDB(dst, b, h) do { _Pragma("unroll") for (int n = 0; n < 2; ++n) _Pragma("unroll") for (int k = 0; k < 2; ++k) dst[n][k] = *(const LAS bf16x8*)(lds + PG8_SB(b, h) + boff + n * 2048 + k * 1024); } while (0)
#define PG8_MMA(ai, bj, At, Bt_) do { __builtin_amdgcn_s_setprio(1); _Pragma("unroll") for (int m = 0; m < 4; ++m) _Pragma("unroll") for (int n = 0; n < 2; ++n) _Pragma("unroll") for (int k = 0; k < 2; ++k) \
        acc[ai][bj][m][n] = __builtin_amdgcn_mfma_f32_16x16x32_bf16(Bt_[n][k], At[m][k], acc[ai][bj][m][n], 0, 0, 0); __builtin_amdgcn_s_setprio(0); } while (0)
#define PG8_WAIT_V(n) asm volatile("s_waitcnt vmcnt(" #n ")" ::: "memory")
#define PG8_WAIT_L(n) asm volatile("s_waitcnt lgkmcnt(" #n ")" ::: "memory")
#define PG8_BAR __builtin_amdgcn_s_barrier()
#define PG8_SCHED __builtin_amdgcn_sched_barrier(0)
    Unit cur, nxt; int ui = 0;
    if (!S.next(0, cur)) return;
    f32x4 acc[2][2][4][2];
#pragma unroll
    for (int a = 0; a < 2; ++a)
#pragma unroll
        for (int b = 0; b < 2; ++b)
#pragma unroll
            for (int m = 0; m < 4; ++m)
#pragma unroll
                for (int n = 0; n < 2; ++n) acc[a][b][m][n] = (f32x4){0.f, 0.f, 0.f, 0.f};
    bf16x8 At[4][2], B0[2][2], B1[2][2];
    const char* cA = (const char*)A + (size_t)cur.pm * tstepA; const char* cB = (const char*)Bt + (size_t)cur.pn * tstepB;
    PG8_STAGE(PG8_SB(0, 0), cB, voffB); PG8_STAGE(PG8_SB(0, 1), cB + hstepB, voffB); PG8_STAGE(PG8_SA(0, 0), cA, voffA); PG8_STAGE(PG8_SA(0, 1), cA + hstepA, voffA);
    if (wr == 1) PG8_BAR;
    PG8_WAIT_V(2); PG8_BAR;
    PG8_STAGE(PG8_SB(1, 0), cB + kstep, voffB); PG8_STAGE(PG8_SA(1, 0), cA + kstep, voffA); PG8_STAGE(PG8_SB(1, 1), cB + hstepB + kstep, voffB);
    PG8_WAIT_V(6); PG8_BAR;
    for (;;) {
        const bool has_next = S.next(ui + 1, nxt);
        const char* nA = has_next ? (const char*)A + (size_t)nxt.pm * tstepA : cA; const char* nB = has_next ? (const char*)Bt + (size_t)nxt.pn * tstepB : cB;
        const int TG = Epi::GS ? 8 : nt;
        for (int tg = 0; tg < nt; tg += TG) {
        for (int t = tg; t < tg + TG; t += 2) {
            const bool last = (t == nt - 2);
            const char* a1 = cA + (size_t)(t + 1) * kstep;
            const char* a2 = last ? nA : cA + (size_t)(t + 2) * kstep; const char* b2 = last ? nB : cB + (size_t)(t + 2) * kstep;
            const char* a3 = a2 + kstep; const char* b3 = b2 + kstep;
            PG8_LDB(B0, 0, 0); PG8_LDB(B1, 0, 1); PG8_SCHED; PG8_LDA(At, 0, 0); PG8_STAGE(PG8_SA(1, 1), a1 + hstepA, voffA);
            PG8_WAIT_V(8); PG8_WAIT_L(0); PG8_BAR; PG8_MMA(0, 0, At, B0); PG8_MMA(0, 1, At, B1); PG8_BAR; PG8_SCHED;
            PG8_LDA(At, 0, 1); PG8_STAGE(PG8_SB(0, 0), b2, voffB); PG8_STAGE(PG8_SB(0, 1), b2 + hstepB, voffB); PG8_STAGE(PG8_SA(0, 0), a2, voffA);
            PG8_WAIT_V(8); PG8_WAIT_L(0); PG8_BAR; PG8_MMA(1, 0, At, B0); PG8_MMA(1, 1, At, B1); PG8_BAR; PG8_SCHED;
            PG8_LDB(B0, 1, 0); PG8_LDB(B1, 1, 1); PG8_SCHED; PG8_LDA(At, 1, 0); PG8_STAGE(PG8_SA(0, 1), a2 + hstepA, voffA);
            PG8_WAIT_V(8); PG8_WAIT_L(0); PG8_BAR; PG8_MMA(0, 0, At, B0); PG8_MMA(0, 1, At, B1); PG8_BAR; PG8_SCHED;
            PG8_LDA(At, 1, 1); PG8_STAGE(PG8_SB(1, 0), b3, voffB); PG8_STAGE(PG8_SB(1, 1), b3 + hstepB, voffB); PG8_STAGE(PG8_SA(1, 0), a3, voffA);
            PG8_WAIT_V(8); PG8_WAIT_L(0); PG8_BAR; PG8_MMA(1, 0, At, B0); PG8_MMA(1, 1, At, B1); PG8_BAR; PG8_SCHED;
        }
        if constexpr (Epi::GS) { if (tg + TG < nt) E.group_scale(acc, ui, tg >> 3, wr, fr); }
        }
        if (wr == 0) PG8_BAR;
        if constexpr (Epi::GS) E.run(acc, cur, wr, wc, fr, fq, ui); else E(acc, cur, wr, wc, fr, fq);
        if (!has_next) break;
#pragma unroll
        for (int a = 0; a < 2; ++a)
#pragma unroll
            for (int b = 0; b < 2; ++b)
#pragma unroll
                for (int m = 0; m < 4; ++m)
#pragma unroll
                    for (int n = 0; n < 2; ++n) acc[a][b][m][n] = (f32x4){0.f, 0.f, 0.f, 0.f};
        cur = nxt; cA = nA; cB = nB; ++ui;
        if (wr == 1) PG8_BAR;
    }
    PG8_WAIT_V(0);
    PG8_BAR;
#undef PG8_SA
#undef PG8_SB
#undef PG8_STAGE
#undef PG8_LDA
#undef PG8_LDB
#undef PG8_MMA
#undef PG8_WAIT_V
#undef PG8_WAIT_L
#undef PG8_BAR
#undef PG8_SCHED
}
}
using pg8::Unit;

struct EpiInProj {
    static constexpr bool GS = false;
    bf16_t* proj; float* misc; const float* cosA; const float* sinA; const float* cosI; const float* sinI; bf16_t* vt;
    __device__ __forceinline__ void operator()(const f32x4 (&acc)[2][2][4][2], const Unit& u, int wr, int wc, int fr, int fq) const {
        const int pn = u.pn, row0 = u.pm * 256 + wr * 64 + fr;
        const bool is_misc = (pn == 8), is_sig = (pn >= 29);
#pragma unroll
        for (int ai = 0; ai < 2; ++ai)
#pragma unroll
            for (int m = 0; m < 4; ++m) {
                const int r = row0 + ai * 128 + m * 16, pos = r & (SEQ - 1);
#pragma unroll
                for (int bj = 0; bj < 2; ++bj) {
                    int kind = 0;
                    if (pn <= 4) kind = (wc == 0) ? 1 : 0;
                    else if (pn == 6 || pn == 7) kind = (((wc & 1) == 0) && fq < 2) ? 2 : 0;
                    else if (pn == 8) kind = (bj == 0 && wc == 0 && fq < 2) ? 2 : 0;
                    f32x4 c4 = (f32x4){1.f, 1.f, 1.f, 1.f}, s4 = (f32x4){0.f, 0.f, 0.f, 0.f};
                    if (kind == 1) { c4 = *(const f32x4*)(cosA + pos * 16 + 4 * fq); s4 = *(const f32x4*)(sinA + pos * 16 + 4 * fq); }
                    else if (kind == 2) { c4 = *(const f32x4*)(cosI + pos * 8 + 4 * fq); s4 = *(const f32x4*)(sinI + pos * 8 + 4 * fq); }
                    const f32x4 v0 = acc[ai][bj][m][0], v1 = acc[ai][bj][m][1];
                    f32x4 o0 = v0 * c4 - v1 * s4, o1 = v1 * c4 + v0 * s4;
                    if (is_sig) {
#pragma unroll
                        for (int j = 0; j < 4; ++j) { o0[j] = sigmoid_f(o0[j]); o1[j] = sigmoid_f(o1[j]); }
                    }
                    const int cc = bj * 128 + wc * 32 + 8 * fq;
                    u32x4 pk; pk.x = pg8::cvt_pk_bf16(o0[0], o0[1]); pk.y = pg8::cvt_pk_bf16(o0[2], o0[3]); pk.z = pg8::cvt_pk_bf16(o1[0], o1[1]); pk.w = pg8::cvt_pk_bf16(o1[2], o1[3]);
                    if (is_misc) {
                        float* mp = misc + (size_t)r * 256 + cc;
                        *(f32x4*)mp = o0; *(f32x4*)(mp + 4) = o1;
                        if (bj == 0 && wc < 2) *(u32x4*)(proj + (size_t)r * NP + C_MISC + cc) = pk;
                    } else {
                        if (pn == 5) {
                            bf16_t* vp = vt + ((size_t)((r >> 12) * 2 + bj) * 128 + wc * 32 + 8 * fq) * SEQ + pos;
#pragma unroll
                            for (int j = 0; j < 4; ++j) { vp[(size_t)j * SEQ] = f2bf(o0[j]); vp[(size_t)(4 + j) * SEQ] = f2bf(o1[j]); }
                        }
                        *(u32x4*)(proj + (size_t)r * NP + pn * 256 + cc) = pk;
                    }
                }
            }
    }
};
struct EpiGateA {
    static constexpr bool GS = false;
    bf16_t* proj;
    __device__ __forceinline__ void operator()(const f32x4 (&acc)[2][2][4][2], const Unit& u, int wr, int wc, int fr, int fq) const {
        const int row0 = u.pm * 256 + wr * 64 + fr, col0 = u.pn * 256 + wc * 32 + 8 * fq;
#pragma unroll
        for (int ai = 0; ai < 2; ++ai)
#pragma unroll
            for (int m = 0; m < 4; ++m)
#pragma unroll
                for (int bj = 0; bj < 2; ++bj) {
                    bf16_t* pp = proj + (size_t)(row0 + ai * 128 + m * 16) * NP + C_GA + col0 + bj * 128;
                    const u32x4 g = *(const u32x4*)pp; const f32x4 a = acc[ai][bj][m][0], b = acc[ai][bj][m][1];
                    u32x4 w; w.x = pg8::cvt_pk_bf16(lo16(g.x) * a[0], hi16(g.x) * a[1]); w.y = pg8::cvt_pk_bf16(lo16(g.y) * a[2], hi16(g.y) * a[3]);
                    w.z = pg8::cvt_pk_bf16(lo16(g.z) * b[0], hi16(g.z) * b[1]); w.w = pg8::cvt_pk_bf16(lo16(g.w) * b[2], hi16(g.w) * b[3]);
                    *(u32x4*)pp = w;
                }
    }
};
struct EpiGateS {
    static constexpr bool GS = true;
    bf16_t* proj; const float* gtab;
    __device__ __forceinline__ void group_scale(f32x4 (&acc)[2][2][4][2], int u, int g, int wr, int fr) const {
        const float* tp = gtab + (u * 4 + g) * 256 + wr * 64 + fr;
#pragma unroll
        for (int ai = 0; ai < 2; ++ai)
#pragma unroll
            for (int m = 0; m < 4; ++m) {
                const float f = tp[ai * 128 + m * 16];
#pragma unroll
                for (int bj = 0; bj < 2; ++bj) { acc[ai][bj][m][0] *= f; acc[ai][bj][m][1] *= f; }
            }
    }
    __device__ __forceinline__ void run(const f32x4 (&acc)[2][2][4][2], const Unit& u, int wr, int wc, int fr, int fq, int ui) const {
        const int row0 = u.pm * 256 + wr * 64 + fr, col0 = u.pn * 256 + wc * 32 + 8 * fq;
        const float* tp = gtab + (ui * 4 + 3) * 256 + wr * 64 + fr;
#pragma unroll
        for (int ai = 0; ai < 2; ++ai)
#pragma unroll
            for (int m = 0; m < 4; ++m) {
                const float rl = tp[ai * 128 + m * 16];
#pragma unroll
                for (int bj = 0; bj < 2; ++bj) {
                    bf16_t* pa = proj + (size_t)(row0 + ai * 128 + m * 16) * NP + C_GA + col0 + bj * 128;
                    bf16_t* ps = pa + (C_GS - C_GA);
                    const u32x4 m1 = *(const u32x4*)pa; const u32x4 g = *(const u32x4*)ps; const f32x4 a = acc[ai][bj][m][0] * rl, b = acc[ai][bj][m][1] * rl;
                    u32x4 w; w.x = pg8::cvt_pk_bf16(lo16(m1.x) + lo16(g.x) * a[0], hi16(m1.x) + hi16(g.x) * a[1]);
                    w.y = pg8::cvt_pk_bf16(lo16(m1.y) + lo16(g.y) * a[2], hi16(m1.y) + hi16(g.y) * a[3]);
                    w.z = pg8::cvt_pk_bf16(lo16(m1.z) + lo16(g.z) * b[0], hi16(m1.z) + hi16(g.z) * b[1]);
                    w.w = pg8::cvt_pk_bf16(lo16(m1.w) + lo16(g.w) * b[2], hi16(m1.w) + hi16(g.w) * b[3]);
                    *(u32x4*)ps = w;
                }
            }
    }
};
struct EpiResid {
    static constexpr bool GS = false;
    const float* xin; float* xout;
    __device__ __forceinline__ void operator()(const f32x4 (&acc)[2][2][4][2], const Unit& u, int wr, int wc, int fr, int fq) const {
        const int row0 = u.pm * 256 + wr * 64 + fr, col0 = u.pn * 256 + wc * 32 + 8 * fq;
#pragma unroll
        for (int ai = 0; ai < 2; ++ai)
#pragma unroll
            for (int m = 0; m < 4; ++m)
#pragma unroll
                for (int bj = 0; bj < 2; ++bj)
#pragma unroll
                    for (int n = 0; n < 2; ++n) {
                        const size_t off = (size_t)(row0 + ai * 128 + m * 16) * 1024 + col0 + bj * 128 + n * 4;
                        *(f32x4*)(xout + off) = *(const f32x4*)(xin + off) + acc[ai][bj][m][n];
                    }
    }
};
struct EpiBf16 {
    static constexpr bool GS = false;
    bf16_t* O; int ldc;
    __device__ __forceinline__ void operator()(const f32x4 (&acc)[2][2][4][2], const Unit& u, int wr, int wc, int fr, int fq) const {
        const int row0 = u.pm * 256 + wr * 64 + fr, col0 = u.pn * 256 + wc * 32 + 8 * fq;
#pragma unroll
        for (int ai = 0; ai < 2; ++ai)
#pragma unroll
            for (int m = 0; m < 4; ++m)
#pragma unroll
                for (int bj = 0; bj < 2; ++bj) {
                    const f32x4 a = acc[ai][bj][m][0], b = acc[ai][bj][m][1];
                    u32x4 w; w.x = pg8::cvt_pk_bf16(a[0], a[1]); w.y = pg8::cvt_pk_bf16(a[2], a[3]); w.z = pg8::cvt_pk_bf16(b[0], b[1]); w.w = pg8::cvt_pk_bf16(b[2], b[3]);
                    *(u32x4*)(O + (size_t)(row0 + ai * 128 + m * 16) * ldc + col0 + bj * 128) = w;
                }
    }
};

template <int MODE>
__device__ __forceinline__ void convT(int wv, const float* src, int K, int Nsrc, bf16_t* dst, int Ndst, const float* kscale, float* tile) {
    const int tid = opaque_tid(wv), kt = K / 64, ntiles = (Ndst / 64) * kt;
    for (int ti = blockIdx.x; ti < ntiles; ti += gridDim.x) {
        const int n0 = (ti / kt) * 64, k0 = (ti % kt) * 64;
        {
            const int nn = tid & 63; const int nd = n0 + nn; const int n = (nd & ~31) + perm32(nd & 31); const int ns = MODE ? inproj_map(n) : n;
#pragma unroll
            for (int i = 0; i < 8; ++i) {
                const int kk = (tid >> 6) + 8 * i;
                float v = (ns >= 0) ? src[(size_t)(k0 + kk) * Nsrc + ns] : 0.f;
                if (kscale) v *= kscale[k0 + kk];
                tile[nn * 65 + kk] = v;
            }
        }
        __syncthreads();
        {
            const int kk = tid & 63;
#pragma unroll
            for (int i = 0; i < 8; ++i) { const int nn = (tid >> 6) + 8 * i; dst[(size_t)(n0 + nn) * K + k0 + kk] = f2bf(tile[nn * 65 + kk]); }
        }
        __syncthreads();
    }
}

__device__ __forceinline__ void phase_convert(int wv, KParams p, float* tile) {
    for (int l = 0; l < DEPTH; ++l) {
        unsigned char* wl = p->ws + OFF_W + (size_t)l * SZ_WL;
        bf16_t* win = (bf16_t*)wl; bf16_t* wpa = (bf16_t*)(wl + SZ_WIN); bf16_t* wps = (bf16_t*)(wl + SZ_WIN + SZ_WPA);
        bf16_t* wo = (bf16_t*)(wl + SZ_WIN + SZ_WPA + SZ_WPS); bf16_t* wup = (bf16_t*)(wl + SZ_WIN + SZ_WPA + SZ_WPS + SZ_WO); bf16_t* wdn = (bf16_t*)(wl + SZ_WIN + SZ_WPA + SZ_WPS + SZ_WO + SZ_WUP);
        convT<1>(wv, p->w_in + (size_t)l * 1024 * IN_COLS, 1024, IN_COLS, win, NP, nullptr, tile);
        convT<0>(wv, p->w_proj_attn + (size_t)l * 1024 * 1024, 1024, 1024, wpa, 1024, nullptr, tile);
        convT<0>(wv, p->w_proj_ssd + (size_t)l * 2048 * 1024, 2048, 1024, wps, 1024, p->ssd_norm_w + l * 2048, tile);
        convT<0>(wv, p->w_out + (size_t)l * 1024 * 1024, 1024, 1024, wo, 1024, nullptr, tile);
        convT<0>(wv, p->ffn_w_up + (size_t)l * 1024 * FFN2, 1024, FFN2, wup, FFN2, nullptr, tile);
        convT<0>(wv, p->ffn_w_down + (size_t)l * FFN * 1024, FFN, 1024, wdn, 1024, nullptr, tile);
    }
    float* rope = (float*)(p->ws + OFF_ROPE);
    float* cosA = rope; float* sinA = rope + 4096 * 16; float* cosI = rope + 4096 * 32; float* sinI = rope + 4096 * 40;
    for (int i = blockIdx.x * 512 + opaque_tid(wv); i < 4096 * 24; i += gridDim.x * 512) {
        int pos, f; float inv;
        if (i < 4096 * 16) { pos = i >> 4; f = i & 15; inv = p->invA[f]; } else { const int j = i - 4096 * 16; pos = j >> 3; f = j & 7; inv = p->invI[f]; }
        const float ang = (float)pos * inv;
        double rev = (double)ang * 0.15915494309189535; rev -= rint(rev);
        const float c = __builtin_amdgcn_cosf((float)rev), s = __builtin_amdgcn_sinf((float)rev);
        if (i < 4096 * 16) { cosA[pos * 16 + f] = c; sinA[pos * 16 + f] = s; } else { cosI[pos * 8 + f] = c; sinI[pos * 8 + f] = s; }
    }
}

template <bool F32OUT>
__device__ __forceinline__ void phase_norm(int wv, const float* xin, const float* w, bf16_t* hout, float* fout, int nrows) {
    const int tid = opaque_tid(wv); const int wave = tid >> 6, lane = tid & 63;
    const int stride = gridDim.x * 8;
    for (int row0 = blockIdx.x * 8 + wave; row0 < nrows; row0 += stride * 4) {
        f32x4 v[4][4];
#pragma unroll
        for (int u = 0; u < 4; ++u) {
            const int row = row0 + u * stride;
            if (row < nrows) {
                const f32x4* xr = (const f32x4*)(xin + (size_t)row * 1024);
#pragma unroll
                for (int i = 0; i < 4; ++i) v[u][i] = xr[lane + 64 * i];
            }
        }
        f32x4 w4[4];
#pragma unroll
        for (int i = 0; i < 4; ++i) w4[i] = ((const f32x4*)w)[lane + 64 * i];
#pragma unroll
        for (int u = 0; u < 4; ++u) {
            const int row = row0 + u * stride;
            if (row < nrows) {
                float ss = 0.f;
#pragma unroll
                for (int i = 0; i < 4; ++i) ss += v[u][i][0] * v[u][i][0] + v[u][i][1] * v[u][i][1] + v[u][i][2] * v[u][i][2] + v[u][i][3] * v[u][i][3];
                ss = wave_sum(ss);
                const float rstd = rsqrtf(ss * (1.0f / 1024.0f) + EPS);
#pragma unroll
                for (int i = 0; i < 4; ++i) {
                    const f32x4 o = v[u][i] * rstd * w4[i];
                    if (F32OUT) ((f32x4*)(fout + (size_t)row * 1024))[lane + 64 * i] = o;
                    else { u32x2 pk; pk.x = pack2(o[0], o[1]); pk.y = pack2(o[2], o[3]); *(u32x2*)(hout + (size_t)row * 1024 + 4 * (lane + 64 * i)) = pk; }
                }
            }
        }
    }
}

__device__ __forceinline__ unsigned fkey(float s) { s += 0.0f; const unsigned u = __float_as_uint(s); return (u & 0x80000000u) ? ~u : (u | 0x80000000u); }

__device__ __forceinline__ void phase_idx_simple(int wv, const bf16_t* proj, const float* misc, unsigned* mask, int* sel, unsigned char* shm) {
    const int tid = opaque_tid(wv); const int wave = tid >> 6, lane = tid & 63;
    float* qs = (float*)(shm + wave * 18432); unsigned* sk = (unsigned*)(shm + wave * 18432 + 2048);
    const unsigned long long lt_mask = (1ull << lane) - 1ull;
    for (int q = blockIdx.x * 8 + wave; q < SLAB; q += gridDim.x * 8) {
        const int bl = q >> 12, t = q & (SEQ - 1), n = t + 1;
        wave_lds_sync();
        {
            const u32x4 raw = *(const u32x4*)(proj + (size_t)q * NP + C_QI + lane * 8);
            f32x4 a, b; a[0] = lo16(raw.x); a[1] = hi16(raw.x); a[2] = lo16(raw.y); a[3] = hi16(raw.y); b[0] = lo16(raw.z); b[1] = hi16(raw.z); b[2] = lo16(raw.w); b[3] = hi16(raw.w);
            *(f32x4*)(qs + lane * 8) = a; *(f32x4*)(qs + lane * 8 + 4) = b;
        }
        float wv[8];
        { const f32x4 w0 = *(const f32x4*)(misc + (size_t)q * 256 + 64), w1 = *(const f32x4*)(misc + (size_t)q * 256 + 68);
#pragma unroll
          for (int j = 0; j < 4; ++j) { wv[j] = w0[j]; wv[4 + j] = w1[j]; } }
        wave_lds_sync();
        const int nr = (n + 63) & ~63;
        for (int s = lane; s < nr; s += 64) {
            if (s < n) {
                const f32x4* kp = (const f32x4*)(misc + (size_t)(bl * SEQ + s) * 256);
                f32x4 kv[16];
#pragma unroll
                for (int i = 0; i < 16; ++i) kv[i] = kp[i];
                float sc = 0.f;
#pragma unroll
                for (int h = 0; h < 8; ++h) {
                    float d = 0.f;
#pragma unroll
                    for (int i = 0; i < 16; ++i) { const f32x4 qv = *(const f32x4*)(qs + h * 64 + i * 4); d += kv[i][0] * qv[0] + kv[i][1] * qv[1] + kv[i][2] * qv[2] + kv[i][3] * qv[3]; }
                    sc += wv[h] * fmaxf(d, 0.f);
                }
                sk[s] = fkey(sc);
            }
        }
        wave_lds_sync();
        unsigned cur = 0u; int need = 1 << 30;
        if (n > 256) {
            for (int bit = 31; bit >= 0; --bit) {
                const unsigned cand = cur | (1u << bit); int cnt = 0;
                for (int s = lane; s < nr; s += 64) { const bool pr = (s < n) && (sk[s] >= cand); cnt += __popcll(__ballot(pr)); }
                if (cnt >= 256) cur = cand;
            }
            int cgt = 0;
            for (int s = lane; s < nr; s += 64) { const bool pr = (s < n) && (sk[s] > cur); cgt += __popcll(__ballot(pr)); }
            need = 256 - cgt;
        }
        int run_eq = 0, run_sel = 0; unsigned long long mybal = 0ull;
        for (int s = lane, c = 0; s < nr; s += 64, ++c) {
            const bool in = s < n; const unsigned k = in ? sk[s] : 0u;
            const bool gt = in && (k > cur), eq = in && (k == cur);
            const unsigned long long beq = __ballot(eq);
            const int rank = run_eq + __popcll(beq & lt_mask);
            const bool se = gt || (eq && rank < need);
            const unsigned long long bs = __ballot(se);
            const int pos = run_sel + __popcll(bs & lt_mask);
            if (se && pos < 256) sel[(size_t)q * 256 + pos] = s;
            run_eq += __popcll(beq); run_sel += __popcll(bs);
            if (lane == c) mybal = bs;
        }
        u32x2 mw; mw.x = (unsigned)mybal; mw.y = (unsigned)(mybal >> 32);
        *(u32x2*)(mask + (size_t)q * 128 + lane * 2) = mw;
        for (int j = run_sel + lane; j < 256; j += 64) sel[(size_t)q * 256 + j] = -1;
    }
}

__device__ __forceinline__ void phase_att_simple(int wv, bf16_t* proj, const int* sel, unsigned char* shm) {
    const int tid = opaque_tid(wv); const int wave = tid >> 6, lane = tid & 63, h = wave, kvh = h >> 2;
    float* qf = (float*)(shm + wave * 2560); float* pj = qf + 128; int* kj = (int*)(pj + 256);
    const float scale = 0.08838834764831845f;
    for (int q = blockIdx.x; q < SLAB; q += gridDim.x) {
        const int bl = q >> 12;
        wave_lds_sync();
        { const unsigned raw = *(const unsigned*)(proj + (size_t)q * NP + C_Q + h * 128 + 2 * lane); qf[2 * lane] = lo16(raw); qf[2 * lane + 1] = hi16(raw); }
        int keys[4];
#pragma unroll
        for (int i = 0; i < 4; ++i) { keys[i] = sel[(size_t)q * 256 + lane + 64 * i]; kj[lane + 64 * i] = keys[i]; }
        wave_lds_sync();
        float lg[4]; float mx = -INFINITY;
#pragma unroll
        for (int i = 0; i < 4; ++i) {
            lg[i] = -INFINITY;
            if (keys[i] >= 0) {
                const u32x4* kp = (const u32x4*)(proj + (size_t)(bl * SEQ + keys[i]) * NP + C_K + kvh * 128);
                float d = 0.f;
#pragma unroll
                for (int c = 0; c < 16; ++c) {
                    const u32x4 raw = kp[c]; const f32x4 q0 = *(const f32x4*)(qf + c * 8), q1 = *(const f32x4*)(qf + c * 8 + 4);
                    d += lo16(raw.x) * q0[0] + hi16(raw.x) * q0[1] + lo16(raw.y) * q0[2] + hi16(raw.y) * q0[3] + lo16(raw.z) * q1[0] + hi16(raw.z) * q1[1] + lo16(raw.w) * q1[2] + hi16(raw.w) * q1[3];
                }
                lg[i] = d * scale;
            }
            mx = fmaxf(mx, lg[i]);
        }
        mx = wave_max(mx);
        float sm = 0.f; float pe[4];
#pragma unroll
        for (int i = 0; i < 4; ++i) { pe[i] = (keys[i] >= 0) ? __expf(lg[i] - mx) : 0.f; sm += pe[i]; }
        sm = wave_sum(sm);
        const float inv = 1.0f / sm;
#pragma unroll
        for (int i = 0; i < 4; ++i) pj[lane + 64 * i] = pe[i] * inv;
        wave_lds_sync();
        float a0 = 0.f, a1 = 0.f;
        const bf16_t* vb = proj + (size_t)(bl * SEQ) * NP + C_V + kvh * 128 + 2 * lane;
        for (int j0 = 0; j0 < 256; j0 += 16) {
            if (kj[j0] < 0) break;
            unsigned raw[16]; float pv[16];
#pragma unroll
            for (int u = 0; u < 16; ++u) { const int key = max(kj[j0 + u], 0); pv[u] = pj[j0 + u]; raw[u] = *(const unsigned*)(vb + (size_t)key * NP); }
#pragma unroll
            for (int u = 0; u < 16; ++u) { a0 += pv[u] * lo16(raw[u]); a1 += pv[u] * hi16(raw[u]); }
        }
        *(unsigned*)(proj + (size_t)q * NP + C_Q + h * 128 + 2 * lane) = pack2(a0, a1);
    }
}


typedef short bf16x4 __attribute__((ext_vector_type(4)));
__device__ __forceinline__ void phase_idx(int wv, const bf16_t* proj, const float* misc, unsigned* mask, unsigned char* shm) {
    const int tid = opaque_tid(wv), wave = __builtin_amdgcn_readfirstlane(tid >> 6), lane = tid & 63, fr = lane & 15, fq = lane >> 4;
    int* cntbuf = (int*)shm;
    int* cbuf2 = cntbuf + 256;
    volatile int* tieflag = (volatile int*)(shm + 149760);
    for (int it = blockIdx.x; it < 256; it += gridDim.x) {
        for (int pass = 0; pass < 4; ++pass) {
            const int i = (pass == 0) ? it : (pass == 1) ? 511 - it : (pass == 2) ? 512 + it : 1023 - it;
            const int qt = 255 - (i >> 2), bl = i & 3;
            const int q0 = qt * 16, nch = (q0 + 15) / 64 + 1, t = q0 + fr;
            const size_t qrow = (size_t)bl * SEQ + q0 + fr;
            int lb = wave * 64 + fq * 4; asm volatile("" : "+v"(lb));
            u32x4 key[4][4];
            u32x4* klds = (u32x4*)(shm + 18688) + tid;
#define KGET(dst, ip, tt) do { if ((ip) < 4) dst = key[(ip) < 4 ? (ip) : 0][tt]; else dst = klds[(((ip) - 4) * 4 + (tt)) * 512]; } while (0)
            {
                float wv[8];
                { const f32x4 w0 = *(const f32x4*)(misc + qrow * 256 + 64), w1 = *(const f32x4*)(misc + qrow * 256 + 68);
#pragma unroll
                  for (int j = 0; j < 4; ++j) { wv[j] = w0[j]; wv[4 + j] = w1[j]; } }
#pragma unroll
                for (int u = 0; u < 2; ++u) { const int ch = tid + 512 * u, r = ch >> 6, cc = ch & 63;
                    *(u32x4*)(shm + 2048 + r * 1040 + cc * 16) = *(const u32x4*)(proj + ((size_t)bl * SEQ + q0 + r) * NP + C_QI + cc * 8); }
                if (tid == 0) tieflag[0] = 0;
                __syncthreads();
                const unsigned char* ql = shm + 2048 + fr * 1040 + fq * 16;
#pragma unroll
                for (int ip = 0; ip < 8; ++ip) {
                    int c = wave + 8 * ip; asm volatile("" : "+s"(c));
                    if (c < nch) {
                        const int trel = t - (c - wave) * 64 - lb;
                        const bf16_t* kp0 = proj + ((size_t)bl * SEQ + c * 64 + fr) * NP + C_MISC + fq * 8;
#pragma unroll
                        for (int tp = 0; tp < 2; ++tp) {
                            bf16x8 kf[2][2];
#pragma unroll
                            for (int u = 0; u < 2; ++u) { const bf16_t* kp = kp0 + (size_t)((tp * 2 + u) * 16) * NP; kf[u][0] = *(const bf16x8*)kp; kf[u][1] = *(const bf16x8*)(kp + 32); }
                            f32x4 sc[2];
                            sc[0] = (f32x4){0.f, 0.f, 0.f, 0.f}; sc[1] = (f32x4){0.f, 0.f, 0.f, 0.f};
#pragma unroll
                            for (int h = 0; h < 8; ++h) {
                                const bf16x8 q0f = *(const bf16x8*)(ql + h * 128), q1f = *(const bf16x8*)(ql + h * 128 + 64);
#pragma unroll
                                for (int u = 0; u < 2; ++u) {
                                    f32x4 d = __builtin_amdgcn_mfma_f32_16x16x32_bf16(kf[u][0], q0f, (f32x4){0.f, 0.f, 0.f, 0.f}, 0, 0, 0);
                                    d = __builtin_amdgcn_mfma_f32_16x16x32_bf16(kf[u][1], q1f, d, 0, 0, 0);
#pragma unroll
                                    for (int j = 0; j < 4; ++j) sc[u][j] += wv[h] * fmaxf(d[j], 0.f);
                                }
                                if ((h & 3) == 3) asm volatile("" ::: "memory");
                            }
#pragma unroll
                            for (int u = 0; u < 2; ++u) {
                                u32x4 kk;
#pragma unroll
                                for (int j = 0; j < 4; ++j) kk[j] = ((tp * 2 + u) * 16 + j <= trel) ? fkey(sc[u][j]) : 0u;
                                if (ip < 4) key[ip < 4 ? ip : 0][tp * 2 + u] = kk; else klds[((ip - 4) * 4 + tp * 2 + u) * 512] = kk;
                            }
                        }
                    } else if (ip < 4) {
#pragma unroll
                        for (int tt = 0; tt < 4; ++tt) key[ip < 4 ? ip : 0][tt] = (u32x4){0u, 0u, 0u, 0u};
                    }
                    asm volatile("" ::: "memory");
                }
            }
            __syncthreads();
            unsigned cur = 0u;
            bool rdone = (t + 1 <= 256);
            for (int bit = 31; bit >= 0; --bit) {
                if (__ballot(rdone) == ~0ull) break;
                const unsigned cand = cur | (1u << bit);
                int cnt = 0;
#pragma unroll
                for (int hp2 = 0; hp2 < 2; ++hp2) {
                    if (wave + 8 * (4 + 2 * hp2) < nch) {
                        u32x4 kl[8];
#pragma unroll
                        for (int q = 0; q < 8; ++q) kl[q] = klds[(hp2 * 8 + q) * 512];
                        const bool second = (wave + 8 * (5 + 2 * hp2) < nch);
#pragma unroll
                        for (int q = 0; q < 4; ++q)
#pragma unroll
                            for (int j = 0; j < 4; ++j) cnt += (kl[q][j] >= cand) ? 1 : 0;
                        if (second) {
#pragma unroll
                            for (int q = 4; q < 8; ++q)
#pragma unroll
                                for (int j = 0; j < 4; ++j) cnt += (kl[q][j] >= cand) ? 1 : 0;
                        }
                    }
                }
#pragma unroll
                for (int ip = 0; ip < 4; ++ip)
                    if (wave + 8 * ip < nch) {
#pragma unroll
                        for (int tt = 0; tt < 4; ++tt)
#pragma unroll
                            for (int j = 0; j < 4; ++j) cnt += (key[ip][tt][j] >= cand) ? 1 : 0;
                    }
                cnt += __shfl_xor(cnt, 16); cnt += __shfl_xor(cnt, 32);
                int* cb = cntbuf + (bit & 1) * 128;
                if (fq == 0) cb[fr * 8 + wave] = cnt;
                __syncthreads();
                const int4 a = *(const int4*)(cb + fr * 8), b = *(const int4*)(cb + fr * 8 + 4);
                const int tot = a.x + a.y + a.z + a.w + b.x + b.y + b.z + b.w;
                if (!rdone && tot >= 256) { cur = cand; if (tot == 256) rdone = true; }
            }
            int cg = 0, ce = 0;
#pragma unroll
            for (int ip = 0; ip < 8; ++ip)
                if (wave + 8 * ip < nch) {
#pragma unroll
                    for (int tt = 0; tt < 4; ++tt) { u32x4 kv; KGET(kv, ip, tt);
#pragma unroll
                        for (int j = 0; j < 4; ++j) { cg += (kv[j] > cur) ? 1 : 0; ce += (kv[j] == cur) ? 1 : 0; } }
                }
            cg += __shfl_xor(cg, 16); cg += __shfl_xor(cg, 32); ce += __shfl_xor(ce, 16); ce += __shfl_xor(ce, 32);
            if (fq == 0) { cbuf2[fr * 8 + wave] = cg; cbuf2[128 + fr * 8 + wave] = ce; }
            __syncthreads();
            int need, ceq;
            { const int4 a = *(const int4*)(cbuf2 + fr * 8), b = *(const int4*)(cbuf2 + fr * 8 + 4);
              need = 256 - (a.x + a.y + a.z + a.w + b.x + b.y + b.z + b.w);
              const int4 c4 = *(const int4*)(cbuf2 + 128 + fr * 8), d4 = *(const int4*)(cbuf2 + 128 + fr * 8 + 4);
              ceq = c4.x + c4.y + c4.z + c4.w + d4.x + d4.y + d4.z + d4.w; }
            const bool ties = (cur != 0u) && (ceq > need);
            unsigned J = 4095u;
            if (ties) tieflag[0] = 1;
            __syncthreads();
            if (tieflag[0] != 0) {
                unsigned Jt = 0u;
                for (int bit = 11; bit >= 0; --bit) {
                    const unsigned cand = Jt | (1u << bit);
                    const int crel = (int)cand - lb;
                    int cnt = 0;
#pragma unroll
                    for (int ip = 0; ip < 8; ++ip)
                        if (wave + 8 * ip < nch) {
#pragma unroll
                            for (int tt = 0; tt < 4; ++tt) { u32x4 kv; KGET(kv, ip, tt);
#pragma unroll
                                for (int j = 0; j < 4; ++j) cnt += (kv[j] == cur && (ip * 512 + tt * 16 + j) < crel) ? 1 : 0; }
                        }
                    cnt += __shfl_xor(cnt, 16); cnt += __shfl_xor(cnt, 32);
                    int* cb = cntbuf + (bit & 1) * 128;
                    if (fq == 0) cb[fr * 8 + wave] = cnt;
                    __syncthreads();
                    const int4 a = *(const int4*)(cb + fr * 8), b = *(const int4*)(cb + fr * 8 + 4);
                    const int tot = a.x + a.y + a.z + a.w + b.x + b.y + b.z + b.w;
                    if (tot < need) Jt = cand;
                }
                if (ties) J = Jt;
            }
#pragma unroll
            for (int ip = 0; ip < 8; ++ip) {
                const int c = wave + 8 * ip;
                if (c < nch) {
                    unsigned lo = 0u, hi = 0u;
                    const int jrel = (int)J - lb;
#pragma unroll
                    for (int tt = 0; tt < 4; ++tt) { u32x4 kv; KGET(kv, ip, tt);
#pragma unroll
                        for (int j = 0; j < 4; ++j) {
                            const unsigned k = kv[j];
                            const bool se = (k > cur) || (k == cur && cur != 0u && (ip * 512 + tt * 16 + j) <= jrel);
                            const unsigned b = se ? 1u : 0u;
                            if (tt < 2) lo |= b << (tt * 16 + j); else hi |= b << ((tt - 2) * 16 + j);
                        } }
                    lo <<= (lb & 15); hi <<= (lb & 15);
                    lo |= __shfl_xor(lo, 16); lo |= __shfl_xor(lo, 32); hi |= __shfl_xor(hi, 16); hi |= __shfl_xor(hi, 32);
                    if (fq == 0) { u32x2 mw; mw.x = lo; mw.y = hi; *(u32x2*)(mask + qrow * 128 + c * 2) = mw; }
                }
            }
            __syncthreads();
        }
    }
#undef KGET
}

__device__ __forceinline__ void phase_att(int wv, bf16_t* proj, const bf16_t* vt, const unsigned* mask, unsigned char* shm) {
    const int tid = opaque_tid(wv), wave = tid >> 6, lane = tid & 63, fr = lane & 15, fq = lane >> 4;
    const int qs = wave & 3, hp = wave >> 2;
    constexpr int KROW = 272, VROW = 272, KBYTES = 128 * KROW, VBYTES = 128 * VROW, BUF = KBYTES + VBYTES;
    const float sc2 = 0.08838834764831845f * 1.4426950408889634f;
    for (int it = blockIdx.x; it < 256; it += gridDim.x) {
        for (int pass = 0; pass < 2; ++pass) {
            const int i = (pass == 0) ? it : 511 - it;
            const int qb = 63 - (i >> 3), sub = i & 7, bl = sub >> 1, kvh = sub & 1, nkt = qb + 1;
            const size_t qrow = (size_t)bl * SEQ + qb * 64 + qs * 16 + fr;
            bf16x8 qf[2][4];
#pragma unroll
            for (int hh = 0; hh < 2; ++hh)
#pragma unroll
                for (int ks = 0; ks < 4; ++ks) qf[hh][ks] = *(const bf16x8*)(proj + qrow * NP + C_Q + (kvh * 4 + hp * 2 + hh) * 128 + ks * 32 + fq * 8);
            f32x4 o[2][8];
#pragma unroll
            for (int hh = 0; hh < 2; ++hh)
#pragma unroll
                for (int dt = 0; dt < 8; ++dt) o[hh][dt] = (f32x4){0.f, 0.f, 0.f, 0.f};
            float mrow[2] = {-1e30f, -1e30f}, lrow[2] = {0.f, 0.f};
            const int sr0 = tid >> 4, sc = tid & 15;
            const bf16_t* kg = proj + ((size_t)bl * SEQ + sr0) * NP + C_K + kvh * 128 + sc * 8;
            const bf16_t* vg = vt + ((size_t)(bl * 2 + kvh) * 128 + sr0) * SEQ + sc * 8;
            const int klds = sr0 * KROW + sc * 16, vlds = KBYTES + sr0 * VROW + sc * 16;
            const int nst = (nkt + 1) >> 1;
            u32x4 kreg[4], vreg[4];
            __syncthreads();
#pragma unroll
            for (int u = 0; u < 4; ++u) { kreg[u] = *(const u32x4*)(kg + (size_t)(32 * u) * NP); vreg[u] = *(const u32x4*)(vg + (size_t)(32 * u) * SEQ); }
#pragma unroll
            for (int u = 0; u < 4; ++u) { *(u32x4*)(shm + klds + 32 * u * KROW) = kreg[u]; *(u32x4*)(shm + vlds + 32 * u * VROW) = vreg[u]; }
            __syncthreads();
            u32x4 mknext = *(const u32x4*)(mask + qrow * 128);
            for (int st = 0; st < nst; ++st) {
                const unsigned char* sbuf = shm + (st & 1) * BUF;
                const bool more = (st + 1 < nst);
                if (more) {
                    const bf16_t* kg2 = kg + (size_t)(st + 1) * 128 * NP; const bf16_t* vg2 = vg + (st + 1) * 128;
#pragma unroll
                    for (int u = 0; u < 4; ++u) { kreg[u] = *(const u32x4*)(kg2 + (size_t)(32 * u) * NP); vreg[u] = *(const u32x4*)(vg2 + (size_t)(32 * u) * SEQ); }
                }
                const u32x4 mk4 = mknext;
                if (more) mknext = *(const u32x4*)(mask + qrow * 128 + (st + 1) * 4);
#pragma unroll 1
                for (int h2 = 0; h2 < 2; ++h2) {
                if (2 * st + h2 >= nkt) break;
                const unsigned char* buf = sbuf + h2 * 64 * KROW;
                const unsigned char* vbuf = sbuf + KBYTES + h2 * 128;
                const unsigned mlo = (h2 ? mk4.z : mk4.x) >> (fq * 4), mhi = (h2 ? mk4.w : mk4.y) >> (fq * 4);
                f32x4 s[2][4];
#pragma unroll
                for (int nt = 0; nt < 4; ++nt) {
                    s[0][nt] = (f32x4){0.f, 0.f, 0.f, 0.f}; s[1][nt] = (f32x4){0.f, 0.f, 0.f, 0.f};
#pragma unroll
                    for (int ks = 0; ks < 4; ++ks) {
                        const bf16x8 kf = *(const bf16x8*)(buf + (nt * 16 + fr) * KROW + (ks * 32 + fq * 8) * 2);
                        s[0][nt] = __builtin_amdgcn_mfma_f32_16x16x32_bf16(kf, qf[0][ks], s[0][nt], 0, 0, 0);
                        s[1][nt] = __builtin_amdgcn_mfma_f32_16x16x32_bf16(kf, qf[1][ks], s[1][nt], 0, 0, 0);
                    }
                }
                bf16x8 pf[2][2];
                f32x4 bias[4];
#pragma unroll
                for (int nt = 0; nt < 4; ++nt)
#pragma unroll
                    for (int j = 0; j < 4; ++j) { const unsigned w = (nt < 2) ? mlo : mhi; bias[nt][j] = ((w >> ((nt & 1) * 16 + j)) & 1u) ? 0.f : -INFINITY; }
#pragma unroll
                for (int hh = 0; hh < 2; ++hh) {
                    float mx = -INFINITY;
#pragma unroll
                    for (int nt = 0; nt < 4; ++nt)
#pragma unroll
                        for (int j = 0; j < 4; ++j) { const float tv = __builtin_fmaf(s[hh][nt][j], sc2, bias[nt][j]); s[hh][nt][j] = tv; mx = fmaxf(mx, tv); }
                    mx = fmaxf(mx, __shfl_xor(mx, 16)); mx = fmaxf(mx, __shfl_xor(mx, 32));
                    const float mnew = fmaxf(mrow[hh], mx);
                    const float alpha = __builtin_amdgcn_exp2f(mrow[hh] - mnew);
                    mrow[hh] = mnew;
                    float ls = 0.f;
#pragma unroll
                    for (int nt = 0; nt < 4; ++nt)
#pragma unroll
                        for (int j = 0; j < 4; ++j) { const float pv = __builtin_amdgcn_exp2f(s[hh][nt][j] - mnew); s[hh][nt][j] = pv; ls += pv; }
                    lrow[hh] = lrow[hh] * alpha + ls;
                    if (__ballot(alpha != 1.0f) != 0ull) {
#pragma unroll
                        for (int dt = 0; dt < 8; ++dt) o[hh][dt] *= alpha;
                    }
#pragma unroll
                    for (int kk = 0; kk < 2; ++kk) {
                        u32x4 pk;
                        pk.x = pg8::cvt_pk_bf16(s[hh][2 * kk][0], s[hh][2 * kk][1]); pk.y = pg8::cvt_pk_bf16(s[hh][2 * kk][2], s[hh][2 * kk][3]);
                        pk.z = pg8::cvt_pk_bf16(s[hh][2 * kk + 1][0], s[hh][2 * kk + 1][1]); pk.w = pg8::cvt_pk_bf16(s[hh][2 * kk + 1][2], s[hh][2 * kk + 1][3]);
                        pf[hh][kk] = __builtin_bit_cast(bf16x8, pk);
                    }
                }
#pragma unroll
                for (int kk = 0; kk < 2; ++kk)
#pragma unroll
                    for (int dt = 0; dt < 8; ++dt) {
                        const unsigned char* vp = vbuf + (dt * 16 + fr) * VROW + (kk * 32 + fq * 4) * 2;
                        const bf16x4 v0 = *(const bf16x4*)vp, v1 = *(const bf16x4*)(vp + 32);
                        const bf16x8 vf = __builtin_shufflevector(v0, v1, 0, 1, 2, 3, 4, 5, 6, 7);
                        o[0][dt] = __builtin_amdgcn_mfma_f32_16x16x32_bf16(vf, pf[0][kk], o[0][dt], 0, 0, 0);
                        o[1][dt] = __builtin_amdgcn_mfma_f32_16x16x32_bf16(vf, pf[1][kk], o[1][dt], 0, 0, 0);
                    }
                }
                if (more) {
                    unsigned char* nb = shm + ((st + 1) & 1) * BUF;
#pragma unroll
                    for (int u = 0; u < 4; ++u) { *(u32x4*)(nb + klds + 32 * u * KROW) = kreg[u]; *(u32x4*)(nb + vlds + 32 * u * VROW) = vreg[u]; }
                }
                __syncthreads();
            }
#pragma unroll
            for (int hh = 0; hh < 2; ++hh) {
                float lt = lrow[hh]; lt += __shfl_xor(lt, 16); lt += __shfl_xor(lt, 32);
                const float inv = 1.0f / lt;
                bf16_t* op = proj + qrow * NP + C_Q + (kvh * 4 + hp * 2 + hh) * 128 + fq * 4;
#pragma unroll
                for (int dt = 0; dt < 8; ++dt) {
                    u32x2 w; w.x = pg8::cvt_pk_bf16(o[hh][dt][0] * inv, o[hh][dt][1] * inv); w.y = pg8::cvt_pk_bf16(o[hh][dt][2] * inv, o[hh][dt][3] * inv);
                    *(u32x2*)(op + dt * 16) = w;
                }
            }
        }
    }
}

__device__ __forceinline__ void phase_ssd_simple(int wv, KParams p, int l, bf16_t* proj, const float* misc, float* ssq, unsigned char* shm) {
    const int tid = opaque_tid(wv), lane = tid & 63;
    float* xs = (float*)shm; float* Bs = xs + 64 * 64; float* Cs = Bs + 64 * 128; float* dts = Cs + 64 * 128; float* decs = dts + 64; float* ybuf = decs + 64;
    const float* cw = p->ssd_conv_w + (size_t)l * 4 * 3072; const float* cb = p->ssd_conv_b + (size_t)l * 3072;
    for (int item = blockIdx.x; item < 128; item += gridDim.x) {
        const int bl = item >> 5, head = item & 31, g = head >> 3;
        const float Aneg = -__expf(p->ssd_a_log[l * 32 + head]), dtb = p->ssd_dt_bias[l * 32 + head], Dsk = p->ssd_d[l * 32 + head];
        const int pp = tid >> 3, ng = tid & 7;
        float hs[16];
#pragma unroll
        for (int k = 0; k < 16; ++k) hs[k] = 0.f;
        for (int c = 0; c < 64; ++c) {
            const int t0 = c * 64;
            __syncthreads();
            for (int i = 0; i < 40; ++i) {
                const int idx = tid + 512 * i, tok = idx / 320, cc = idx - tok * 320;
                int ch; float* dstp;
                if (cc < 64) { ch = head * 64 + cc; dstp = xs + tok * 64 + cc; }
                else if (cc < 192) { ch = 2048 + g * 128 + (cc - 64); dstp = Bs + tok * 128 + (cc - 64); }
                else { ch = 2560 + g * 128 + (cc - 192); dstp = Cs + tok * 128 + (cc - 192); }
                float a = cb[ch];
#pragma unroll
                for (int j = 0; j < 4; ++j) { const int tt = t0 + tok - 3 + j; if (tt >= 0) a += cw[j * 3072 + ch] * bf2f(proj[(size_t)(bl * SEQ + tt) * NP + C_XBC + ch]); }
                *dstp = silu_f(a);
            }
            if (tid < 64) {
                const float v = misc[(size_t)(bl * SEQ + t0 + tid) * 256 + 72 + head] + dtb;
                const float dt = (v > 20.f) ? v : log1pf(__expf(v));
                dts[tid] = dt; decs[tid] = __expf(dt * Aneg);
            }
            __syncthreads();
            for (int tok = 0; tok < 64; ++tok) {
                const float xv = xs[tok * 64 + pp], dt = dts[tok], dec = decs[tok], xdt = xv * dt;
                float y = 0.f;
#pragma unroll
                for (int k4 = 0; k4 < 4; ++k4) {
                    const f32x4 b4 = *(const f32x4*)(Bs + tok * 128 + ng * 16 + k4 * 4), c4 = *(const f32x4*)(Cs + tok * 128 + ng * 16 + k4 * 4);
#pragma unroll
                    for (int j = 0; j < 4; ++j) { float& hh = hs[k4 * 4 + j]; hh = hh * dec + xdt * b4[j]; y += c4[j] * hh; }
                }
                y += __shfl_xor(y, 1); y += __shfl_xor(y, 2); y += __shfl_xor(y, 4);
                if (ng == 0) ybuf[tok * 65 + pp] = y + Dsk * xv;
            }
            __syncthreads();
#pragma unroll
            for (int i = 0; i < 8; ++i) {
                const int idx = tid + 512 * i, tok = idx >> 6, p2 = idx & 63;
                bf16_t* zp = proj + (size_t)(bl * SEQ + t0 + tok) * NP + C_Z + head * 64 + p2;
                const float yg = ybuf[tok * 65 + p2] * silu_f(bf2f(*zp));
                *zp = f2bf(yg);
                const float s2 = wave_sum(yg * yg);
                if (lane == 0) ssq[(size_t)(bl * SEQ + t0 + tok) * 32 + head] = s2;
            }
        }
    }
}


__device__ __forceinline__ void phase_bcconv(int wv, KParams p, int l, const bf16_t* proj, bf16_t* bc, bf16_t* btg) {
    const int tid = opaque_tid(wv);
    const float* cw = p->ssd_conv_w + (size_t)l * 4 * 3072 + 2048; const float* cb = p->ssd_conv_b + (size_t)l * 3072 + 2048;
    for (int idx = blockIdx.x * 512 + tid; idx < 128 * (SLAB / 16); idx += gridDim.x * 512) {
        const int run = idx >> 7, c = (idx & 127) * 8, t0 = run * 16;
        float wt[4][8], bias[8];
#pragma unroll
        for (int e = 0; e < 8; ++e) { bias[e] = cb[c + e];
#pragma unroll
            for (int j = 0; j < 4; ++j) wt[j][e] = cw[j * 3072 + c + e]; }
        const bf16_t* xb = proj + (size_t)t0 * NP + C_XBC + 2048 + c;
        u32x4 r0 = (u32x4){0u, 0u, 0u, 0u}, r1 = r0, r2 = r0;
        if ((t0 & (SEQ - 1)) != 0) { r0 = *(const u32x4*)(xb - 3 * (ptrdiff_t)NP); r1 = *(const u32x4*)(xb - 2 * (ptrdiff_t)NP); r2 = *(const u32x4*)(xb - (ptrdiff_t)NP); }
        unsigned W[16][4];
#pragma unroll
        for (int tb = 0; tb < 16; tb += 4) {
            u32x4 rn[4];
#pragma unroll
            for (int u = 0; u < 4; ++u) rn[u] = *(const u32x4*)(xb + (size_t)(tb + u) * NP);
#pragma unroll
            for (int u = 0; u < 4; ++u) {
                const unsigned a0[4] = {r0.x, r0.y, r0.z, r0.w}, a1[4] = {r1.x, r1.y, r1.z, r1.w}, a2[4] = {r2.x, r2.y, r2.z, r2.w}, a3[4] = {rn[u].x, rn[u].y, rn[u].z, rn[u].w};
#pragma unroll
                for (int e = 0; e < 4; ++e) {
                    const float lo = bias[2 * e] + wt[0][2 * e] * lo16(a0[e]) + wt[1][2 * e] * lo16(a1[e]) + wt[2][2 * e] * lo16(a2[e]) + wt[3][2 * e] * lo16(a3[e]);
                    const float hi = bias[2 * e + 1] + wt[0][2 * e + 1] * hi16(a0[e]) + wt[1][2 * e + 1] * hi16(a1[e]) + wt[2][2 * e + 1] * hi16(a2[e]) + wt[3][2 * e + 1] * hi16(a3[e]);
                    W[tb + u][e] = pack2(silu_f(lo), silu_f(hi));
                }
                u32x4 o; o.x = W[tb + u][0]; o.y = W[tb + u][1]; o.z = W[tb + u][2]; o.w = W[tb + u][3];
                *(u32x4*)(bc + (size_t)(t0 + tb + u) * 1024 + c) = o;
                r0 = r1; r1 = r2; r2 = rn[u];
            }
        }
        if (c < 512) {
            bf16_t* tp = btg + ((size_t)((t0 >> 12) * 512 + c)) * SEQ + (t0 & (SEQ - 1));
#pragma unroll
            for (int e = 0; e < 4; ++e) {
                u32x4 lo0, lo1, hi0, hi1;
                lo0.x = (W[0][e] & 0xffffu) | (W[1][e] << 16); lo0.y = (W[2][e] & 0xffffu) | (W[3][e] << 16); lo0.z = (W[4][e] & 0xffffu) | (W[5][e] << 16); lo0.w = (W[6][e] & 0xffffu) | (W[7][e] << 16);
                lo1.x = (W[8][e] & 0xffffu) | (W[9][e] << 16); lo1.y = (W[10][e] & 0xffffu) | (W[11][e] << 16); lo1.z = (W[12][e] & 0xffffu) | (W[13][e] << 16); lo1.w = (W[14][e] & 0xffffu) | (W[15][e] << 16);
                hi0.x = (W[0][e] >> 16) | (W[1][e] & 0xffff0000u); hi0.y = (W[2][e] >> 16) | (W[3][e] & 0xffff0000u); hi0.z = (W[4][e] >> 16) | (W[5][e] & 0xffff0000u); hi0.w = (W[6][e] >> 16) | (W[7][e] & 0xffff0000u);
                hi1.x = (W[8][e] >> 16) | (W[9][e] & 0xffff0000u); hi1.y = (W[10][e] >> 16) | (W[11][e] & 0xffff0000u); hi1.z = (W[12][e] >> 16) | (W[13][e] & 0xffff0000u); hi1.w = (W[14][e] >> 16) | (W[15][e] & 0xffff0000u);
                *(u32x4*)(tp + (size_t)(2 * e) * SEQ) = lo0; *(u32x4*)(tp + (size_t)(2 * e) * SEQ + 8) = lo1;
                *(u32x4*)(tp + (size_t)(2 * e + 1) * SEQ) = hi0; *(u32x4*)(tp + (size_t)(2 * e + 1) * SEQ + 8) = hi1;
            }
        }
    }
}

#define SSD_SCAN(cc) do { float* dts_ = dbase + ((cc) & 1) * 384; float* acs_ = dts_ + 128; float* wdec_ = acs_ + 128; \
                const float v0 = dtr0 + dtb, v1 = dtr1 + dtb; \
                const float dt0 = (v0 > 20.f) ? v0 : log1pf(__expf(v0)), dt1 = (v1 > 20.f) ? v1 : log1pf(__expf(v1)); \
                const float a0 = dt0 * Aneg, a1 = dt1 * Aneg; \
                float sc = a0 + a1; \
                _Pragma("unroll") for (int o = 1; o < 64; o <<= 1) { const float tv = __shfl_up(sc, o); if (lane >= o) sc += tv; } \
                const float atot = __shfl(sc, 63); \
                dts_[2 * lane] = dt0; dts_[2 * lane + 1] = dt1; acs_[2 * lane] = sc - a1; acs_[2 * lane + 1] = sc; \
                wdec_[2 * lane] = dt0 * __expf(atot - (sc - a1)); wdec_[2 * lane + 1] = dt1 * __expf(atot - sc); } while (0)
__device__ __forceinline__ void phase_ssd(int wv, KParams p, int l, bf16_t* proj, const float* misc, const bf16_t* bc, const bf16_t* btg, float* ssq, unsigned char* shm, unsigned long long& tacc, unsigned long long& tst) {
    const int tid = opaque_tid(wv), wave = __builtin_amdgcn_readfirstlane(tid >> 6), lane = tid & 63, fr = lane & 15, fq = lane >> 4;
    constexpr int ROW = 272;
    unsigned char* Cr = shm; unsigned char* Br = Cr + 128 * ROW; unsigned char* BT = Br + 128 * ROW;
    unsigned char* XT = BT + 128 * ROW; unsigned char* Hb = XT + 32 * ROW;
    float* wtab = (float*)(Hb + 32 * ROW) + 768;
    float* dbase = (float*)(Hb + 32 * ROW);
    const float* cw = p->ssd_conv_w + (size_t)l * 4 * 3072; const float* cb = p->ssd_conv_b + (size_t)l * 3072;
    for (int item = blockIdx.x; item < 256; item += gridDim.x) {
        const int bl = item >> 6, head = (item >> 1) & 31, ph = item & 1, g = head >> 3;
        const float Aneg = -__expf(p->ssd_a_log[l * 32 + head]), dtb = p->ssd_dt_bias[l * 32 + head], Dsk = p->ssd_d[l * 32 + head];
        const int lx = tid >> 2, cgx = tid & 3, chx = head * 64 + ph * 32 + cgx * 8;
        const int sr = tid >> 4, sc16 = tid & 15;
        f32x4 Hacc[2][2];
#pragma unroll
        for (int q2 = 0; q2 < 2; ++q2) { Hacc[q2][0] = (f32x4){0.f, 0.f, 0.f, 0.f}; Hacc[q2][1] = (f32x4){0.f, 0.f, 0.f, 0.f}; }
        __syncthreads();
        for (int i = tid; i < 32 * ROW / 4; i += 512) ((unsigned*)Hb)[i] = 0u;
        if (tid < 160) { const int cgi = tid / 40, r = tid - cgi * 40, j = r >> 3, chn = head * 64 + ph * 32 + cgi * 8 + (r & 7); wtab[tid] = (j == 0) ? cb[chn] : cw[(j - 1) * 3072 + chn]; }
        __syncthreads();
        u32x4 xr[4], br[12]; float dtr0 = 0.f, dtr1 = 0.f;
        {
            const char* gb = (const char*)(proj + ((ptrdiff_t)bl * SEQ - 3) * NP + C_XBC);
            unsigned vo = (unsigned)((lx * NP + chx) * 2); asm volatile("" : "+v"(vo));
#pragma unroll
            for (int j = 0; j < 4; ++j) { xr[j] = (u32x4){0u, 0u, 0u, 0u}; if (lx - 3 + j >= 0) xr[j] = *(const u32x4*)(gb + (vo + (unsigned)(j * NP * 2))); }
            const char* hb2 = (const char*)(bc + ((size_t)bl * SEQ) * 1024);
            unsigned vb = (unsigned)((sr * 1024 + g * 128 + sc16 * 8) * 2); asm volatile("" : "+v"(vb));
            const char* tb2 = (const char*)(btg + ((size_t)(bl * 512 + g * 128)) * SEQ);
            unsigned vt2 = (unsigned)((sr * SEQ + sc16 * 8) * 2); asm volatile("" : "+v"(vt2));
#pragma unroll
            for (int u = 0; u < 4; ++u) { br[u] = *(const u32x4*)(hb2 + (vb + (unsigned)(u * 32 * 1024 * 2))); br[4 + u] = *(const u32x4*)(hb2 + (vb + (unsigned)(u * 32 * 1024 * 2 + 1024)));
                br[8 + u] = *(const u32x4*)(tb2 + (vt2 + (unsigned)(u * 32 * SEQ * 2))); }
            if (wave == 0) { const float* mp = misc + ((size_t)bl * SEQ + 2 * lane) * 256 + 72 + head; dtr0 = mp[0]; dtr1 = mp[256];
                SSD_SCAN(0);
                dtr0 = mp[128 * 256]; dtr1 = mp[128 * 256 + 256]; }
        }
        for (int c = 0; c < 32; ++c) {
            TIC(12);
            const int t0 = c * 128;
            const size_t rbase = (size_t)bl * SEQ + t0;
            const float* dts = dbase + (c & 1) * 384; const float* acs = dts + 128; const float* wdec = acs + 128;
            {
                float wt[4][8], bias[8];
                { const float* wl = wtab + cgx * 40;
                  const f32x4 b0 = *(const f32x4*)wl, b1 = *(const f32x4*)(wl + 4);
#pragma unroll
                  for (int e = 0; e < 4; ++e) { bias[e] = b0[e]; bias[4 + e] = b1[e]; }
#pragma unroll
                  for (int j = 0; j < 4; ++j) { const f32x4 w0 = *(const f32x4*)(wl + 8 + j * 8), w1 = *(const f32x4*)(wl + 12 + j * 8);
#pragma unroll
                      for (int e = 0; e < 4; ++e) { wt[j][e] = w0[e]; wt[j][4 + e] = w1[e]; } } }
                const unsigned a0[4] = {xr[0].x, xr[0].y, xr[0].z, xr[0].w}, a1[4] = {xr[1].x, xr[1].y, xr[1].z, xr[1].w}, a2[4] = {xr[2].x, xr[2].y, xr[2].z, xr[2].w}, a3[4] = {xr[3].x, xr[3].y, xr[3].z, xr[3].w};
                unsigned char* xp = XT + (cgx * 8) * ROW + lx * 2;
#pragma unroll
                for (int e = 0; e < 4; ++e) {
                    const float lo = bias[2 * e] + wt[0][2 * e] * lo16(a0[e]) + wt[1][2 * e] * lo16(a1[e]) + wt[2][2 * e] * lo16(a2[e]) + wt[3][2 * e] * lo16(a3[e]);
                    const float hi = bias[2 * e + 1] + wt[0][2 * e + 1] * hi16(a0[e]) + wt[1][2 * e + 1] * hi16(a1[e]) + wt[2][2 * e + 1] * hi16(a2[e]) + wt[3][2 * e + 1] * hi16(a3[e]);
                    *(bf16_t*)(xp + (2 * e) * ROW) = f2bf(silu_f(lo)); *(bf16_t*)(xp + (2 * e + 1) * ROW) = f2bf(silu_f(hi));
                }
            }
            {
#pragma unroll
                for (int u = 0; u < 4; ++u) {
                    *(u32x4*)(Br + (sr + 32 * u) * ROW + sc16 * 16) = br[u];
                    *(u32x4*)(Cr + (sr + 32 * u) * ROW + sc16 * 16) = br[4 + u];
                    *(u32x4*)(BT + (sr + 32 * u) * ROW + sc16 * 16) = br[8 + u];
                }
            }
            __syncthreads(); TOC(12); TIC(11);
            {
                const size_t rnext = rbase + ((c + 1 < 32) ? 128 : 0);
                const char* gb = (const char*)(proj + ((ptrdiff_t)rnext - 3) * NP + C_XBC);
                unsigned vo = (unsigned)((lx * NP + chx) * 2); asm volatile("" : "+v"(vo));
#pragma unroll
                for (int j = 0; j < 4; ++j) xr[j] = *(const u32x4*)(gb + (vo + (unsigned)(j * NP * 2)));
                const char* hb2 = (const char*)(bc + rnext * 1024);
                unsigned vb = (unsigned)((sr * 1024 + g * 128 + sc16 * 8) * 2); asm volatile("" : "+v"(vb));
                const char* tb2 = (const char*)(btg + ((size_t)(bl * 512 + g * 128)) * SEQ + (rnext - (size_t)bl * SEQ));
                unsigned vt2 = (unsigned)((sr * SEQ + sc16 * 8) * 2); asm volatile("" : "+v"(vt2));
#pragma unroll
                for (int u = 0; u < 4; ++u) { br[u] = *(const u32x4*)(hb2 + (vb + (unsigned)(u * 32 * 1024 * 2))); br[4 + u] = *(const u32x4*)(hb2 + (vb + (unsigned)(u * 32 * 1024 * 2 + 1024)));
                    br[8 + u] = *(const u32x4*)(tb2 + (vt2 + (unsigned)(u * 32 * SEQ * 2))); }
            }
            {
                const int lt = (wave < 4) ? wave : 11 - wave;
                bf16_t* zp = proj + (rbase + lt * 16 + fr) * NP + C_Z + head * 64 + ph * 32 + fq * 4;
                const u32x2 zr0 = *(const u32x2*)zp, zr1 = *(const u32x2*)(zp + 16);
                const float acs_l = acs[lt * 16 + fr];
                bf16x8 cf[4];
#pragma unroll
                for (int ks = 0; ks < 4; ++ks) cf[ks] = *(const bf16x8*)(Cr + (lt * 16 + fr) * ROW + (ks * 32 + fq * 8) * 2);
                f32x4 yacc[2];
                {
                    bf16x8 hf[2][4];
#pragma unroll
                    for (int pt = 0; pt < 2; ++pt)
#pragma unroll
                        for (int ks = 0; ks < 4; ++ks) hf[pt][ks] = *(const bf16x8*)(Hb + (pt * 16 + fr) * ROW + (ks * 32 + fq * 8) * 2);
                    const float el = __expf(acs_l);
#pragma unroll
                    for (int pt = 0; pt < 2; ++pt) {
                        yacc[pt] = (f32x4){0.f, 0.f, 0.f, 0.f};
#pragma unroll
                        for (int ks = 0; ks < 4; ++ks) yacc[pt] = __builtin_amdgcn_mfma_f32_16x16x32_bf16(hf[pt][ks], cf[ks], yacc[pt], 0, 0, 0);
                        yacc[pt] *= el;
                    }
                    __builtin_amdgcn_sched_group_barrier(0x100, 12, 0); __builtin_amdgcn_sched_group_barrier(0x008, 8, 0);
                }
                const int lloc = fr - fq * 4;
                f32x4 cbt[8];
#pragma unroll
                for (int kk = 0; kk < 4; ++kk) {
                    cbt[2 * kk] = (f32x4){0.f, 0.f, 0.f, 0.f}; cbt[2 * kk + 1] = (f32x4){0.f, 0.f, 0.f, 0.f};
                    if (2 * kk <= lt) {
                        bf16x8 bfr[2][4];
#pragma unroll
                        for (int h2 = 0; h2 < 2; ++h2)
#pragma unroll
                            for (int ks = 0; ks < 4; ++ks) bfr[h2][ks] = *(const bf16x8*)(Br + ((2 * kk + h2) * 16 + fr) * ROW + (ks * 32 + fq * 8) * 2);
#pragma unroll
                        for (int ks = 0; ks < 4; ++ks) {
                            cbt[2 * kk] = __builtin_amdgcn_mfma_f32_16x16x32_bf16(bfr[0][ks], cf[ks], cbt[2 * kk], 0, 0, 0);
                            cbt[2 * kk + 1] = __builtin_amdgcn_mfma_f32_16x16x32_bf16(bfr[1][ks], cf[ks], cbt[2 * kk + 1], 0, 0, 0);
                        }
                        __builtin_amdgcn_sched_group_barrier(0x100, 8, 0); __builtin_amdgcn_sched_group_barrier(0x008, 8, 0);
                    }
                }
                unsigned mp[8][2];
#pragma unroll
                for (int st = 0; st < 8; ++st) {
                    mp[st][0] = 0u; mp[st][1] = 0u;
                    if (st <= lt) {
                        const f32x4 av = *(const f32x4*)(acs + st * 16 + fq * 4), dv = *(const f32x4*)(dts + st * 16 + fq * 4);
                        float mv[4];
#pragma unroll
                        for (int r = 0; r < 4; ++r) {
                            const int dl = (lt - st) * 16 + lloc - r;
                            float m = (dl >= 0) ? cbt[st][r] * __expf(acs_l - av[r]) * dv[r] : 0.f;
                            if (dl == 0) m += Dsk;
                            mv[r] = m;
                        }
                        mp[st][0] = pg8::cvt_pk_bf16(mv[0], mv[1]); mp[st][1] = pg8::cvt_pk_bf16(mv[2], mv[3]);
                    }
                }
#pragma unroll
                for (int kk = 0; kk < 4; ++kk) {
                    if (2 * kk <= lt) {
                        u32x4 pk; pk.x = mp[2 * kk][0]; pk.y = mp[2 * kk][1]; pk.z = mp[2 * kk + 1][0]; pk.w = mp[2 * kk + 1][1];
                        const bf16x8 pf = __builtin_bit_cast(bf16x8, pk);
#pragma unroll
                        for (int pt = 0; pt < 2; ++pt) {
                            const unsigned char* xp = XT + (pt * 16 + fr) * ROW + (kk * 32 + fq * 4) * 2;
                            const bf16x4 v0 = *(const bf16x4*)xp, v1 = *(const bf16x4*)(xp + 32);
                            const bf16x8 xf = __builtin_shufflevector(v0, v1, 0, 1, 2, 3, 4, 5, 6, 7);
                            yacc[pt] = __builtin_amdgcn_mfma_f32_16x16x32_bf16(xf, pf, yacc[pt], 0, 0, 0);
                        }
                    }
                }
                float sq = 0.f;
#pragma unroll
                for (int pt = 0; pt < 2; ++pt) {
                    const u32x2 zr = pt ? zr1 : zr0;
                    const float y0 = yacc[pt][0] * silu_f(lo16(zr.x)), y1 = yacc[pt][1] * silu_f(hi16(zr.x)), y2 = yacc[pt][2] * silu_f(lo16(zr.y)), y3 = yacc[pt][3] * silu_f(hi16(zr.y));
                    sq += y0 * y0 + y1 * y1 + y2 * y2 + y3 * y3;
                    u32x2 w; w.x = pg8::cvt_pk_bf16(y0, y1); w.y = pg8::cvt_pk_bf16(y2, y3);
                    *(u32x2*)(zp + pt * 16) = w;
                }
                sq += __shfl_xor(sq, 16); sq += __shfl_xor(sq, 32);
                if (fq == 0) ssq[(rbase + lt * 16 + fr) * 64 + head * 2 + ph] = sq;
                if (wave < 4) {
                    const float dec = __expf(acs[127]);
#pragma unroll
                    for (int q2 = 0; q2 < 2; ++q2) { Hacc[q2][0] *= dec; Hacc[q2][1] *= dec; }
#pragma unroll
                    for (int ks = 0; ks < 4; ++ks) {
                        const f32x4 w0 = *(const f32x4*)(wdec + ks * 32 + fq * 8), w1 = *(const f32x4*)(wdec + ks * 32 + fq * 8 + 4);
                        bf16x8 xw[2];
#pragma unroll
                        for (int pt = 0; pt < 2; ++pt) {
                            const u32x4 raw = *(const u32x4*)(XT + (pt * 16 + fr) * ROW + (ks * 32 + fq * 8) * 2);
                            u32x4 sc4;
                            sc4.x = pg8::cvt_pk_bf16(lo16(raw.x) * w0[0], hi16(raw.x) * w0[1]); sc4.y = pg8::cvt_pk_bf16(lo16(raw.y) * w0[2], hi16(raw.y) * w0[3]);
                            sc4.z = pg8::cvt_pk_bf16(lo16(raw.z) * w1[0], hi16(raw.z) * w1[1]); sc4.w = pg8::cvt_pk_bf16(lo16(raw.w) * w1[2], hi16(raw.w) * w1[3]);
                            xw[pt] = __builtin_bit_cast(bf16x8, sc4);
                        }
#pragma unroll
                        for (int q2 = 0; q2 < 2; ++q2) {
                            const bf16x8 btf = *(const bf16x8*)(BT + ((wave * 2 + q2) * 16 + fr) * ROW + (ks * 32 + fq * 8) * 2);
                            Hacc[q2][0] = __builtin_amdgcn_mfma_f32_16x16x32_bf16(xw[0], btf, Hacc[q2][0], 0, 0, 0);
                            Hacc[q2][1] = __builtin_amdgcn_mfma_f32_16x16x32_bf16(xw[1], btf, Hacc[q2][1], 0, 0, 0);
                        }
                    }
                }
            }
            TOC(11); TIC(13);
            if (wave == 0 && c + 1 < 32) {
                SSD_SCAN(c + 1);
                if (c + 2 < 32) { const float* mp = misc + (rbase + 256 + 2 * lane) * 256 + 72 + head; dtr0 = mp[0]; dtr1 = mp[256]; }
            }
            __syncthreads();
            if (wave < 4) {
#pragma unroll
                for (int q2 = 0; q2 < 2; ++q2)
#pragma unroll
                    for (int pt = 0; pt < 2; ++pt)
#pragma unroll
                        for (int r = 0; r < 4; ++r) *(bf16_t*)(Hb + (pt * 16 + fq * 4 + r) * ROW + ((wave * 2 + q2) * 16 + fr) * 2) = f2bf(Hacc[q2][pt][r]);
            }
            TOC(13);
        }
    }
}

#undef SSD_SCAN
__device__ __forceinline__ void phase_gtab(int wv, const float* ssq, float* gtab) {
    const int tid = opaque_tid(wv);
    pg8::StaticOrder S; S.init(SLAB, 1024, (int)gridDim.x, (int)blockIdx.x);
    pg8::Unit u;
    for (int ui = 0; ui < 4 && S.next(ui, u); ++ui) {
        if (tid < 256) {
            const float* sp = ssq + (size_t)(u.pm * 256 + tid) * 64;
            float r[4];
#pragma unroll
            for (int g = 0; g < 4; ++g) {
                const f32x4 s0 = *(const f32x4*)(sp + g * 16), s1 = *(const f32x4*)(sp + g * 16 + 4), s2 = *(const f32x4*)(sp + g * 16 + 8), s3 = *(const f32x4*)(sp + g * 16 + 12);
                const float tot = s0[0] + s0[1] + s0[2] + s0[3] + s1[0] + s1[1] + s1[2] + s1[3] + s2[0] + s2[1] + s2[2] + s2[3] + s3[0] + s3[1] + s3[2] + s3[3];
                r[g] = rsqrtf(tot * (1.0f / 512.0f) + EPS);
            }
            float* tp = gtab + ui * 1024 + tid;
            tp[0] = r[0] / r[1]; tp[256] = r[1] / r[2]; tp[512] = r[2] / r[3]; tp[768] = r[3];
        }
    }
    __syncthreads();
}

__device__ __forceinline__ void phase_convglu(int wv, const bf16_t* U, bf16_t* GL, const float* cw, const float* cb) {
    const int tid = opaque_tid(wv);
    for (int idx = blockIdx.x * 512 + tid; idx < 352 * (SLAB / 32); idx += gridDim.x * 512) {
        const int run = idx / 352, f = (idx - run * 352) * 8, t0 = run * 32;
        float wg[3][8], wvv[3][8], bg[8], bv[8];
#pragma unroll
        for (int e = 0; e < 8; ++e) { bg[e] = cb[f + e]; bv[e] = cb[FFN + f + e];
#pragma unroll
            for (int j = 0; j < 3; ++j) { wg[j][e] = cw[j * FFN2 + f + e]; wvv[j][e] = cw[j * FFN2 + FFN + f + e]; } }
        u32x4 g0 = (u32x4){0u, 0u, 0u, 0u}, g1 = g0, v0 = g0, v1 = g0;
        if ((t0 & (SEQ - 1)) != 0) {
            const bf16_t* up = U + (size_t)(t0 - 2) * FFN2 + f;
            g0 = *(const u32x4*)up; v0 = *(const u32x4*)(up + FFN); g1 = *(const u32x4*)(up + FFN2); v1 = *(const u32x4*)(up + FFN2 + FFN);
        }
        for (int tb = 0; tb < 32; tb += 8) {
            u32x4 gn[8], vn[8];
#pragma unroll
            for (int u = 0; u < 8; ++u) { const bf16_t* up = U + (size_t)(t0 + tb + u) * FFN2 + f; gn[u] = *(const u32x4*)up; vn[u] = *(const u32x4*)(up + FFN); }
#pragma unroll
            for (int u = 0; u < 8; ++u) {
                const unsigned ga0[4] = {g0.x, g0.y, g0.z, g0.w}, ga1[4] = {g1.x, g1.y, g1.z, g1.w}, ga2[4] = {gn[u].x, gn[u].y, gn[u].z, gn[u].w};
                const unsigned va0[4] = {v0.x, v0.y, v0.z, v0.w}, va1[4] = {v1.x, v1.y, v1.z, v1.w}, va2[4] = {vn[u].x, vn[u].y, vn[u].z, vn[u].w};
                unsigned ow[4];
#pragma unroll
                for (int e = 0; e < 4; ++e) {
                    const float gl = bg[2 * e] + wg[0][2 * e] * lo16(ga0[e]) + wg[1][2 * e] * lo16(ga1[e]) + wg[2][2 * e] * lo16(ga2[e]);
                    const float gh = bg[2 * e + 1] + wg[0][2 * e + 1] * hi16(ga0[e]) + wg[1][2 * e + 1] * hi16(ga1[e]) + wg[2][2 * e + 1] * hi16(ga2[e]);
                    const float vl = bv[2 * e] + wvv[0][2 * e] * lo16(va0[e]) + wvv[1][2 * e] * lo16(va1[e]) + wvv[2][2 * e] * lo16(va2[e]);
                    const float vh = bv[2 * e + 1] + wvv[0][2 * e + 1] * hi16(va0[e]) + wvv[1][2 * e + 1] * hi16(va1[e]) + wvv[2][2 * e + 1] * hi16(va2[e]);
                    ow[e] = pack2(silu_f(gl) * vl, silu_f(gh) * vh);
                }
                u32x4 o; o.x = ow[0]; o.y = ow[1]; o.z = ow[2]; o.w = ow[3];
                *(u32x4*)(GL + (size_t)(t0 + tb + u) * FFN + f) = o;
                g0 = g1; g1 = gn[u]; v0 = v1; v1 = vn[u];
            }
        }
    }
}

__device__ __forceinline__ KParams kparams() { KParams k = (KParams)__builtin_amdgcn_kernarg_segment_ptr(); asm volatile("" : "+s"(k)); return k; }
#define WSP(T, off) ((T*)(kparams()->ws + (off)))

__global__ void __launch_bounds__(512, 2) mega(Params p_unused) {
    extern __shared__ __attribute__((aligned(16))) unsigned char shm[];
    cg::grid_group grid = cg::this_grid();
    const int wv = __builtin_amdgcn_readfirstlane((int)(threadIdx.x >> 6));
    LAS unsigned char* lds = (LAS unsigned char*)shm;
    unsigned long long tacc = 0ull, tst = 0ull;

#define NORM_MIX(l_, half_) do { KParams k_ = kparams(); const float* xi_ = ((l_) == 0) ? k_->x : k_->out; \
        phase_norm<false>(wv, xi_ + (size_t)(half_) * SLAB * 1024, k_->norm_mix_w + (l_) * 1024, WSP(bf16_t, OFF_H), nullptr, SLAB); } while (0)
#define NORM_FFN(l_, half_) do { KParams k_ = kparams(); \
        phase_norm<false>(wv, k_->out + (size_t)(half_) * SLAB * 1024, k_->norm_ffn_w + (l_) * 1024, WSP(bf16_t, OFF_H), nullptr, SLAB); } while (0)
    TIC(9); phase_convert(wv, kparams(), (float*)shm);
    NORM_MIX(0, 0);
    grid.sync(); TOC(9);
    for (int l = 0; l < DEPTH; ++l) {
        for (int half = 0; half < NSLAB; ++half) {
            const size_t r0 = (size_t)half * SLAB;
            TIC(1);
            { const float* rope = WSP(const float, OFF_ROPE);
              EpiInProj E{WSP(bf16_t, OFF_PROJ), WSP(float, OFF_MISC), rope, rope + 4096 * 16, rope + 4096 * 32, rope + 4096 * 40, WSP(bf16_t, OFF_VT)};
              pg8::gemm_phase(wv, lds, WSP(const bf16_t, OFF_H), 1024, WSP(const bf16_t, OFF_W + (size_t)l * SZ_WL), SLAB, NP, 1024, E); }
            grid.sync(); TOC(1); TIC(2);
            phase_bcconv(wv, kparams(), l, WSP(const bf16_t, OFF_PROJ), WSP(bf16_t, OFF_H), WSP(bf16_t, OFF_BTG));
            phase_idx(wv, WSP(const bf16_t, OFF_PROJ), WSP(const float, OFF_MISC), WSP(unsigned, OFF_MASK), shm);
            grid.sync(); TOC(2); TIC(3);
            phase_att(wv, WSP(bf16_t, OFF_PROJ), WSP(const bf16_t, OFF_VT), WSP(const unsigned, OFF_MASK), shm);
            __syncthreads(); TOC(3); TIC(4);
            { phase_ssd(wv, kparams(), l, WSP(bf16_t, OFF_PROJ), WSP(const float, OFF_MISC), WSP(const bf16_t, OFF_H), WSP(const bf16_t, OFF_BTG), WSP(float, OFF_SSQ), shm, tacc, tst); }
            TOC(4); TIC(10); grid.sync(); TOC(10); TIC(5);
            phase_gtab(wv, WSP(const float, OFF_SSQ), (float*)(shm + 131072));
            { EpiGateA E{WSP(bf16_t, OFF_PROJ)}; pg8::gemm_phase(wv, lds, WSP(const bf16_t, OFF_PROJ) + C_Q, NP, WSP(const bf16_t, OFF_W + (size_t)l * SZ_WL + SZ_WIN), SLAB, 1024, 1024, E); }
            { EpiGateS E{WSP(bf16_t, OFF_PROJ), (const float*)(shm + 131072)}; pg8::gemm_phase(wv, lds, WSP(const bf16_t, OFF_PROJ) + C_Z, NP, WSP(const bf16_t, OFF_W + (size_t)l * SZ_WL + SZ_WIN + SZ_WPA), SLAB, 1024, 2048, E); }
            grid.sync();
            { KParams k = kparams(); const float* xin = (l == 0) ? k->x : k->out;
              EpiResid E{xin + r0 * 1024, k->out + r0 * 1024};
              pg8::gemm_phase(wv, lds, WSP(const bf16_t, OFF_PROJ) + C_GS, NP, WSP(const bf16_t, OFF_W + (size_t)l * SZ_WL + SZ_WIN + SZ_WPA + SZ_WPS), SLAB, 1024, 1024, E); }
            if (half == 0) NORM_MIX(l, 1); else NORM_FFN(l, 0);
            grid.sync(); TOC(5);
        }
        for (int half = 0; half < NSLAB; ++half) {
            const size_t r0 = (size_t)half * SLAB;
            TIC(6);
            { EpiBf16 E{WSP(bf16_t, OFF_PROJ), FFN2};
              pg8::gemm_phase(wv, lds, WSP(const bf16_t, OFF_H), 1024, WSP(const bf16_t, OFF_W + (size_t)l * SZ_WL + SZ_WIN + SZ_WPA + SZ_WPS + SZ_WO), SLAB, FFN2, 1024, E); }
            grid.sync(); TOC(6); TIC(7);
            { KParams k = kparams(); phase_convglu(wv, WSP(const bf16_t, OFF_PROJ), WSP(bf16_t, OFF_GL), k->ffn_conv_w + (size_t)l * 3 * FFN2, k->ffn_conv_b + (size_t)l * FFN2); }
            grid.sync(); TOC(7); TIC(6);
            { KParams k = kparams(); EpiResid E{k->out + r0 * 1024, k->out + r0 * 1024};
              pg8::gemm_phase(wv, lds, WSP(const bf16_t, OFF_GL), FFN, WSP(const bf16_t, OFF_W + (size_t)l * SZ_WL + SZ_WIN + SZ_WPA + SZ_WPS + SZ_WO + SZ_WUP), SLAB, 1024, FFN, E); }
            if (half == 0) NORM_FFN(l, 1); else if (l + 1 < DEPTH) NORM_MIX(l + 1, 0);
            grid.sync(); TOC(6);
        }
    }
    { KParams k = kparams(); phase_norm<true>(wv, k->out, k->norm_final_w, nullptr, k->out, NTOK); }
    if (PROBE != 0 && blockIdx.x == 0) { const unsigned long long tend = __builtin_amdgcn_s_memrealtime() + 4ull * tacc; while (__builtin_amdgcn_s_memrealtime() < tend) __builtin_amdgcn_s_sleep(8); }
}

extern "C" void kernel_launch(void* const* d_in, const int* in_sizes, int n_in, void* d_out, int out_size, void* d_ws, size_t ws_size, hipStream_t stream) {
    static int grid_blocks = 0;
    if (!grid_blocks) {
        int dev = 0, cus = 0, per_cu = 0;
        hipGetDevice(&dev);
        hipDeviceGetAttribute(&cus, hipDeviceAttributeMultiprocessorCount, dev);
        hipFuncSetAttribute((const void*)mega, hipFuncAttributeMaxDynamicSharedMemorySize, LDS_BYTES);
        hipOccupancyMaxActiveBlocksPerMultiprocessor(&per_cu, mega, 512, LDS_BYTES);
        if (per_cu < 1) per_cu = 1;
        grid_blocks = cus * 1;
    }
    if (ws_size < OFF_END) { fprintf(stderr, "workspace too small: %zu < %zu\n", ws_size, (size_t)OFF_END); return; }
    Params p{};
    p.x = (const float*)d_in[0]; p.norm_mix_w = (const float*)d_in[1]; p.w_in = (const float*)d_in[2]; p.ssd_conv_w = (const float*)d_in[3]; p.ssd_conv_b = (const float*)d_in[4];
    p.ssd_dt_bias = (const float*)d_in[5]; p.ssd_a_log = (const float*)d_in[6]; p.ssd_d = (const float*)d_in[7]; p.ssd_norm_w = (const float*)d_in[8];
    p.w_proj_attn = (const float*)d_in[9]; p.w_proj_ssd = (const float*)d_in[10]; p.w_out = (const float*)d_in[11]; p.norm_ffn_w = (const float*)d_in[12];
    p.ffn_w_up = (const float*)d_in[13]; p.ffn_conv_w = (const float*)d_in[14]; p.ffn_conv_b = (const float*)d_in[15]; p.ffn_w_down = (const float*)d_in[16]; p.norm_final_w = (const float*)d_in[17];
    p.out = (float*)d_out; p.ws = (unsigned char*)d_ws;
    for (int i = 0; i < 16; ++i) p.invA[i] = powf(500000.0f, -(float)(2 * i) / 32.0f);
    for (int i = 0; i < 8; ++i) p.invI[i] = powf(500000.0f, -(float)(2 * i) / 16.0f);
    void* args[] = {&p};
    hipError_t e = hipLaunchCooperativeKernel((const void*)mega, dim3(grid_blocks), dim3(512), args, LDS_BYTES, stream);
    if (e != hipSuccess) fprintf(stderr, "cooperative launch failed: %s (grid %d)\n", hipGetErrorString(e), grid_blocks);
}
```

```cpp
#include <hip/hip_runtime.h>
#include <hip/hip_cooperative_groups.h>
#include <cstdio>
#include <cmath>
namespace cg = cooperative_groups;

#define LAS __attribute__((address_space(3)))
typedef unsigned short bf16_t;
typedef short bf16x8 __attribute__((ext_vector_type(8)));
typedef float f32x4 __attribute__((ext_vector_type(4)));
typedef unsigned u32x2 __attribute__((ext_vector_type(2)));
typedef unsigned u32x4 __attribute__((ext_vector_type(4)));

constexpr int D_MODEL = 1024, SEQ = 4096, NTOK = 32768, SLAB = 16384, NSLAB = 2, DEPTH = 2;
constexpr int IN_COLS = 9320, NP = 9472;
constexpr int C_Q = 0, C_K = 1024, C_V = 1280, C_QI = 1536, C_MISC = 2048, C_Z = 2304, C_XBC = 4352, C_GA = 7424, C_GS = 8448;
constexpr int FFN = 2816, FFN2 = 5632;
constexpr float EPS = 1e-6f;

constexpr size_t SZ_WIN = (size_t)NP * 1024 * 2, SZ_WPA = (size_t)1024 * 1024 * 2, SZ_WPS = (size_t)1024 * 2048 * 2, SZ_WO = SZ_WPA,
                 SZ_WUP = (size_t)FFN2 * 1024 * 2, SZ_WDN = (size_t)1024 * FFN * 2;
constexpr size_t SZ_WL = SZ_WIN + SZ_WPA + SZ_WPS + SZ_WO + SZ_WUP + SZ_WDN;
constexpr size_t OFF_W = 0;
constexpr size_t OFF_ROPE = OFF_W + 2 * SZ_WL;
constexpr size_t OFF_H = OFF_ROPE + (size_t)4096 * 48 * 4;
constexpr size_t OFF_PROJ = OFF_H + (size_t)SLAB * 1024 * 2;
constexpr size_t OFF_MISC = OFF_PROJ + (size_t)SLAB * NP * 2;
constexpr size_t OFF_MASK = OFF_MISC + (size_t)SLAB * 256 * 4;
constexpr size_t OFF_SEL = OFF_MASK + (size_t)SLAB * 128 * 4;
constexpr size_t OFF_SSQ = OFF_SEL + (size_t)SLAB * 256 * 4;
constexpr size_t OFF_VT = OFF_SSQ + (size_t)SLAB * 64 * 4;
constexpr size_t OFF_BTG = OFF_VT + (size_t)4 * 2 * 128 * 4096 * 2;
constexpr size_t OFF_END = OFF_BTG + (size_t)4 * 512 * 4096 * 2;
static_assert(OFF_END <= (size_t)536870912, "workspace budget");
constexpr size_t OFF_GL = OFF_PROJ + (size_t)SLAB * FFN2 * 2;

constexpr int LDS_BYTES = 150528;
#ifndef PROBE
#define PROBE 0
#endif
#define TIC(k) do { if (PROBE == (k)) tst = __builtin_amdgcn_s_memrealtime(); } while (0)
#define TOC(k) do { if (PROBE == (k)) tacc += __builtin_amdgcn_s_memrealtime() - tst; } while (0)

struct Params {
    const float* x; const float* norm_mix_w; const float* w_in; const float* ssd_conv_w; const float* ssd_conv_b;
    const float* ssd_dt_bias; const float* ssd_a_log; const float* ssd_d; const float* ssd_norm_w;
    const float* w_proj_attn; const float* w_proj_ssd; const float* w_out; const float* norm_ffn_w;
    const float* ffn_w_up; const float* ffn_conv_w; const float* ffn_conv_b; const float* ffn_w_down; const float* norm_final_w;
    float* out; unsigned char* ws;
    float invA[16]; float invI[8];
};
typedef const __attribute__((address_space(4))) Params* KParams;

__device__ __forceinline__ int opaque_tid(int wv) { int t; asm volatile("v_mbcnt_lo_u32_b32 %0, -1, 0\n\tv_mbcnt_hi_u32_b32 %0, -1, %0" : "=v"(t)); return wv * 64 + t; }
__device__ __forceinline__ float bf2f(bf16_t b) { return __uint_as_float(((unsigned)b) << 16); }
__device__ __forceinline__ bf16_t f2bf(float f) { unsigned u = __float_as_uint(f); u += 0x7FFFu + ((u >> 16) & 1u); return (bf16_t)(u >> 16); }
__device__ __forceinline__ unsigned pack2(float lo, float hi) { return (unsigned)f2bf(lo) | ((unsigned)f2bf(hi) << 16); }
__device__ __forceinline__ float lo16(unsigned w) { return __uint_as_float(w << 16); }
__device__ __forceinline__ float hi16(unsigned w) { return __uint_as_float(w & 0xffff0000u); }
__device__ __forceinline__ float silu_f(float v) { return v * __builtin_amdgcn_rcpf(1.0f + __expf(-v)); }
__device__ __forceinline__ float sigmoid_f(float v) { return __builtin_amdgcn_rcpf(1.0f + __expf(-v)); }
__device__ __forceinline__ void wave_lds_sync() { __builtin_amdgcn_fence(__ATOMIC_SEQ_CST, "wavefront"); __builtin_amdgcn_wave_barrier(); }
__device__ __forceinline__ float wave_sum(float v) {
#pragma unroll
    for (int o = 32; o >= 1; o >>= 1) v += __shfl_xor(v, o);
    return v;
}
__device__ __forceinline__ float wave_max(float v) {
#pragma unroll
    for (int o = 32; o >= 1; o >>= 1) v = fmaxf(v, __shfl_xor(v, o));
    return v;
}
__device__ __forceinline__ int permA(int s) { return 16 * ((s >> 2) & 1) + 4 * (s >> 3) + (s & 3); }
__device__ __forceinline__ int permI(int s) { return s < 16 ? 8 * ((s >> 2) & 1) + 4 * (s >> 3) + (s & 3) : s; }
__device__ __forceinline__ int perm32(int rho) { const int n = rho >> 4, i = rho & 15; return 8 * (i >> 2) + 4 * n + (i & 3); }
__device__ __forceinline__ int inproj_map(int n) {
    if (n < C_V) { const int sd = n & 127; return (sd < 32) ? (n & ~127) + permA(sd) : n; }
    if (n < C_QI) return n;
    if (n < C_MISC) { const int r = n - C_QI; return C_QI + (r & ~63) + permI(r & 63); }
    if (n < C_Z) { const int c = n - C_MISC; if (c < 64) return 2048 + permI(c); if (c < 72) return 2112 + (c - 64); if (c < 104) return 7240 + (c - 72); return -1; }
    if (n < C_XBC) return 2120 + (n - C_Z);
    if (n < C_GA) return 4168 + (n - C_XBC);
    if (n < C_GS) return 7272 + (n - C_GA);
    return 8296 + (n - C_GS);
}

namespace pg8 {
constexpr int BM = 256, BK = 64, HALF = 128, HTB = HALF * BK * 2, NXCD = 8, WGM = 8;
__device__ __forceinline__ int lds_byte(int r, int c) { const int st = (r >> 4) * 2 + (c >> 5), rr = r & 15, cc = c & 31, ob = rr * 64 + cc * 2; return st * 1024 + (ob ^ (((ob >> 9) & 1) << 5)); }
__device__ __forceinline__ void stage_rc(int b, int& R, int& C) { const int st = b / 1024, sb = b % 1024, swz = sb ^ (((sb >> 9) & 1) << 5); R = (st >> 1) * 16 + swz / 64; C = (st & 1) * 32 + (swz % 64) / 2; }
struct Unit { int pm, pn; };
struct StaticOrder {
    int nM, nN, nwg, G, c;
    __device__ void init(int M, int N, int G_, int c_) { nM = M / BM; nN = N / BM; nwg = nM * nN; G = G_; c = c_; }
    __device__ bool next(int i, Unit& u) const {
        const long L = (long)i * G + c; if (L >= nwg) return false;
        int wgid = (int)L; { const int q = nwg / NXCD, r = nwg % NXCD, xcd = wgid % NXCD, off = wgid / NXCD; wgid = (xcd < r ? xcd * (q + 1) : r * (q + 1) + (xcd - r) * q) + off; }
        const int nig = WGM * nN, gid = wgid / nig, fm = gid * WGM, gsz = (nM - fm) < WGM ? (nM - fm) : WGM;
        u.pm = fm + ((wgid % nig) % gsz); u.pn = (wgid % nig) / gsz; return true;
    }
};
__device__ __forceinline__ unsigned cvt_pk_bf16(float lo, float hi) { unsigned r; asm volatile("v_cvt_pk_bf16_f32 %0, %1, %2" : "=v"(r) : "v"(lo), "v"(hi)); return r; }

template <class Epi>
__device__ __forceinline__ void gemm_phase(int wv, LAS unsigned char* lds, const bf16_t* A, int lda, const bf16_t* Bt, int M, int N, int K, const Epi& E) {
    const int tid = opaque_tid(wv), wid = __builtin_amdgcn_readfirstlane(tid >> 6), lane = tid & 63, wr = wid >> 2, wc = wid & 3, fr = lane & 15, fq = lane >> 4;
    const int nt = K / BK;
    StaticOrder S; S.init(M, N, (int)gridDim.x, (int)blockIdx.x);
    unsigned voffA[2], voffB[2];
#pragma unroll
    for (int i = 0; i < 2; ++i) { int R, C; stage_rc(tid * 16 + i * 8192, R, C); voffA[i] = (unsigned)(R * lda + C) * 2u; voffB[i] = (unsigned)(R * K + C) * 2u; }
    const size_t kstep = (size_t)(BK * 2);
    const size_t hstepA = (size_t)HALF * lda * 2, hstepB = (size_t)HALF * K * 2;
    const size_t tstepA = 2 * hstepA, tstepB = 2 * hstepB;
    const unsigned ldsw = (unsigned)wid * 1024u;
    const int aoff = lds_byte(wr * 64 + fr, fq * 8), boff = lds_byte(wc * 32 + fr, fq * 8);
#define PG8_SA(b, h) (((b) * 2 + (h)) * HTB)
#define PG8_SB(b, h) ((4 + (b) * 2 + (h)) * HTB)
#define PG8_STAGE(bufoff, gbase, voff) do { _Pragma("unroll") for (int _i = 0; _i < 2; ++_i) \
        __builtin_amdgcn_global_load_lds((const unsigned*)((const char*)(gbase) + (voff)[_i]), (LAS unsigned*)(lds + (bufoff) + ldsw + _i * 8192), 16, 0, 0); } while (0)
#define PG8_LDA(dst, b, h) do { _Pragma("unroll") for (int m = 0; m < 4; ++m) _Pragma("unroll") for (int k = 0; k < 2; ++k) dst[m][k] = *(const LAS bf16x8*)(lds + PG8_SA(b, h) + aoff + m * 2048 + k * 1024); } while (0)
#define PG8_LDB(dst, b, h) do { _Pragma("unroll") for (int n = 0; n < 2; ++n) _Pragma("unroll") for (int k = 0; k < 2; ++k) dst[n][k] = *(const LAS bf16x8*)(lds + PG8_SB(b, h) + boff + n * 2048 + k * 1024); } while (0)
#define PG8_MMA(ai, bj, At, Bt_) do { __builtin_amdgcn_s_setprio(1); _Pragma("unroll") for (int m = 0; m < 4; ++m) _Pragma("unroll") for (int n = 0; n < 2; ++n) _Pragma("unroll") for (int k = 0; k < 2; ++k) \
        acc[ai][bj][m][n] = __builtin_amdgcn_mfma_f32_16x16x32_bf16(Bt_[n][k], At[m][k], acc[ai][bj][m][n], 0, 0, 0); __builtin_amdgcn_s_setprio(0); } while (0)
#define PG8_WAIT_V(n) asm volatile("s_waitcnt vmcnt(" #n ")" ::: "memory")
#define PG8_WAIT_L(n) asm volatile("s_waitcnt lgkmcnt(" #n ")" ::: "memory")
#define PG8_BAR __builtin_amdgcn_s_barrier()
#define PG8_SCHED __builtin_amdgcn_sched_barrier(0)
    Unit cur, nxt; int ui = 0;
    if (!S.next(0, cur)) return;
    f32x4 acc[2][2][4][2];
#pragma unroll
    for (int a = 0; a < 2; ++a)
#pragma unroll
        for (int b = 0; b < 2; ++b)
#pragma unroll
            for (int m = 0; m < 4; ++m)
#pragma unroll
                for (int n = 0; n < 2; ++n) acc[a][b][m][n] = (f32x4){0.f, 0.f, 0.f, 0.f};
    bf16x8 At[4][2], B0[2][2], B1[2][2];
    const char* cA = (const char*)A + (size_t)cur.pm * tstepA; const char* cB = (const char*)Bt + (size_t)cur.pn * tstepB;
    PG8_STAGE(PG8_SB(0, 0), cB, voffB); PG8_STAGE(PG8_SB(0, 1), cB + hstepB, voffB); PG8_STAGE(PG8_SA(0, 0), cA, voffA); PG8_STAGE(PG8_SA(0, 1), cA + hstepA, voffA);
    if (wr == 1) PG8_BAR;
    PG8_WAIT_V(2); PG8_BAR;
    PG8_STAGE(PG8_SB(1, 0), cB + kstep, voffB); PG8_STAGE(PG8_SA(1, 0), cA + kstep, voffA); PG8_STAGE(PG8_SB(1, 1), cB + hstepB + kstep, voffB);
    PG8_WAIT_V(6); PG8_BAR;
    for (;;) {
        const bool has_next = S.next(ui + 1, nxt);
        const char* nA = has_next ? (const char*)A + (size_t)nxt.pm * tstepA : cA; const char* nB = has_next ? (const char*)Bt + (size_t)nxt.pn * tstepB : cB;
        const int TG = Epi::GS ? 8 : nt;
        for (int tg = 0; tg < nt; tg += TG) {
        for (int t = tg; t < tg + TG; t += 2) {
            const bool last = (t == nt - 2);
            const char* a1 = cA + (size_t)(t + 1) * kstep;
            const char* a2 = last ? nA : cA + (size_t)(t + 2) * kstep; const char* b2 = last ? nB : cB + (size_t)(t + 2) * kstep;
            const char* a3 = a2 + kstep; const char* b3 = b2 + kstep;
            PG8_LDB(B0, 0, 0); PG8_LDB(B1, 0, 1); PG8_SCHED; PG8_LDA(At, 0, 0); PG8_STAGE(PG8_SA(1, 1), a1 + hstepA, voffA);
            PG8_WAIT_V(8); PG8_WAIT_L(0); PG8_BAR; PG8_MMA(0, 0, At, B0); PG8_MMA(0, 1, At, B1); PG8_BAR; PG8_SCHED;
            PG8_LDA(At, 0, 1); PG8_STAGE(PG8_SB(0, 0), b2, voffB); PG8_STAGE(PG8_SB(0, 1), b2 + hstepB, voffB); PG8_STAGE(PG8_SA(0, 0), a2, voffA);
            PG8_WAIT_V(8); PG8_WAIT_L(0); PG8_BAR; PG8_MMA(1, 0, At, B0); PG8_MMA(1, 1, At, B1); PG8_BAR; PG8_SCHED;
            PG8_LDB(B0, 1, 0); PG8_LDB(B1, 1, 1); PG8_SCHED; PG8_LDA(At, 1, 0); PG8_STAGE(PG8_SA(0, 1), a2 + hstepA, voffA);
            PG8_WAIT_V(8); PG8_WAIT_L(0); PG8_BAR; PG8_MMA(0, 0, At, B0); PG8_MMA(0, 1, At, B1); PG8_BAR; PG8_SCHED;
            PG8_LDA(At, 1, 1); PG8_STAGE(PG8_SB(1, 0), b3, voffB); PG8_STAGE(PG8_SB(1, 1), b3 + hstepB, voffB); PG8_STAGE(PG8_SA(1, 0), a3, voffA);
            PG8_WAIT_V(8); PG8_WAIT_L(0); PG8_BAR; PG8_MMA(1, 0, At, B0); PG8_MMA(1, 1, At, B1); PG8_BAR; PG8_SCHED;
        }
        if constexpr (Epi::GS) { if (tg + TG < nt) E.group_scale(acc, ui, tg >> 3, wr, fr); }
        }
        if (wr == 0) PG8_BAR;
        if constexpr (Epi::GS) E.run(acc, cur, wr, wc, fr, fq, ui); else E(acc, cur, wr, wc, fr, fq);
        if (!has_next) break;
#pragma unroll
        for (int a = 0; a < 2; ++a)
#pragma unroll
            for (int b = 0; b < 2; ++b)
#pragma unroll
                for (int m = 0; m < 4; ++m)
#pragma unroll
                    for (int n = 0; n < 2; ++n) acc[a][b][m][n] = (f32x4){0.f, 0.f, 0.f, 0.f};
        cur = nxt; cA = nA; cB = nB; ++ui;
        if (wr == 1) PG8_BAR;
    }
    PG8_WAIT_V(0);
    PG8_BAR;
#undef PG8_SA
#undef PG8_SB
#undef PG8_STAGE
#undef PG8_LDA
#undef PG8_LDB
#undef PG8_MMA
#undef PG8_WAIT_V
#undef PG8_WAIT_L
#undef PG8_BAR
#undef PG8_SCHED
}
}
using pg8::Unit;

struct EpiInProj {
    static constexpr bool GS = false;
    bf16_t* proj; float* misc; const float* cosA; const float* sinA; const float* cosI; const float* sinI; bf16_t* vt;
    __device__ __forceinline__ void operator()(const f32x4 (&acc)[2][2][4][2], const Unit& u, int wr, int wc, int fr, int fq) const {
        const int pn = u.pn, row0 = u.pm * 256 + wr * 64 + fr;
        const bool is_misc = (pn == 8), is_sig = (pn >= 29);
#pragma unroll
        for (int ai = 0; ai < 2; ++ai)
#pragma unroll
            for (int m = 0; m < 4; ++m) {
                const int r = row0 + ai * 128 + m * 16, pos = r & (SEQ - 1);
#pragma unroll
                for (int bj = 0; bj < 2; ++bj) {
                    int kind = 0;
                    if (pn <= 4) kind = (wc == 0) ? 1 : 0;
                    else if (pn == 6 || pn == 7) kind = (((wc & 1) == 0) && fq < 2) ? 2 : 0;
                    else if (pn == 8) kind = (bj == 0 && wc == 0 && fq < 2) ? 2 : 0;
                    f32x4 c4 = (f32x4){1.f, 1.f, 1.f, 1.f}, s4 = (f32x4){0.f, 0.f, 0.f, 0.f};
                    if (kind == 1) { c4 = *(const f32x4*)(cosA + pos * 16 + 4 * fq); s4 = *(const f32x4*)(sinA + pos * 16 + 4 * fq); }
                    else if (kind == 2) { c4 = *(const f32x4*)(cosI + pos * 8 + 4 * fq); s4 = *(const f32x4*)(sinI + pos * 8 + 4 * fq); }
                    const f32x4 v0 = acc[ai][bj][m][0], v1 = acc[ai][bj][m][1];
                    f32x4 o0 = v0 * c4 - v1 * s4, o1 = v1 * c4 + v0 * s4;
                    if (is_sig) {
#pragma unroll
                        for (int j = 0; j < 4; ++j) { o0[j] = sigmoid_f(o0[j]); o1[j] = sigmoid_f(o1[j]); }
                    }
                    const int cc = bj * 128 + wc * 32 + 8 * fq;
                    u32x4 pk; pk.x = pg8::cvt_pk_bf16(o0[0], o0[1]); pk.y = pg8::cvt_pk_bf16(o0[2], o0[3]); pk.z = pg8::cvt_pk_bf16(o1[0], o1[1]); pk.w = pg8::cvt_pk_bf16(o1[2], o1[3]);
                    if (is_misc) {
                        float* mp = misc + (size_t)r * 256 + cc;
                        *(f32x4*)mp = o0; *(f32x4*)(mp + 4) = o1;
                        if (bj == 0 && wc < 2) *(u32x4*)(proj + (size_t)r * NP + C_MISC + cc) = pk;
                    } else {
                        if (pn == 5) {
                            bf16_t* vp = vt + ((size_t)((r >> 12) * 2 + bj) * 128 + wc * 32 + 8 * fq) * SEQ + pos;
#pragma unroll
                            for (int j = 0; j < 4; ++j) { vp[(size_t)j * SEQ] = f2bf(o0[j]); vp[(size_t)(4 + j) * SEQ] = f2bf(o1[j]); }
                        }
                        *(u32x4*)(proj + (size_t)r * NP + pn * 256 + cc) = pk;
                    }
                }
            }
    }
};
struct EpiGateA {
    static constexpr bool GS = false;
    bf16_t* proj;
    __device__ __forceinline__ void operator()(const f32x4 (&acc)[2][2][4][2], const Unit& u, int wr, int wc, int fr, int fq) const {
        const int row0 = u.pm * 256 + wr * 64 + fr, col0 = u.pn * 256 + wc * 32 + 8 * fq;
#pragma unroll
        for (int ai = 0; ai < 2; ++ai)
#pragma unroll
            for (int m = 0; m < 4; ++m)
#pragma unroll
                for (int bj = 0; bj < 2; ++bj) {
                    bf16_t* pp = proj + (size_t)(row0 + ai * 128 + m * 16) * NP + C_GA + col0 + bj * 128;
                    const u32x4 g = *(const u32x4*)pp; const f32x4 a = acc[ai][bj][m][0], b = acc[ai][bj][m][1];
                    u32x4 w; w.x = pg8::cvt_pk_bf16(lo16(g.x) * a[0], hi16(g.x) * a[1]); w.y = pg8::cvt_pk_bf16(lo16(g.y) * a[2], hi16(g.y) * a[3]);
                    w.z = pg8::cvt_pk_bf16(lo16(g.z) * b[0], hi16(g.z) * b[1]); w.w = pg8::cvt_pk_bf16(lo16(g.w) * b[2], hi16(g.w) * b[3]);
                    *(u32x4*)pp = w;
                }
    }
};
struct EpiGateS {
    static constexpr bool GS = true;
    bf16_t* proj; const float* gtab;
    __device__ __forceinline__ void group_scale(f32x4 (&acc)[2][2][4][2], int u, int g, int wr, int fr) const {
        const float* tp = gtab + (u * 4 + g) * 256 + wr * 64 + fr;
#pragma unroll
        for (int ai = 0; ai < 2; ++ai)
#pragma unroll
            for (int m = 0; m < 4; ++m) {
                const float f = tp[ai * 128 + m * 16];
#pragma unroll
                for (int bj = 0; bj < 2; ++bj) { acc[ai][bj][m][0] *= f; acc[ai][bj][m][1] *= f; }
            }
    }
    __device__ __forceinline__ void run(const f32x4 (&acc)[2][2][4][2], const Unit& u, int wr, int wc, int fr, int fq, int ui) const {
        const int row0 = u.pm * 256 + wr * 64 + fr, col0 = u.pn * 256 + wc * 32 + 8 * fq;
        const float* tp = gtab + (ui * 4 + 3) * 256 + wr * 64 + fr;
#pragma unroll
        for (int ai = 0; ai < 2; ++ai)
#pragma unroll
            for (int m = 0; m < 4; ++m) {
                const float rl = tp[ai * 128 + m * 16];
#pragma unroll
                for (int bj = 0; bj < 2; ++bj) {
                    bf16_t* pa = proj + (size_t)(row0 + ai * 128 + m * 16) * NP + C_GA + col0 + bj * 128;
                    bf16_t* ps = pa + (C_GS - C_GA);
                    const u32x4 m1 = *(const u32x4*)pa; const u32x4 g = *(const u32x4*)ps; const f32x4 a = acc[ai][bj][m][0] * rl, b = acc[ai][bj][m][1] * rl;
                    u32x4 w; w.x = pg8::cvt_pk_bf16(lo16(m1.x) + lo16(g.x) * a[0], hi16(m1.x) + hi16(g.x) * a[1]);
                    w.y = pg8::cvt_pk_bf16(lo16(m1.y) + lo16(g.y) * a[2], hi16(m1.y) + hi16(g.y) * a[3]);
                    w.z = pg8::cvt_pk_bf16(lo16(m1.z) + lo16(g.z) * b[0], hi16(m1.z) + hi16(g.z) * b[1]);
                    w.w = pg8::cvt_pk_bf16(lo16(m1.w) + lo16(g.w) * b[2], hi16(m1.w) + hi16(g.w) * b[3]);
                    *(u32x4*)ps = w;
                }
            }
    }
};
struct EpiResid {
    static constexpr bool GS = false;
    const float* xin; float* xout;
    __device__ __forceinline__ void operator()(const f32x4 (&acc)[2][2][4][2], const Unit& u, int wr, int wc, int fr, int fq) const {
        const int row0 = u.pm * 256 + wr * 64 + fr, col0 = u.pn * 256 + wc * 32 + 8 * fq;
#pragma unroll
        for (int ai = 0; ai < 2; ++ai)
#pragma unroll
            for (int m = 0; m < 4; ++m)
#pragma unroll
                for (int bj = 0; bj < 2; ++bj)
#pragma unroll
                    for (int n = 0; n < 2; ++n) {
                        const size_t off = (size_t)(row0 + ai * 128 + m * 16) * 1024 + col0 + bj * 128 + n * 4;
                        *(f32x4*)(xout + off) = *(const f32x4*)(xin + off) + acc[ai][bj][m][n];
                    }
    }
};
struct EpiBf16 {
    static constexpr bool GS = false;
    bf16_t* O; int ldc;
    __device__ __forceinline__ void operator()(const f32x4 (&acc)[2][2][4][2], const Unit& u, int wr, int wc, int fr, int fq) const {
        const int row0 = u.pm * 256 + wr * 64 + fr, col0 = u.pn * 256 + wc * 32 + 8 * fq;
#pragma unroll
        for (int ai = 0; ai < 2; ++ai)
#pragma unroll
            for (int m = 0; m < 4; ++m)
#pragma unroll
                for (int bj = 0; bj < 2; ++bj) {
                    const f32x4 a = acc[ai][bj][m][0], b = acc[ai][bj][m][1];
                    u32x4 w; w.x = pg8::cvt_pk_bf16(a[0], a[1]); w.y = pg8::cvt_pk_bf16(a[2], a[3]); w.z = pg8::cvt_pk_bf16(b[0], b[1]); w.w = pg8::cvt_pk_bf16(b[2], b[3]);
                    *(u32x4*)(O + (size_t)(row0 + ai * 128 + m * 16) * ldc + col0 + bj * 128) = w;
                }
    }
};

template <int MODE>
__device__ __forceinline__ void convT(int wv, const float* src, int K, int Nsrc, bf16_t* dst, int Ndst, const float* kscale, float* tile) {
    const int tid = opaque_tid(wv), kt = K / 64, ntiles = (Ndst / 64) * kt;
    for (int ti = blockIdx.x; ti < ntiles; ti += gridDim.x) {
        const int n0 = (ti / kt) * 64, k0 = (ti % kt) * 64;
        {
            const int nn = tid & 63; const int nd = n0 + nn; const int n = (nd & ~31) + perm32(nd & 31); const int ns = MODE ? inproj_map(n) : n;
#pragma unroll
            for (int i = 0; i < 8; ++i) {
                const int kk = (tid >> 6) + 8 * i;
                float v = (ns >= 0) ? src[(size_t)(k0 + kk) * Nsrc + ns] : 0.f;
                if (kscale) v *= kscale[k0 + kk];
                tile[nn * 65 + kk] = v;
            }
        }
        __syncthreads();
        {
            const int kk = tid & 63;
#pragma unroll
            for (int i = 0; i < 8; ++i) { const int nn = (tid >> 6) + 8 * i; dst[(size_t)(n0 + nn) * K + k0 + kk] = f2bf(tile[nn * 65 + kk]); }
        }
        __syncthreads();
    }
}

__device__ __forceinline__ void phase_convert(int wv, KParams p, float* tile) {
    for (int l = 0; l < DEPTH; ++l) {
        unsigned char* wl = p->ws + OFF_W + (size_t)l * SZ_WL;
        bf16_t* win = (bf16_t*)wl; bf16_t* wpa = (bf16_t*)(wl + SZ_WIN); bf16_t* wps = (bf16_t*)(wl + SZ_WIN + SZ_WPA);
        bf16_t* wo = (bf16_t*)(wl + SZ_WIN + SZ_WPA + SZ_WPS); bf16_t* wup = (bf16_t*)(wl + SZ_WIN + SZ_WPA + SZ_WPS + SZ_WO); bf16_t* wdn = (bf16_t*)(wl + SZ_WIN + SZ_WPA + SZ_WPS + SZ_WO + SZ_WUP);
        convT<1>(wv, p->w_in + (size_t)l * 1024 * IN_COLS, 1024, IN_COLS, win, NP, nullptr, tile);
        convT<0>(wv, p->w_proj_attn + (size_t)l * 1024 * 1024, 1024, 1024, wpa, 1024, nullptr, tile);
        convT<0>(wv, p->w_proj_ssd + (size_t)l * 2048 * 1024, 2048, 1024, wps, 1024, p->ssd_norm_w + l * 2048, tile);
        convT<0>(wv, p->w_out + (size_t)l * 1024 * 1024, 1024, 1024, wo, 1024, nullptr, tile);
        convT<0>(wv, p->ffn_w_up + (size_t)l * 1024 * FFN2, 1024, FFN2, wup, FFN2, nullptr, tile);
        convT<0>(wv, p->ffn_w_down + (size_t)l * FFN * 1024, FFN, 1024, wdn, 1024, nullptr, tile);
    }
    float* rope = (float*)(p->ws + OFF_ROPE);
    float* cosA = rope; float* sinA = rope + 4096 * 16; float* cosI = rope + 4096 * 32; float* sinI = rope + 4096 * 40;
    for (int i = blockIdx.x * 512 + opaque_tid(wv); i < 4096 * 24; i += gridDim.x * 512) {
        int pos, f; float inv;
        if (i < 4096 * 16) { pos = i >> 4; f = i & 15; inv = p->invA[f]; } else { const int j = i - 4096 * 16; pos = j >> 3; f = j & 7; inv = p->invI[f]; }
        const float ang = (float)pos * inv;
        double rev = (double)ang * 0.15915494309189535; rev -= rint(rev);
        const float c = __builtin_amdgcn_cosf((float)rev), s = __builtin_amdgcn_sinf((float)rev);
        if (i < 4096 * 16) { cosA[pos * 16 + f] = c; sinA[pos * 16 + f] = s; } else { cosI[pos * 8 + f] = c; sinI[pos * 8 + f] = s; }
    }
}

template <bool F32OUT>
__device__ __forceinline__ void phase_norm(int wv, const float* xin, const float* w, bf16_t* hout, float* fout, int nrows) {
    const int tid = opaque_tid(wv); const int wave = tid >> 6, lane = tid & 63;
    const int stride = gridDim.x * 8;
    for (int row0 = blockIdx.x * 8 + wave; row0 < nrows; row0 += stride * 4) {
        f32x4 v[4][4];
#pragma unroll
        for (int u = 0; u < 4; ++u) {
            const int row = row0 + u * stride;
            if (row < nrows) {
                const f32x4* xr = (const f32x4*)(xin + (size_t)row * 1024);
#pragma unroll
                for (int i = 0; i < 4; ++i) v[u][i] = xr[lane + 64 * i];
            }
        }
        f32x4 w4[4];
#pragma unroll
        for (int i = 0; i < 4; ++i) w4[i] = ((const f32x4*)w)[lane + 64 * i];
#pragma unroll
        for (int u = 0; u < 4; ++u) {
            const int row = row0 + u * stride;
            if (row < nrows) {
                float ss = 0.f;
#pragma unroll
                for (int i = 0; i < 4; ++i) ss += v[u][i][0] * v[u][i][0] + v[u][i][1] * v[u][i][1] + v[u][i][2] * v[u][i][2] + v[u][i][3] * v[u][i][3];
                ss = wave_sum(ss);
                const float rstd = rsqrtf(ss * (1.0f / 1024.0f) + EPS);
#pragma unroll
                for (int i = 0; i < 4; ++i) {
                    const f32x4 o = v[u][i] * rstd * w4[i];
                    if (F32OUT) ((f32x4*)(fout + (size_t)row * 1024))[lane + 64 * i] = o;
                    else { u32x2 pk; pk.x = pack2(o[0], o[1]); pk.y = pack2(o[2], o[3]); *(u32x2*)(hout + (size_t)row * 1024 + 4 * (lane + 64 * i)) = pk; }
                }
            }
        }
    }
}

__device__ __forceinline__ unsigned fkey(float s) { s += 0.0f; const unsigned u = __float_as_uint(s); return (u & 0x80000000u) ? ~u : (u | 0x80000000u); }

__device__ __forceinline__ void phase_idx_simple(int wv, const bf16_t* proj, const float* misc, unsigned* mask, int* sel, unsigned char* shm) {
    const int tid = opaque_tid(wv); const int wave = tid >> 6, lane = tid & 63;
    float* qs = (float*)(shm + wave * 18432); unsigned* sk = (unsigned*)(shm + wave * 18432 + 2048);
    const unsigned long long lt_mask = (1ull << lane) - 1ull;
    for (int q = blockIdx.x * 8 + wave; q < SLAB; q += gridDim.x * 8) {
        const int bl = q >> 12, t = q & (SEQ - 1), n = t + 1;
        wave_lds_sync();
        {
            const u32x4 raw = *(const u32x4*)(proj + (size_t)q * NP + C_QI + lane * 8);
            f32x4 a, b; a[0] = lo16(raw.x); a[1] = hi16(raw.x); a[2] = lo16(raw.y); a[3] = hi16(raw.y); b[0] = lo16(raw.z); b[1] = hi16(raw.z); b[2] = lo16(raw.w); b[3] = hi16(raw.w);
            *(f32x4*)(qs + lane * 8) = a; *(f32x4*)(qs + lane * 8 + 4) = b;
        }
        float wv[8];
        { const f32x4 w0 = *(const f32x4*)(misc + (size_t)q * 256 + 64), w1 = *(const f32x4*)(misc + (size_t)q * 256 + 68);
#pragma unroll
          for (int j = 0; j < 4; ++j) { wv[j] = w0[j]; wv[4 + j] = w1[j]; } }
        wave_lds_sync();
        const int nr = (n + 63) & ~63;
        for (int s = lane; s < nr; s += 64) {
            if (s < n) {
                const f32x4* kp = (const f32x4*)(misc + (size_t)(bl * SEQ + s) * 256);
                f32x4 kv[16];
#pragma unroll
                for (int i = 0; i < 16; ++i) kv[i] = kp[i];
                float sc = 0.f;
#pragma unroll
                for (int h = 0; h < 8; ++h) {
                    float d = 0.f;
#pragma unroll
                    for (int i = 0; i < 16; ++i) { const f32x4 qv = *(const f32x4*)(qs + h * 64 + i * 4); d += kv[i][0] * qv[0] + kv[i][1] * qv[1] + kv[i][2] * qv[2] + kv[i][3] * qv[3]; }
                    sc += wv[h] * fmaxf(d, 0.f);
                }
                sk[s] = fkey(sc);
            }
        }
        wave_lds_sync();
        unsigned cur = 0u; int need = 1 << 30;
        if (n > 256) {
            for (int bit = 31; bit >= 0; --bit) {
                const unsigned cand = cur | (1u << bit); int cnt = 0;
                for (int s = lane; s < nr; s += 64) { const bool pr = (s < n) && (sk[s] >= cand); cnt += __popcll(__ballot(pr)); }
                if (cnt >= 256) cur = cand;
            }
            int cgt = 0;
            for (int s = lane; s < nr; s += 64) { const bool pr = (s < n) && (sk[s] > cur); cgt += __popcll(__ballot(pr)); }
            need = 256 - cgt;
        }
        int run_eq = 0, run_sel = 0; unsigned long long mybal = 0ull;
        for (int s = lane, c = 0; s < nr; s += 64, ++c) {
            const bool in = s < n; const unsigned k = in ? sk[s] : 0u;
            const bool gt = in && (k > cur), eq = in && (k == cur);
            const unsigned long long beq = __ballot(eq);
            const int rank = run_eq + __popcll(beq & lt_mask);
            const bool se = gt || (eq && rank < need);
            const unsigned long long bs = __ballot(se);
            const int pos = run_sel + __popcll(bs & lt_mask);
            if (se && pos < 256) sel[(size_t)q * 256 + pos] = s;
            run_eq += __popcll(beq); run_sel += __popcll(bs);
            if (lane == c) mybal = bs;
        }
        u32x2 mw; mw.x = (unsigned)mybal; mw.y = (unsigned)(mybal >> 32);
        *(u32x2*)(mask + (size_t)q * 128 + lane * 2) = mw;
        for (int j = run_sel + lane; j < 256; j += 64) sel[(size_t)q * 256 + j] = -1;
    }
}

__device__ __forceinline__ void phase_att_simple(int wv, bf16_t* proj, const int* sel, unsigned char* shm) {
    const int tid = opaque_tid(wv); const int wave = tid >> 6, lane = tid & 63, h = wave, kvh = h >> 2;
    float* qf = (float*)(shm + wave * 2560); float* pj = qf + 128; int* kj = (int*)(pj + 256);
    const float scale = 0.08838834764831845f;
    for (int q = blockIdx.x; q < SLAB; q += gridDim.x) {
        const int bl = q >> 12;
        wave_lds_sync();
        { const unsigned raw = *(const unsigned*)(proj + (size_t)q * NP + C_Q + h * 128 + 2 * lane); qf[2 * lane] = lo16(raw); qf[2 * lane + 1] = hi16(raw); }
        int keys[4];
#pragma unroll
        for (int i = 0; i < 4; ++i) { keys[i] = sel[(size_t)q * 256 + lane + 64 * i]; kj[lane + 64 * i] = keys[i]; }
        wave_lds_sync();
        float lg[4]; float mx = -INFINITY;
#pragma unroll
        for (int i = 0; i < 4; ++i) {
            lg[i] = -INFINITY;
            if (keys[i] >= 0) {
                const u32x4* kp = (const u32x4*)(proj + (size_t)(bl * SEQ + keys[i]) * NP + C_K + kvh * 128);
                float d = 0.f;
#pragma unroll
                for (int c = 0; c < 16; ++c) {
                    const u32x4 raw = kp[c]; const f32x4 q0 = *(const f32x4*)(qf + c * 8), q1 = *(const f32x4*)(qf + c * 8 + 4);
                    d += lo16(raw.x) * q0[0] + hi16(raw.x) * q0[1] + lo16(raw.y) * q0[2] + hi16(raw.y) * q0[3] + lo16(raw.z) * q1[0] + hi16(raw.z) * q1[1] + lo16(raw.w) * q1[2] + hi16(raw.w) * q1[3];
                }
                lg[i] = d * scale;
            }
            mx = fmaxf(mx, lg[i]);
        }
        mx = wave_max(mx);
        float sm = 0.f; float pe[4];
#pragma unroll
        for (int i = 0; i < 4; ++i) { pe[i] = (keys[i] >= 0) ? __expf(lg[i] - mx) : 0.f; sm += pe[i]; }
        sm = wave_sum(sm);
        const float inv = 1.0f / sm;
#pragma unroll
        for (int i = 0; i < 4; ++i) pj[lane + 64 * i] = pe[i] * inv;
        wave_lds_sync();
        float a0 = 0.f, a1 = 0.f;
        const bf16_t* vb = proj + (size_t)(bl * SEQ) * NP + C_V + kvh * 128 + 2 * lane;
        for (int j0 = 0; j0 < 256; j0 += 16) {
            if (kj[j0] < 0) break;
            unsigned raw[16]; float pv[16];
#pragma unroll
            for (int u = 0; u < 16; ++u) { const int key = max(kj[j0 + u], 0); pv[u] = pj[j0 + u]; raw[u] = *(const unsigned*)(vb + (size_t)key * NP); }
#pragma unroll
            for (int u = 0; u < 16; ++u) { a0 += pv[u] * lo16(raw[u]); a1 += pv[u] * hi16(raw[u]); }
        }
        *(unsigned*)(proj + (size_t)q * NP + C_Q + h * 128 + 2 * lane) = pack2(a0, a1);
    }
}


typedef short bf16x4 __attribute__((ext_vector_type(4)));
__device__ __forceinline__ void phase_idx(int wv, const bf16_t* proj, const float* misc, unsigned* mask, unsigned char* shm) {
    const int tid = opaque_tid(wv), wave = __builtin_amdgcn_readfirstlane(tid >> 6), lane = tid & 63, fr = lane & 15, fq = lane >> 4;
    int* cntbuf = (int*)shm;
    int* cbuf2 = cntbuf + 256;
    volatile int* tieflag = (volatile int*)(shm + 149760);
    for (int it = blockIdx.x; it < 256; it += gridDim.x) {
        for (int pass = 0; pass < 4; ++pass) {
            const int i = (pass == 0) ? it : (pass == 1) ? 511 - it : (pass == 2) ? 512 + it : 1023 - it;
            const int qt = 255 - (i >> 2), bl = i & 3;
            const int q0 = qt * 16, nch = (q0 + 15) / 64 + 1, t = q0 + fr;
            const size_t qrow = (size_t)bl * SEQ + q0 + fr;
            int lb = wave * 64 + fq * 4; asm volatile("" : "+v"(lb));
            u32x4 key[4][4];
            u32x4* klds = (u32x4*)(shm + 18688) + tid;
#define KGET(dst, ip, tt) do { if ((ip) < 4) dst = key[(ip) < 4 ? (ip) : 0][tt]; else dst = klds[(((ip) - 4) * 4 + (tt)) * 512]; } while (0)
            {
                float wv[8];
                { const f32x4 w0 = *(const f32x4*)(misc + qrow * 256 + 64), w1 = *(const f32x4*)(misc + qrow * 256 + 68);
#pragma unroll
                  for (int j = 0; j < 4; ++j) { wv[j] = w0[j]; wv[4 + j] = w1[j]; } }
#pragma unroll
                for (int u = 0; u < 2; ++u) { const int ch = tid + 512 * u, r = ch >> 6, cc = ch & 63;
                    *(u32x4*)(shm + 2048 + r * 1040 + cc * 16) = *(const u32x4*)(proj + ((size_t)bl * SEQ + q0 + r) * NP + C_QI + cc * 8); }
                if (tid == 0) tieflag[0] = 0;
                __syncthreads();
                const unsigned char* ql = shm + 2048 + fr * 1040 + fq * 16;
#pragma unroll
                for (int ip = 0; ip < 8; ++ip) {
                    int c = wave + 8 * ip; asm volatile("" : "+s"(c));
                    if (c < nch) {
                        const int trel = t - (c - wave) * 64 - lb;
                        const bf16_t* kp0 = proj + ((size_t)bl * SEQ + c * 64 + fr) * NP + C_MISC + fq * 8;
#pragma unroll
                        for (int tp = 0; tp < 2; ++tp) {
                            bf16x8 kf[2][2];
#pragma unroll
                            for (int u = 0; u < 2; ++u) { const bf16_t* kp = kp0 + (size_t)((tp * 2 + u) * 16) * NP; kf[u][0] = *(const bf16x8*)kp; kf[u][1] = *(const bf16x8*)(kp + 32); }
                            f32x4 sc[2];
                            sc[0] = (f32x4){0.f, 0.f, 0.f, 0.f}; sc[1] = (f32x4){0.f, 0.f, 0.f, 0.f};
#pragma unroll
                            for (int h = 0; h < 8; ++h) {
                                const bf16x8 q0f = *(const bf16x8*)(ql + h * 128), q1f = *(const bf16x8*)(ql + h * 128 + 64);
#pragma unroll
                                for (int u = 0; u < 2; ++u) {
                                    f32x4 d = __builtin_amdgcn_mfma_f32_16x16x32_bf16(kf[u][0], q0f, (f32x4){0.f, 0.f, 0.f, 0.f}, 0, 0, 0);
                                    d = __builtin_amdgcn_mfma_f32_16x16x32_bf16(kf[u][1], q1f, d, 0, 0, 0);
#pragma unroll
                                    for (int j = 0; j < 4; ++j) sc[u][j] += wv[h] * fmaxf(d[j], 0.f);
                                }
                                if ((h & 3) == 3) asm volatile("" ::: "memory");
                            }
#pragma unroll
                            for (int u = 0; u < 2; ++u) {
                                u32x4 kk;
#pragma unroll
                                for (int j = 0; j < 4; ++j) kk[j] = ((tp * 2 + u) * 16 + j <= trel) ? fkey(sc[u][j]) : 0u;
                                if (ip < 4) key[ip < 4 ? ip : 0][tp * 2 + u] = kk; else klds[((ip - 4) * 4 + tp * 2 + u) * 512] = kk;
                            }
                        }
                    } else if (ip < 4) {
#pragma unroll
                        for (int tt = 0; tt < 4; ++tt) key[ip < 4 ? ip : 0][tt] = (u32x4){0u, 0u, 0u, 0u};
                    }
                    asm volatile("" ::: "memory");
                }
            }
            __syncthreads();
            unsigned cur = 0u;
            bool rdone = (t + 1 <= 256);
            for (int bit = 31; bit >= 0; --bit) {
                if (__ballot(rdone) == ~0ull) break;
                const unsigned cand = cur | (1u << bit);
                int cnt = 0;
#pragma unroll
                for (int hp2 = 0; hp2 < 2; ++hp2) {
                    if (wave + 8 * (4 + 2 * hp2) < nch) {
                        u32x4 kl[8];
#pragma unroll
                        for (int q = 0; q < 8; ++q) kl[q] = klds[(hp2 * 8 + q) * 512];
                        const bool second = (wave + 8 * (5 + 2 * hp2) < nch);
#pragma unroll
                        for (int q = 0; q < 4; ++q)
#pragma unroll
                            for (int j = 0; j < 4; ++j) cnt += (kl[q][j] >= cand) ? 1 : 0;
                        if (second) {
#pragma unroll
                            for (int q = 4; q < 8; ++q)
#pragma unroll
                                for (int j = 0; j < 4; ++j) cnt += (kl[q][j] >= cand) ? 1 : 0;
                        }
                    }
                }
#pragma unroll
                for (int ip = 0; ip < 4; ++ip)
                    if (wave + 8 * ip < nch) {
#pragma unroll
                        for (int tt = 0; tt < 4; ++tt)
#pragma unroll
                            for (int j = 0; j < 4; ++j) cnt += (key[ip][tt][j] >= cand) ? 1 : 0;
                    }
                cnt += __shfl_xor(cnt, 16); cnt += __shfl_xor(cnt, 32);
                int* cb = cntbuf + (bit & 1) * 128;
                if (fq == 0) cb[fr * 8 + wave] = cnt;
                __syncthreads();
                const int4 a = *(const int4*)(cb + fr * 8), b = *(const int4*)(cb + fr * 8 + 4);
                const int tot = a.x + a.y + a.z + a.w + b.x + b.y + b.z + b.w;
                if (!rdone && tot >= 256) { cur = cand; if (tot == 256) rdone = true; }
            }
            int cg = 0, ce = 0;
#pragma unroll
            for (int ip = 0; ip < 8; ++ip)
                if (wave + 8 * ip < nch) {
#pragma unroll
                    for (int tt = 0; tt < 4; ++tt) { u32x4 kv; KGET(kv, ip, tt);
#pragma unroll
                        for (int j = 0; j < 4; ++j) { cg += (kv[j] > cur) ? 1 : 0; ce += (kv[j] == cur) ? 1 : 0; } }
                }
            cg += __shfl_xor(cg, 16); cg += __shfl_xor(cg, 32); ce += __shfl_xor(ce, 16); ce += __shfl_xor(ce, 32);
            if (fq == 0) { cbuf2[fr * 8 + wave] = cg; cbuf2[128 + fr * 8 + wave] = ce; }
            __syncthreads();
            int need, ceq;
            { const int4 a = *(const int4*)(cbuf2 + fr * 8), b = *(const int4*)(cbuf2 + fr * 8 + 4);
              need = 256 - (a.x + a.y + a.z + a.w + b.x + b.y + b.z + b.w);
              const int4 c4 = *(const int4*)(cbuf2 + 128 + fr * 8), d4 = *(const int4*)(cbuf2 + 128 + fr * 8 + 4);
              ceq = c4.x + c4.y + c4.z + c4.w + d4.x + d4.y + d4.z + d4.w; }
            const bool ties = (cur != 0u) && (ceq > need);
            unsigned J = 4095u;
            if (ties) tieflag[0] = 1;
            __syncthreads();
            if (tieflag[0] != 0) {
                unsigned Jt = 0u;
                for (int bit = 11; bit >= 0; --bit) {
                    const unsigned cand = Jt | (1u << bit);
                    const int crel = (int)cand - lb;
                    int cnt = 0;
#pragma unroll
                    for (int ip = 0; ip < 8; ++ip)
                        if (wave + 8 * ip < nch) {
#pragma unroll
                            for (int tt = 0; tt < 4; ++tt) { u32x4 kv; KGET(kv, ip, tt);
#pragma unroll
                                for (int j = 0; j < 4; ++j) cnt += (kv[j] == cur && (ip * 512 + tt * 16 + j) < crel) ? 1 : 0; }
                        }
                    cnt += __shfl_xor(cnt, 16); cnt += __shfl_xor(cnt, 32);
                    int* cb = cntbuf + (bit & 1) * 128;
                    if (fq == 0) cb[fr * 8 + wave] = cnt;
                    __syncthreads();
                    const int4 a = *(const int4*)(cb + fr * 8), b = *(const int4*)(cb + fr * 8 + 4);
                    const int tot = a.x + a.y + a.z + a.w + b.x + b.y + b.z + b.w;
                    if (tot < need) Jt = cand;
                }
                if (ties) J = Jt;
            }
#pragma unroll
            for (int ip = 0; ip < 8; ++ip) {
                const int c = wave + 8 * ip;
                if (c < nch) {
                    unsigned lo = 0u, hi = 0u;
                    const int jrel = (int)J - lb;
#pragma unroll
                    for (int tt = 0; tt < 4; ++tt) { u32x4 kv; KGET(kv, ip, tt);
#pragma unroll
                        for (int j = 0; j < 4; ++j) {
                            const unsigned k = kv[j];
                            const bool se = (k > cur) || (k == cur && cur != 0u && (ip * 512 + tt * 16 + j) <= jrel);
                            const unsigned b = se ? 1u : 0u;
                            if (tt < 2) lo |= b << (tt * 16 + j); else hi |= b << ((tt - 2) * 16 + j);
                        } }
                    lo <<= (lb & 15); hi <<= (lb & 15);
                    lo |= __shfl_xor(lo, 16); lo |= __shfl_xor(lo, 32); hi |= __shfl_xor(hi, 16); hi |= __shfl_xor(hi, 32);
                    if (fq == 0) { u32x2 mw; mw.x = lo; mw.y = hi; *(u32x2*)(mask + qrow * 128 + c * 2) = mw; }
                }
            }
            __syncthreads();
        }
    }
#undef KGET
}

__device__ __forceinline__ void phase_att(int wv, bf16_t* proj, const bf16_t* vt, const unsigned* mask, unsigned char* shm) {
    const int tid = opaque_tid(wv), wave = tid >> 6, lane = tid & 63, fr = lane & 15, fq = lane >> 4;
    const int qs = wave & 3, hp = wave >> 2;
    constexpr int KROW = 272, VROW = 272, KBYTES = 128 * KROW, VBYTES = 128 * VROW, BUF = KBYTES + VBYTES;
    const float sc2 = 0.08838834764831845f * 1.4426950408889634f;
    for (int it = blockIdx.x; it < 256; it += gridDim.x) {
        for (int pass = 0; pass < 2; ++pass) {
            const int i = (pass == 0) ? it : 511 - it;
            const int qb = 63 - (i >> 3), sub = i & 7, bl = sub >> 1, kvh = sub & 1, nkt = qb + 1;
            const size_t qrow = (size_t)bl * SEQ + qb * 64 + qs * 16 + fr;
            bf16x8 qf[2][4];
#pragma unroll
            for (int hh = 0; hh < 2; ++hh)
#pragma unroll
                for (int ks = 0; ks < 4; ++ks) qf[hh][ks] = *(const bf16x8*)(proj + qrow * NP + C_Q + (kvh * 4 + hp * 2 + hh) * 128 + ks * 32 + fq * 8);
            f32x4 o[2][8];
#pragma unroll
            for (int hh = 0; hh < 2; ++hh)
#pragma unroll
                for (int dt = 0; dt < 8; ++dt) o[hh][dt] = (f32x4){0.f, 0.f, 0.f, 0.f};
            float mrow[2] = {-1e30f, -1e30f}, lrow[2] = {0.f, 0.f};
            const int sr0 = tid >> 4, sc = tid & 15;
            const bf16_t* kg = proj + ((size_t)bl * SEQ + sr0) * NP + C_K + kvh * 128 + sc * 8;
            const bf16_t* vg = vt + ((size_t)(bl * 2 + kvh) * 128 + sr0) * SEQ + sc * 8;
            const int klds = sr0 * KROW + sc * 16, vlds = KBYTES + sr0 * VROW + sc * 16;
            const int nst = (nkt + 1) >> 1;
            u32x4 kreg[4], vreg[4];
            __syncthreads();
#pragma unroll
            for (int u = 0; u < 4; ++u) { kreg[u] = *(const u32x4*)(kg + (size_t)(32 * u) * NP); vreg[u] = *(const u32x4*)(vg + (size_t)(32 * u) * SEQ); }
#pragma unroll
            for (int u = 0; u < 4; ++u) { *(u32x4*)(shm + klds + 32 * u * KROW) = kreg[u]; *(u32x4*)(shm + vlds + 32 * u * VROW) = vreg[u]; }
            __syncthreads();
            u32x4 mknext = *(const u32x4*)(mask + qrow * 128);
            for (int st = 0; st < nst; ++st) {
                const unsigned char* sbuf = shm + (st & 1) * BUF;
                const bool more = (st + 1 < nst);
                if (more) {
                    const bf16_t* kg2 = kg + (size_t)(st + 1) * 128 * NP; const bf16_t* vg2 = vg + (st + 1) * 128;
#pragma unroll
                    for (int u = 0; u < 4; ++u) { kreg[u] = *(const u32x4*)(kg2 + (size_t)(32 * u) * NP); vreg[u] = *(const u32x4*)(vg2 + (size_t)(32 * u) * SEQ); }
                }
                const u32x4 mk4 = mknext;
                if (more) mknext = *(const u32x4*)(mask + qrow * 128 + (st + 1) * 4);
#pragma unroll
                for (int h2 = 0; h2 < 2; ++h2) {
                if (2 * st + h2 >= nkt) break;
                const unsigned char* buf = sbuf + h2 * 64 * KROW;
                const unsigned char* vbuf = sbuf + KBYTES + h2 * 128;
                const unsigned mlo = (h2 ? mk4.z : mk4.x) >> (fq * 4), mhi = (h2 ? mk4.w : mk4.y) >> (fq * 4);
                f32x4 s[2][4];
#pragma unroll
                for (int nt = 0; nt < 4; ++nt) {
                    s[0][nt] = (f32x4){0.f, 0.f, 0.f, 0.f}; s[1][nt] = (f32x4){0.f, 0.f, 0.f, 0.f};
#pragma unroll
                    for (int ks = 0; ks < 4; ++ks) {
                        const bf16x8 kf = *(const bf16x8*)(buf + (nt * 16 + fr) * KROW + (ks * 32 + fq * 8) * 2);
                        s[0][nt] = __builtin_amdgcn_mfma_f32_16x16x32_bf16(kf, qf[0][ks], s[0][nt], 0, 0, 0);
                        s[1][nt] = __builtin_amdgcn_mfma_f32_16x16x32_bf16(kf, qf[1][ks], s[1][nt], 0, 0, 0);
                    }
                }
                bf16x8 pf[2][2];
                f32x4 bias[4];
#pragma unroll
                for (int nt = 0; nt < 4; ++nt)
#pragma unroll
                    for (int j = 0; j < 4; ++j) { const unsigned w = (nt < 2) ? mlo : mhi; bias[nt][j] = ((w >> ((nt & 1) * 16 + j)) & 1u) ? 0.f : -INFINITY; }
#pragma unroll
                for (int hh = 0; hh < 2; ++hh) {
                    float mx = -INFINITY;
#pragma unroll
                    for (int nt = 0; nt < 4; ++nt)
#pragma unroll
                        for (int j = 0; j < 4; ++j) { const float tv = __builtin_fmaf(s[hh][nt][j], sc2, bias[nt][j]); s[hh][nt][j] = tv; mx = fmaxf(mx, tv); }
                    mx = fmaxf(mx, __shfl_xor(mx, 16)); mx = fmaxf(mx, __shfl_xor(mx, 32));
                    const float mnew = fmaxf(mrow[hh], mx);
                    const float alpha = __builtin_amdgcn_exp2f(mrow[hh] - mnew);
                    mrow[hh] = mnew;
                    float ls = 0.f;
#pragma unroll
                    for (int nt = 0; nt < 4; ++nt)
#pragma unroll
                        for (int j = 0; j < 4; ++j) { const float pv = __builtin_amdgcn_exp2f(s[hh][nt][j] - mnew); s[hh][nt][j] = pv; ls += pv; }
                    lrow[hh] = lrow[hh] * alpha + ls;
                    if (__ballot(alpha != 1.0f) != 0ull) {
#pragma unroll
                        for (int dt = 0; dt < 8; ++dt) o[hh][dt] *= alpha;
                    }
#pragma unroll
                    for (int kk = 0; kk < 2; ++kk) {
                        u32x4 pk;
                        pk.x = pg8::cvt_pk_bf16(s[hh][2 * kk][0], s[hh][2 * kk][1]); pk.y = pg8::cvt_pk_bf16(s[hh][2 * kk][2], s[hh][2 * kk][3]);
                        pk.z = pg8::cvt_pk_bf16(s[hh][2 * kk + 1][0], s[hh][2 * kk + 1][1]); pk.w = pg8::cvt_pk_bf16(s[hh][2 * kk + 1][2], s[hh][2 * kk + 1][3]);
                        pf[hh][kk] = __builtin_bit_cast(bf16x8, pk);
                    }
                }
#pragma unroll
                for (int kk = 0; kk < 2; ++kk)
#pragma unroll
                    for (int dt = 0; dt < 8; ++dt) {
                        const unsigned char* vp = vbuf + (dt * 16 + fr) * VROW + (kk * 32 + fq * 4) * 2;
                        const bf16x4 v0 = *(const bf16x4*)vp, v1 = *(const bf16x4*)(vp + 32);
                        const bf16x8 vf = __builtin_shufflevector(v0, v1, 0, 1, 2, 3, 4, 5, 6, 7);
                        o[0][dt] = __builtin_amdgcn_mfma_f32_16x16x32_bf16(vf, pf[0][kk], o[0][dt], 0, 0, 0);
                        o[1][dt] = __builtin_amdgcn_mfma_f32_16x16x32_bf16(vf, pf[1][kk], o[1][dt], 0, 0, 0);
                    }
                }
                if (more) {
                    unsigned char* nb = shm + ((st + 1) & 1) * BUF;
#pragma unroll
                    for (int u = 0; u < 4; ++u) { *(u32x4*)(nb + klds + 32 * u * KROW) = kreg[u]; *(u32x4*)(nb + vlds + 32 * u * VROW) = vreg[u]; }
                }
                __syncthreads();
            }
#pragma unroll
            for (int hh = 0; hh < 2; ++hh) {
                float lt = lrow[hh]; lt += __shfl_xor(lt, 16); lt += __shfl_xor(lt, 32);
                const float inv = 1.0f / lt;
                bf16_t* op = proj + qrow * NP + C_Q + (kvh * 4 + hp * 2 + hh) * 128 + fq * 4;
#pragma unroll
                for (int dt = 0; dt < 8; ++dt) {
                    u32x2 w; w.x = pg8::cvt_pk_bf16(o[hh][dt][0] * inv, o[hh][dt][1] * inv); w.y = pg8::cvt_pk_bf16(o[hh][dt][2] * inv, o[hh][dt][3] * inv);
                    *(u32x2*)(op + dt * 16) = w;
                }
            }
        }
    }
}

__device__ __forceinline__ void phase_ssd_simple(int wv, KParams p, int l, bf16_t* proj, const float* misc, float* ssq, unsigned char* shm) {
    const int tid = opaque_tid(wv), lane = tid & 63;
    float* xs = (float*)shm; float* Bs = xs + 64 * 64; float* Cs = Bs + 64 * 128; float* dts = Cs + 64 * 128; float* decs = dts + 64; float* ybuf = decs + 64;
    const float* cw = p->ssd_conv_w + (size_t)l * 4 * 3072; const float* cb = p->ssd_conv_b + (size_t)l * 3072;
    for (int item = blockIdx.x; item < 128; item += gridDim.x) {
        const int bl = item >> 5, head = item & 31, g = head >> 3;
        const float Aneg = -__expf(p->ssd_a_log[l * 32 + head]), dtb = p->ssd_dt_bias[l * 32 + head], Dsk = p->ssd_d[l * 32 + head];
        const int pp = tid >> 3, ng = tid & 7;
        float hs[16];
#pragma unroll
        for (int k = 0; k < 16; ++k) hs[k] = 0.f;
        for (int c = 0; c < 64; ++c) {
            const int t0 = c * 64;
            __syncthreads();
            for (int i = 0; i < 40; ++i) {
                const int idx = tid + 512 * i, tok = idx / 320, cc = idx - tok * 320;
                int ch; float* dstp;
                if (cc < 64) { ch = head * 64 + cc; dstp = xs + tok * 64 + cc; }
                else if (cc < 192) { ch = 2048 + g * 128 + (cc - 64); dstp = Bs + tok * 128 + (cc - 64); }
                else { ch = 2560 + g * 128 + (cc - 192); dstp = Cs + tok * 128 + (cc - 192); }
                float a = cb[ch];
#pragma unroll
                for (int j = 0; j < 4; ++j) { const int tt = t0 + tok - 3 + j; if (tt >= 0) a += cw[j * 3072 + ch] * bf2f(proj[(size_t)(bl * SEQ + tt) * NP + C_XBC + ch]); }
                *dstp = silu_f(a);
            }
            if (tid < 64) {
                const float v = misc[(size_t)(bl * SEQ + t0 + tid) * 256 + 72 + head] + dtb;
                const float dt = (v > 20.f) ? v : log1pf(__expf(v));
                dts[tid] = dt; decs[tid] = __expf(dt * Aneg);
            }
            __syncthreads();
            for (int tok = 0; tok < 64; ++tok) {
                const float xv = xs[tok * 64 + pp], dt = dts[tok], dec = decs[tok], xdt = xv * dt;
                float y = 0.f;
#pragma unroll
                for (int k4 = 0; k4 < 4; ++k4) {
                    const f32x4 b4 = *(const f32x4*)(Bs + tok * 128 + ng * 16 + k4 * 4), c4 = *(const f32x4*)(Cs + tok * 128 + ng * 16 + k4 * 4);
#pragma unroll
                    for (int j = 0; j < 4; ++j) { float& hh = hs[k4 * 4 + j]; hh = hh * dec + xdt * b4[j]; y += c4[j] * hh; }
                }
                y += __shfl_xor(y, 1); y += __shfl_xor(y, 2); y += __shfl_xor(y, 4);
                if (ng == 0) ybuf[tok * 65 + pp] = y + Dsk * xv;
            }
            __syncthreads();
#pragma unroll
            for (int i = 0; i < 8; ++i) {
                const int idx = tid + 512 * i, tok = idx >> 6, p2 = idx & 63;
                bf16_t* zp = proj + (size_t)(bl * SEQ + t0 + tok) * NP + C_Z + head * 64 + p2;
                const float yg = ybuf[tok * 65 + p2] * silu_f(bf2f(*zp));
                *zp = f2bf(yg);
                const float s2 = wave_sum(yg * yg);
                if (lane == 0) ssq[(size_t)(bl * SEQ + t0 + tok) * 32 + head] = s2;
            }
        }
    }
}


__device__ __forceinline__ void phase_bcconv(int wv, KParams p, int l, const bf16_t* proj, bf16_t* bc, bf16_t* btg) {
    const int tid = opaque_tid(wv);
    const float* cw = p->ssd_conv_w + (size_t)l * 4 * 3072 + 2048; const float* cb = p->ssd_conv_b + (size_t)l * 3072 + 2048;
    for (int idx = blockIdx.x * 512 + tid; idx < 128 * (SLAB / 16); idx += gridDim.x * 512) {
        const int run = idx >> 7, c = (idx & 127) * 8, t0 = run * 16;
        float wt[4][8], bias[8];
#pragma unroll
        for (int e = 0; e < 8; ++e) { bias[e] = cb[c + e];
#pragma unroll
            for (int j = 0; j < 4; ++j) wt[j][e] = cw[j * 3072 + c + e]; }
        const bf16_t* xb = proj + (size_t)t0 * NP + C_XBC + 2048 + c;
        u32x4 r0 = (u32x4){0u, 0u, 0u, 0u}, r1 = r0, r2 = r0;
        if ((t0 & (SEQ - 1)) != 0) { r0 = *(const u32x4*)(xb - 3 * (ptrdiff_t)NP); r1 = *(const u32x4*)(xb - 2 * (ptrdiff_t)NP); r2 = *(const u32x4*)(xb - (ptrdiff_t)NP); }
        unsigned W[16][4];
#pragma unroll
        for (int tb = 0; tb < 16; tb += 4) {
            u32x4 rn[4];
#pragma unroll
            for (int u = 0; u < 4; ++u) rn[u] = *(const u32x4*)(xb + (size_t)(tb + u) * NP);
#pragma unroll
            for (int u = 0; u < 4; ++u) {
                const unsigned a0[4] = {r0.x, r0.y, r0.z, r0.w}, a1[4] = {r1.x, r1.y, r1.z, r1.w}, a2[4] = {r2.x, r2.y, r2.z, r2.w}, a3[4] = {rn[u].x, rn[u].y, rn[u].z, rn[u].w};
#pragma unroll
                for (int e = 0; e < 4; ++e) {
                    const float lo = bias[2 * e] + wt[0][2 * e] * lo16(a0[e]) + wt[1][2 * e] * lo16(a1[e]) + wt[2][2 * e] * lo16(a2[e]) + wt[3][2 * e] * lo16(a3[e]);
                    const float hi = bias[2 * e + 1] + wt[0][2 * e + 1] * hi16(a0[e]) + wt[1][2 * e + 1] * hi16(a1[e]) + wt[2][2 * e + 1] * hi16(a2[e]) + wt[3][2 * e + 1] * hi16(a3[e]);
                    W[tb + u][e] = pack2(silu_f(lo), silu_f(hi));
                }
                u32x4 o; o.x = W[tb + u][0]; o.y = W[tb + u][1]; o.z = W[tb + u][2]; o.w = W[tb + u][3];
                *(u32x4*)(bc + (size_t)(t0 + tb + u) * 1024 + c) = o;
                r0 = r1; r1 = r2; r2 = rn[u];
            }
        }
        if (c < 512) {
            bf16_t* tp = btg + ((size_t)((t0 >> 12) * 512 + c)) * SEQ + (t0 & (SEQ - 1));
#pragma unroll
            for (int e = 0; e < 4; ++e) {
                u32x4 lo0, lo1, hi0, hi1;
                lo0.x = (W[0][e] & 0xffffu) | (W[1][e] << 16); lo0.y = (W[2][e] & 0xffffu) | (W[3][e] << 16); lo0.z = (W[4][e] & 0xffffu) | (W[5][e] << 16); lo0.w = (W[6][e] & 0xffffu) | (W[7][e] << 16);
                lo1.x = (W[8][e] & 0xffffu) | (W[9][e] << 16); lo1.y = (W[10][e] & 0xffffu) | (W[11][e] << 16); lo1.z = (W[12][e] & 0xffffu) | (W[13][e] << 16); lo1.w = (W[14][e] & 0xffffu) | (W[15][e] << 16);
                hi0.x = (W[0][e] >> 16) | (W[1][e] & 0xffff0000u); hi0.y = (W[2][e] >> 16) | (W[3][e] & 0xffff0000u); hi0.z = (W[4][e] >> 16) | (W[5][e] & 0xffff0000u); hi0.w = (W[6][e] >> 16) | (W[7][e] & 0xffff0000u);
                hi1.x = (W[8][e] >> 16) | (W[9][e] & 0xffff0000u); hi1.y = (W[10][e] >> 16) | (W[11][e] & 0xffff0000u); hi1.z = (W[12][e] >> 16) | (W[13][e] & 0xffff0000u); hi1.w = (W[14][e] >> 16) | (W[15][e] & 0xffff0000u);
                *(u32x4*)(tp + (size_t)(2 * e) * SEQ) = lo0; *(u32x4*)(tp + (size_t)(2 * e) * SEQ + 8) = lo1;
                *(u32x4*)(tp + (size_t)(2 * e + 1) * SEQ) = hi0; *(u32x4*)(tp + (size_t)(2 * e + 1) * SEQ + 8) = hi1;
            }
        }
    }
}

#define SSD_SCAN(cc) do { float* dts_ = dbase + ((cc) & 1) * 384; float* acs_ = dts_ + 128; float* wdec_ = acs_ + 128; \
                const float v0 = dtr0 + dtb, v1 = dtr1 + dtb; \
                const float dt0 = (v0 > 20.f) ? v0 : log1pf(__expf(v0)), dt1 = (v1 > 20.f) ? v1 : log1pf(__expf(v1)); \
                const float a0 = dt0 * Aneg, a1 = dt1 * Aneg; \
                float sc = a0 + a1; \
                _Pragma("unroll") for (int o = 1; o < 64; o <<= 1) { const float tv = __shfl_up(sc, o); if (lane >= o) sc += tv; } \
                const float atot = __shfl(sc, 63); \
                dts_[2 * lane] = dt0; dts_[2 * lane + 1] = dt1; acs_[2 * lane] = sc - a1; acs_[2 * lane + 1] = sc; \
                wdec_[2 * lane] = dt0 * __expf(atot - (sc - a1)); wdec_[2 * lane + 1] = dt1 * __expf(atot - sc); } while (0)
__device__ __forceinline__ void phase_ssd(int wv, KParams p, int l, bf16_t* proj, const float* misc, const bf16_t* bc, const bf16_t* btg, float* ssq, unsigned char* shm, unsigned long long& tacc, unsigned long long& tst) {
    const int tid = opaque_tid(wv), wave = __builtin_amdgcn_readfirstlane(tid >> 6), lane = tid & 63, fr = lane & 15, fq = lane >> 4;
    constexpr int ROW = 272;
    unsigned char* Cr = shm; unsigned char* Br = Cr + 128 * ROW; unsigned char* BT = Br + 128 * ROW;
    unsigned char* XT = BT + 128 * ROW; unsigned char* Hb = XT + 32 * ROW;
    float* wtab = (float*)(Hb + 32 * ROW) + 768;
    float* dbase = (float*)(Hb + 32 * ROW);
    const float* cw = p->ssd_conv_w + (size_t)l * 4 * 3072; const float* cb = p->ssd_conv_b + (size_t)l * 3072;
    for (int item = blockIdx.x; item < 256; item += gridDim.x) {
        const int bl = item >> 6, head = (item >> 1) & 31, ph = item & 1, g = head >> 3;
        const float Aneg = -__expf(p->ssd_a_log[l * 32 + head]), dtb = p->ssd_dt_bias[l * 32 + head], Dsk = p->ssd_d[l * 32 + head];
        const int lx = tid >> 2, cgx = tid & 3, chx = head * 64 + ph * 32 + cgx * 8;
        const int sr = tid >> 4, sc16 = tid & 15;
        f32x4 Hacc[2][2];
#pragma unroll
        for (int q2 = 0; q2 < 2; ++q2) { Hacc[q2][0] = (f32x4){0.f, 0.f, 0.f, 0.f}; Hacc[q2][1] = (f32x4){0.f, 0.f, 0.f, 0.f}; }
        __syncthreads();
        for (int i = tid; i < 32 * ROW / 4; i += 512) ((unsigned*)Hb)[i] = 0u;
        if (tid < 160) { const int cgi = tid / 40, r = tid - cgi * 40, j = r >> 3, chn = head * 64 + ph * 32 + cgi * 8 + (r & 7); wtab[tid] = (j == 0) ? cb[chn] : cw[(j - 1) * 3072 + chn]; }
        __syncthreads();
        u32x4 xr[4], br[12]; float dtr0 = 0.f, dtr1 = 0.f;
        {
            const char* gb = (const char*)(proj + ((ptrdiff_t)bl * SEQ - 3) * NP + C_XBC);
            unsigned vo = (unsigned)((lx * NP + chx) * 2); asm volatile("" : "+v"(vo));
#pragma unroll
            for (int j = 0; j < 4; ++j) { xr[j] = (u32x4){0u, 0u, 0u, 0u}; if (lx - 3 + j >= 0) xr[j] = *(const u32x4*)(gb + (vo + (unsigned)(j * NP * 2))); }
            const char* hb2 = (const char*)(bc + ((size_t)bl * SEQ) * 1024);
            unsigned vb = (unsigned)((sr * 1024 + g * 128 + sc16 * 8) * 2); asm volatile("" : "+v"(vb));
            const char* tb2 = (const char*)(btg + ((size_t)(bl * 512 + g * 128)) * SEQ);
            unsigned vt2 = (unsigned)((sr * SEQ + sc16 * 8) * 2); asm volatile("" : "+v"(vt2));
#pragma unroll
            for (int u = 0; u < 4; ++u) { br[u] = *(const u32x4*)(hb2 + (vb + (unsigned)(u * 32 * 1024 * 2))); br[4 + u] = *(const u32x4*)(hb2 + (vb + (unsigned)(u * 32 * 1024 * 2 + 1024)));
                br[8 + u] = *(const u32x4*)(tb2 + (vt2 + (unsigned)(u * 32 * SEQ * 2))); }
            if (wave == 0) { const float* mp = misc + ((size_t)bl * SEQ + 2 * lane) * 256 + 72 + head; dtr0 = mp[0]; dtr1 = mp[256];
                SSD_SCAN(0);
                dtr0 = mp[128 * 256]; dtr1 = mp[128 * 256 + 256]; }
        }
        for (int c = 0; c < 32; ++c) {
            TIC(12);
            const int t0 = c * 128;
            const size_t rbase = (size_t)bl * SEQ + t0;
            const float* dts = dbase + (c & 1) * 384; const float* acs = dts + 128; const float* wdec = acs + 128;
            {
                float wt[4][8], bias[8];
                { const float* wl = wtab + cgx * 40;
                  const f32x4 b0 = *(const f32x4*)wl, b1 = *(const f32x4*)(wl + 4);
#pragma unroll
                  for (int e = 0; e < 4; ++e) { bias[e] = b0[e]; bias[4 + e] = b1[e]; }
#pragma unroll
                  for (int j = 0; j < 4; ++j) { const f32x4 w0 = *(const f32x4*)(wl + 8 + j * 8), w1 = *(const f32x4*)(wl + 12 + j * 8);
#pragma unroll
                      for (int e = 0; e < 4; ++e) { wt[j][e] = w0[e]; wt[j][4 + e] = w1[e]; } } }
                const unsigned a0[4] = {xr[0].x, xr[0].y, xr[0].z, xr[0].w}, a1[4] = {xr[1].x, xr[1].y, xr[1].z, xr[1].w}, a2[4] = {xr[2].x, xr[2].y, xr[2].z, xr[2].w}, a3[4] = {xr[3].x, xr[3].y, xr[3].z, xr[3].w};
                unsigned char* xp = XT + (cgx * 8) * ROW + lx * 2;
#pragma unroll
                for (int e = 0; e < 4; ++e) {
                    const float lo = bias[2 * e] + wt[0][2 * e] * lo16(a0[e]) + wt[1][2 * e] * lo16(a1[e]) + wt[2][2 * e] * lo16(a2[e]) + wt[3][2 * e] * lo16(a3[e]);
                    const float hi = bias[2 * e + 1] + wt[0][2 * e + 1] * hi16(a0[e]) + wt[1][2 * e + 1] * hi16(a1[e]) + wt[2][2 * e + 1] * hi16(a2[e]) + wt[3][2 * e + 1] * hi16(a3[e]);
                    *(bf16_t*)(xp + (2 * e) * ROW) = f2bf(silu_f(lo)); *(bf16_t*)(xp + (2 * e + 1) * ROW) = f2bf(silu_f(hi));
                }
            }
            {
#pragma unroll
                for (int u = 0; u < 4; ++u) {
                    *(u32x4*)(Br + (sr + 32 * u) * ROW + sc16 * 16) = br[u];
                    *(u32x4*)(Cr + (sr + 32 * u) * ROW + sc16 * 16) = br[4 + u];
                    *(u32x4*)(BT + (sr + 32 * u) * ROW + sc16 * 16) = br[8 + u];
                }
            }
            __syncthreads(); TOC(12); TIC(11);
            {
                const size_t rnext = rbase + ((c + 1 < 32) ? 128 : 0);
                const char* gb = (const char*)(proj + ((ptrdiff_t)rnext - 3) * NP + C_XBC);
                unsigned vo = (unsigned)((lx * NP + chx) * 2); asm volatile("" : "+v"(vo));
#pragma unroll
                for (int j = 0; j < 4; ++j) xr[j] = *(const u32x4*)(gb + (vo + (unsigned)(j * NP * 2)));
                const char* hb2 = (const char*)(bc + rnext * 1024);
                unsigned vb = (unsigned)((sr * 1024 + g * 128 + sc16 * 8) * 2); asm volatile("" : "+v"(vb));
                const char* tb2 = (const char*)(btg + ((size_t)(bl * 512 + g * 128)) * SEQ + (rnext - (size_t)bl * SEQ));
                unsigned vt2 = (unsigned)((sr * SEQ + sc16 * 8) * 2); asm volatile("" : "+v"(vt2));
#pragma unroll
                for (int u = 0; u < 4; ++u) { br[u] = *(const u32x4*)(hb2 + (vb + (unsigned)(u * 32 * 1024 * 2))); br[4 + u] = *(const u32x4*)(hb2 + (vb + (unsigned)(u * 32 * 1024 * 2 + 1024)));
                    br[8 + u] = *(const u32x4*)(tb2 + (vt2 + (unsigned)(u * 32 * SEQ * 2))); }
            }
            {
                const int lt = (wave < 4) ? wave : 11 - wave;
                bf16_t* zp = proj + (rbase + lt * 16 + fr) * NP + C_Z + head * 64 + ph * 32 + fq * 4;
                const u32x2 zr0 = *(const u32x2*)zp, zr1 = *(const u32x2*)(zp + 16);
                const float acs_l = acs[lt * 16 + fr];
                bf16x8 cf[4];
#pragma unroll
                for (int ks = 0; ks < 4; ++ks) cf[ks] = *(const bf16x8*)(Cr + (lt * 16 + fr) * ROW + (ks * 32 + fq * 8) * 2);
                f32x4 yacc[2];
                {
                    bf16x8 hf[2][4];
#pragma unroll
                    for (int pt = 0; pt < 2; ++pt)
#pragma unroll
                        for (int ks = 0; ks < 4; ++ks) hf[pt][ks] = *(const bf16x8*)(Hb + (pt * 16 + fr) * ROW + (ks * 32 + fq * 8) * 2);
                    const float el = __expf(acs_l);
#pragma unroll
                    for (int pt = 0; pt < 2; ++pt) {
                        yacc[pt] = (f32x4){0.f, 0.f, 0.f, 0.f};
#pragma unroll
                        for (int ks = 0; ks < 4; ++ks) yacc[pt] = __builtin_amdgcn_mfma_f32_16x16x32_bf16(hf[pt][ks], cf[ks], yacc[pt], 0, 0, 0);
                        yacc[pt] *= el;
                    }
                    __builtin_amdgcn_sched_group_barrier(0x100, 12, 0); __builtin_amdgcn_sched_group_barrier(0x008, 8, 0);
                }
                const int lloc = fr - fq * 4;
                f32x4 cbt[8];
#pragma unroll
                for (int kk = 0; kk < 4; ++kk) {
                    cbt[2 * kk] = (f32x4){0.f, 0.f, 0.f, 0.f}; cbt[2 * kk + 1] = (f32x4){0.f, 0.f, 0.f, 0.f};
                    if (2 * kk <= lt) {
                        bf16x8 bfr[2][4];
#pragma unroll
                        for (int h2 = 0; h2 < 2; ++h2)
#pragma unroll
                            for (int ks = 0; ks < 4; ++ks) bfr[h2][ks] = *(const bf16x8*)(Br + ((2 * kk + h2) * 16 + fr) * ROW + (ks * 32 + fq * 8) * 2);
#pragma unroll
                        for (int ks = 0; ks < 4; ++ks) {
                            cbt[2 * kk] = __builtin_amdgcn_mfma_f32_16x16x32_bf16(bfr[0][ks], cf[ks], cbt[2 * kk], 0, 0, 0);
                            cbt[2 * kk + 1] = __builtin_amdgcn_mfma_f32_16x16x32_bf16(bfr[1][ks], cf[ks], cbt[2 * kk + 1], 0, 0, 0);
                        }
                        __builtin_amdgcn_sched_group_barrier(0x100, 8, 0); __builtin_amdgcn_sched_group_barrier(0x008, 8, 0);
                    }
                }
                unsigned mp[8][2];
#pragma unroll
                for (int st = 0; st < 8; ++st) {
                    mp[st][0] = 0u; mp[st][1] = 0u;
                    if (st <= lt) {
                        const f32x4 av = *(const f32x4*)(acs + st * 16 + fq * 4), dv = *(const f32x4*)(dts + st * 16 + fq * 4);
                        float mv[4];
#pragma unroll
                        for (int r = 0; r < 4; ++r) {
                            const int dl = (lt - st) * 16 + lloc - r;
                            float m = (dl >= 0) ? cbt[st][r] * __expf(acs_l - av[r]) * dv[r] : 0.f;
                            if (dl == 0) m += Dsk;
                            mv[r] = m;
                        }
                        mp[st][0] = pg8::cvt_pk_bf16(mv[0], mv[1]); mp[st][1] = pg8::cvt_pk_bf16(mv[2], mv[3]);
                    }
                }
#pragma unroll
                for (int kk = 0; kk < 4; ++kk) {
                    if (2 * kk <= lt) {
                        u32x4 pk; pk.x = mp[2 * kk][0]; pk.y = mp[2 * kk][1]; pk.z = mp[2 * kk + 1][0]; pk.w = mp[2 * kk + 1][1];
                        const bf16x8 pf = __builtin_bit_cast(bf16x8, pk);
#pragma unroll
                        for (int pt = 0; pt < 2; ++pt) {
                            const unsigned char* xp = XT + (pt * 16 + fr) * ROW + (kk * 32 + fq * 4) * 2;
                            const bf16x4 v0 = *(const bf16x4*)xp, v1 = *(const bf16x4*)(xp + 32);
                            const bf16x8 xf = __builtin_shufflevector(v0, v1, 0, 1, 2, 3, 4, 5, 6, 7);
                            yacc[pt] = __builtin_amdgcn_mfma_f32_16x16x32_bf16(xf, pf, yacc[pt], 0, 0, 0);
                        }
                    }
                }
                float sq = 0.f;
#pragma unroll
                for (int pt = 0; pt < 2; ++pt) {
                    const u32x2 zr = pt ? zr1 : zr0;
                    const float y0 = yacc[pt][0] * silu_f(lo16(zr.x)), y1 = yacc[pt][1] * silu_f(hi16(zr.x)), y2 = yacc[pt][2] * silu_f(lo16(zr.y)), y3 = yacc[pt][3] * silu_f(hi16(zr.y));
                    sq += y0 * y0 + y1 * y1 + y2 * y2 + y3 * y3;
                    u32x2 w; w.x = pg8::cvt_pk_bf16(y0, y1); w.y = pg8::cvt_pk_bf16(y2, y3);
                    *(u32x2*)(zp + pt * 16) = w;
                }
                sq += __shfl_xor(sq, 16); sq += __shfl_xor(sq, 32);
                if (fq == 0) ssq[(rbase + lt * 16 + fr) * 64 + head * 2 + ph] = sq;
                if (wave < 4) {
                    const float dec = __expf(acs[127]);
#pragma unroll
                    for (int q2 = 0; q2 < 2; ++q2) { Hacc[q2][0] *= dec; Hacc[q2][1] *= dec; }
#pragma unroll
                    for (int ks = 0; ks < 4; ++ks) {
                        const f32x4 w0 = *(const f32x4*)(wdec + ks * 32 + fq * 8), w1 = *(const f32x4*)(wdec + ks * 32 + fq * 8 + 4);
                        bf16x8 xw[2];
#pragma unroll
                        for (int pt = 0; pt < 2; ++pt) {
                            const u32x4 raw = *(const u32x4*)(XT + (pt * 16 + fr) * ROW + (ks * 32 + fq * 8) * 2);
                            u32x4 sc4;
                            sc4.x = pg8::cvt_pk_bf16(lo16(raw.x) * w0[0], hi16(raw.x) * w0[1]); sc4.y = pg8::cvt_pk_bf16(lo16(raw.y) * w0[2], hi16(raw.y) * w0[3]);
                            sc4.z = pg8::cvt_pk_bf16(lo16(raw.z) * w1[0], hi16(raw.z) * w1[1]); sc4.w = pg8::cvt_pk_bf16(lo16(raw.w) * w1[2], hi16(raw.w) * w1[3]);
                            xw[pt] = __builtin_bit_cast(bf16x8, sc4);
                        }
#pragma unroll
                        for (int q2 = 0; q2 < 2; ++q2) {
                            const bf16x8 btf = *(const bf16x8*)(BT + ((wave * 2 + q2) * 16 + fr) * ROW + (ks * 32 + fq * 8) * 2);
                            Hacc[q2][0] = __builtin_amdgcn_mfma_f32_16x16x32_bf16(xw[0], btf, Hacc[q2][0], 0, 0, 0);
                            Hacc[q2][1] = __builtin_amdgcn_mfma_f32_16x16x32_bf16(xw[1], btf, Hacc[q2][1], 0, 0, 0);
                        }
                    }
                }
            }
            TOC(11); TIC(13);
            if (wave == 0 && c + 1 < 32) {
                SSD_SCAN(c + 1);
                if (c + 2 < 32) { const float* mp = misc + (rbase + 256 + 2 * lane) * 256 + 72 + head; dtr0 = mp[0]; dtr1 = mp[256]; }
            }
            __syncthreads();
            if (wave < 4) {
#pragma unroll
                for (int q2 = 0; q2 < 2; ++q2)
#pragma unroll
                    for (int pt = 0; pt < 2; ++pt)
#pragma unroll
                        for (int r = 0; r < 4; ++r) *(bf16_t*)(Hb + (pt * 16 + fq * 4 + r) * ROW + ((wave * 2 + q2) * 16 + fr) * 2) = f2bf(Hacc[q2][pt][r]);
            }
            TOC(13);
        }
    }
}

#undef SSD_SCAN
__device__ __forceinline__ void phase_gtab(int wv, const float* ssq, float* gtab) {
    const int tid = opaque_tid(wv);
    pg8::StaticOrder S; S.init(SLAB, 1024, (int)gridDim.x, (int)blockIdx.x);
    pg8::Unit u;
    for (int ui = 0; ui < 4 && S.next(ui, u); ++ui) {
        if (tid < 256) {
            const float* sp = ssq + (size_t)(u.pm * 256 + tid) * 64;
            float r[4];
#pragma unroll
            for (int g = 0; g < 4; ++g) {
                const f32x4 s0 = *(const f32x4*)(sp + g * 16), s1 = *(const f32x4*)(sp + g * 16 + 4), s2 = *(const f32x4*)(sp + g * 16 + 8), s3 = *(const f32x4*)(sp + g * 16 + 12);
                const float tot = s0[0] + s0[1] + s0[2] + s0[3] + s1[0] + s1[1] + s1[2] + s1[3] + s2[0] + s2[1] + s2[2] + s2[3] + s3[0] + s3[1] + s3[2] + s3[3];
                r[g] = rsqrtf(tot * (1.0f / 512.0f) + EPS);
            }
            float* tp = gtab + ui * 1024 + tid;
            tp[0] = r[0] / r[1]; tp[256] = r[1] / r[2]; tp[512] = r[2] / r[3]; tp[768] = r[3];
        }
    }
    __syncthreads();
}

__device__ __forceinline__ void phase_convglu(int wv, const bf16_t* U, bf16_t* GL, const float* cw, const float* cb) {
    const int tid = opaque_tid(wv);
    for (int idx = blockIdx.x * 512 + tid; idx < 352 * (SLAB / 32); idx += gridDim.x * 512) {
        const int run = idx / 352, f = (idx - run * 352) * 8, t0 = run * 32;
        float wg[3][8], wvv[3][8], bg[8], bv[8];
#pragma unroll
        for (int e = 0; e < 8; ++e) { bg[e] = cb[f + e]; bv[e] = cb[FFN + f + e];
#pragma unroll
            for (int j = 0; j < 3; ++j) { wg[j][e] = cw[j * FFN2 + f + e]; wvv[j][e] = cw[j * FFN2 + FFN + f + e]; } }
        u32x4 g0 = (u32x4){0u, 0u, 0u, 0u}, g1 = g0, v0 = g0, v1 = g0;
        if ((t0 & (SEQ - 1)) != 0) {
            const bf16_t* up = U + (size_t)(t0 - 2) * FFN2 + f;
            g0 = *(const u32x4*)up; v0 = *(const u32x4*)(up + FFN); g1 = *(const u32x4*)(up + FFN2); v1 = *(const u32x4*)(up + FFN2 + FFN);
        }
        for (int tb = 0; tb < 32; tb += 4) {
            u32x4 gn[4], vn[4];
#pragma unroll
            for (int u = 0; u < 4; ++u) { const bf16_t* up = U + (size_t)(t0 + tb + u) * FFN2 + f; gn[u] = *(const u32x4*)up; vn[u] = *(const u32x4*)(up + FFN); }
#pragma unroll
            for (int u = 0; u < 4; ++u) {
                const unsigned ga0[4] = {g0.x, g0.y, g0.z, g0.w}, ga1[4] = {g1.x, g1.y, g1.z, g1.w}, ga2[4] = {gn[u].x, gn[u].y, gn[u].z, gn[u].w};
                const unsigned va0[4] = {v0.x, v0.y, v0.z, v0.w}, va1[4] = {v1.x, v1.y, v1.z, v1.w}, va2[4] = {vn[u].x, vn[u].y, vn[u].z, vn[u].w};
                unsigned ow[4];
#pragma unroll
                for (int e = 0; e < 4; ++e) {
                    const float gl = bg[2 * e] + wg[0][2 * e] * lo16(ga0[e]) + wg[1][2 * e] * lo16(ga1[e]) + wg[2][2 * e] * lo16(ga2[e]);
                    const float gh = bg[2 * e + 1] + wg[0][2 * e + 1] * hi16(ga0[e]) + wg[1][2 * e + 1] * hi16(ga1[e]) + wg[2][2 * e + 1] * hi16(ga2[e]);
                    const float vl = bv[2 * e] + wvv[0][2 * e] * lo16(va0[e]) + wvv[1][2 * e] * lo16(va1[e]) + wvv[2][2 * e] * lo16(va2[e]);
                    const float vh = bv[2 * e + 1] + wvv[0][2 * e + 1] * hi16(va0[e]) + wvv[1][2 * e + 1] * hi16(va1[e]) + wvv[2][2 * e + 1] * hi16(va2[e]);
                    ow[e] = pack2(silu_f(gl) * vl, silu_f(gh) * vh);
                }
                u32x4 o; o.x = ow[0]; o.y = ow[1]; o.z = ow[2]; o.w = ow[3];
                *(u32x4*)(GL + (size_t)(t0 + tb + u) * FFN + f) = o;
                g0 = g1; g1 = gn[u]; v0 = v1; v1 = vn[u];
            }
        }
    }
}

__device__ __forceinline__ KParams kparams() { KParams k = (KParams)__builtin_amdgcn_kernarg_segment_ptr(); asm volatile("" : "+s"(k)); return k; }
#define WSP(T, off) ((T*)(kparams()->ws + (off)))

__global__ void __launch_bounds__(512, 2) mega(Params p_unused) {
    extern __shared__ __attribute__((aligned(16))) unsigned char shm[];
    cg::grid_group grid = cg::this_grid();
    const int wv = __builtin_amdgcn_readfirstlane((int)(threadIdx.x >> 6));
    LAS unsigned char* lds = (LAS unsigned char*)shm;
    unsigned long long tacc = 0ull, tst = 0ull;

#define NORM_MIX(l_, half_) do { KParams k_ = kparams(); const float* xi_ = ((l_) == 0) ? k_->x : k_->out; \
        phase_norm<false>(wv, xi_ + (size_t)(half_) * SLAB * 1024, k_->norm_mix_w + (l_) * 1024, WSP(bf16_t, OFF_H), nullptr, SLAB); } while (0)
#define NORM_FFN(l_, half_) do { KParams k_ = kparams(); \
        phase_norm<false>(wv, k_->out + (size_t)(half_) * SLAB * 1024, k_->norm_ffn_w + (l_) * 1024, WSP(bf16_t, OFF_H), nullptr, SLAB); } while (0)
    TIC(9); phase_convert(wv, kparams(), (float*)shm);
    NORM_MIX(0, 0);
    grid.sync(); TOC(9);
    for (int l = 0; l < DEPTH; ++l) {
        for (int half = 0; half < NSLAB; ++half) {
            const size_t r0 = (size_t)half * SLAB;
            TIC(1);
            { const float* rope = WSP(const float, OFF_ROPE);
              EpiInProj E{WSP(bf16_t, OFF_PROJ), WSP(float, OFF_MISC), rope, rope + 4096 * 16, rope + 4096 * 32, rope + 4096 * 40, WSP(bf16_t, OFF_VT)};
              pg8::gemm_phase(wv, lds, WSP(const bf16_t, OFF_H), 1024, WSP(const bf16_t, OFF_W + (size_t)l * SZ_WL), SLAB, NP, 1024, E); }
            grid.sync(); TOC(1); TIC(2);
            phase_bcconv(wv, kparams(), l, WSP(const bf16_t, OFF_PROJ), WSP(bf16_t, OFF_H), WSP(bf16_t, OFF_BTG));
            phase_idx(wv, WSP(const bf16_t, OFF_PROJ), WSP(const float, OFF_MISC), WSP(unsigned, OFF_MASK), shm);
            grid.sync(); TOC(2); TIC(3);
            phase_att(wv, WSP(bf16_t, OFF_PROJ), WSP(const bf16_t, OFF_VT), WSP(const unsigned, OFF_MASK), shm);
            __syncthreads(); TOC(3); TIC(4);
            { phase_ssd(wv, kparams(), l, WSP(bf16_t, OFF_PROJ), WSP(const float, OFF_MISC), WSP(const bf16_t, OFF_H), WSP(const bf16_t, OFF_BTG), WSP(float, OFF_SSQ), shm, tacc, tst); }
            TOC(4); TIC(10); grid.sync(); TOC(10); TIC(5);
            phase_gtab(wv, WSP(const float, OFF_SSQ), (float*)(shm + 131072));
            { EpiGateA E{WSP(bf16_t, OFF_PROJ)}; pg8::gemm_phase(wv, lds, WSP(const bf16_t, OFF_PROJ) + C_Q, NP, WSP(const bf16_t, OFF_W + (size_t)l * SZ_WL + SZ_WIN), SLAB, 1024, 1024, E); }
            { EpiGateS E{WSP(bf16_t, OFF_PROJ), (const float*)(shm + 131072)}; pg8::gemm_phase(wv, lds, WSP(const bf16_t, OFF_PROJ) + C_Z, NP, WSP(const bf16_t, OFF_W + (size_t)l * SZ_WL + SZ_WIN + SZ_WPA), SLAB, 1024, 2048, E); }
            grid.sync();
            { KParams k = kparams(); const float* xin = (l == 0) ? k->x : k->out;
              EpiResid E{xin + r0 * 1024, k->out + r0 * 1024};
              pg8::gemm_phase(wv, lds, WSP(const bf16_t, OFF_PROJ) + C_GS, NP, WSP(const bf16_t, OFF_W + (size_t)l * SZ_WL + SZ_WIN + SZ_WPA + SZ_WPS), SLAB, 1024, 1024, E); }
            if (half == 0) NORM_MIX(l, 1); else NORM_FFN(l, 0);
            grid.sync(); TOC(5);
        }
        for (int half = 0; half < NSLAB; ++half) {
            const size_t r0 = (size_t)half * SLAB;
            TIC(6);
            { EpiBf16 E{WSP(bf16_t, OFF_PROJ), FFN2};
              pg8::gemm_phase(wv, lds, WSP(const bf16_t, OFF_H), 1024, WSP(const bf16_t, OFF_W + (size_t)l * SZ_WL + SZ_WIN + SZ_WPA + SZ_WPS + SZ_WO), SLAB, FFN2, 1024, E); }
            grid.sync(); TOC(6); TIC(7);
            { KParams k = kparams(); phase_convglu(wv, WSP(const bf16_t, OFF_PROJ), WSP(bf16_t, OFF_GL), k->ffn_conv_w + (size_t)l * 3 * FFN2, k->ffn_conv_b + (size_t)l * FFN2); }
            grid.sync(); TOC(7); TIC(6);
            { KParams k = kparams(); EpiResid E{k->out + r0 * 1024, k->out + r0 * 1024};
              pg8::gemm_phase(wv, lds, WSP(const bf16_t, OFF_GL), FFN, WSP(const bf16_t, OFF_W + (size_t)l * SZ_WL + SZ_WIN + SZ_WPA + SZ_WPS + SZ_WO + SZ_WUP), SLAB, 1024, FFN, E); }
            if (half == 0) NORM_FFN(l, 1); else if (l + 1 < DEPTH) NORM_MIX(l + 1, 0);
            grid.sync(); TOC(6);
        }
    }
    { KParams k = kparams(); phase_norm<true>(wv, k->out, k->norm_final_w, nullptr, k->out, NTOK); }
    if (PROBE != 0 && blockIdx.x == 0) { const unsigned long long tend = __builtin_amdgcn_s_memrealtime() + 4ull * tacc; while (__builtin_amdgcn_s_memrealtime() < tend) __builtin_amdgcn_s_sleep(8); }
}

extern "C" void kernel_launch(void* const* d_in, const int* in_sizes, int n_in, void* d_out, int out_size, void* d_ws, size_t ws_size, hipStream_t stream) {
    static int grid_blocks = 0;
    if (!grid_blocks) {
        int dev = 0, cus = 0, per_cu = 0;
        hipGetDevice(&dev);
        hipDeviceGetAttribute(&cus, hipDeviceAttributeMultiprocessorCount, dev);
        hipFuncSetAttribute((const void*)mega, hipFuncAttributeMaxDynamicSharedMemorySize, LDS_BYTES);
        hipOccupancyMaxActiveBlocksPerMultiprocessor(&per_cu, mega, 512, LDS_BYTES);
        if (per_cu < 1) per_cu = 1;
        grid_blocks = cus * 1;
    }
    if (ws_size < OFF_END) { fprintf(stderr, "workspace too small: %zu < %zu\n", ws_size, (size_t)OFF_END); return; }
    Params p{};
    p.x = (const float*)d_in[0]; p.norm_mix_w = (const float*)d_in[1]; p.w_in = (const float*)d_in[2]; p.ssd_conv_w = (const float*)d_in[3]; p.ssd_conv_b = (const float*)d_in[4];
    p.ssd_dt_bias = (const float*)d_in[5]; p.ssd_a_log = (const float*)d_in[6]; p.ssd_d = (const float*)d_in[7]; p.ssd_norm_w = (const float*)d_in[8];
    p.w_proj_attn = (const float*)d_in[9]; p.w_proj_ssd = (const float*)d_in[10]; p.w_out = (const float*)d_in[11]; p.norm_ffn_w = (const float*)d_in[12];
    p.ffn_w_up = (const float*)d_in[13]; p.ffn_conv_w = (const float*)d_in[14]; p.ffn_conv_b = (const float*)d_in[15]; p.ffn_w_down = (const float*)d_in[16]; p.norm_final_w = (const float*)d_in[17];
    p.out = (float*)d_out; p.ws = (unsigned char*)d_ws;
    for (int i = 0; i < 16; ++i) p.invA[i] = powf(500000.0f, -(float)(2 * i) / 32.0f);
    for (int i = 0; i < 8; ++i) p.invI[i] = powf(500000.0f, -(float)(2 * i) / 16.0f);
    void* args[] = {&p};
    hipError_t e = hipLaunchCooperativeKernel((const void*)mega, dim3(grid_blocks), dim3(512), args, LDS_BYTES, stream);
    if (e != hipSuccess) fprintf(stderr, "cooperative launch failed: %s (grid %d)\n", hipGetErrorString(e), grid_blocks);
}
```

```cpp
#include <hip/hip_runtime.h>
#include <hip/hip_cooperative_groups.h>
#include <cstdio>
#include <cmath>
namespace cg = cooperative_groups;

#define LAS __attribute__((address_space(3)))
typedef unsigned short bf16_t;
typedef short bf16x8 __attribute__((ext_vector_type(8)));
typedef float f32x4 __attribute__((ext_vector_type(4)));
typedef unsigned u32x2 __attribute__((ext_vector_type(2)));
typedef unsigned u32x4 __attribute__((ext_vector_type(4)));

constexpr int D_MODEL = 1024, SEQ = 4096, NTOK = 32768, SLAB = 16384, NSLAB = 2, DEPTH = 2;
constexpr int IN_COLS = 9320, NP = 9472;
constexpr int C_Q = 0, C_K = 1024, C_V = 1280, C_QI = 1536, C_MISC = 2048, C_Z = 2304, C_XBC = 4352, C_GA = 7424, C_GS = 8448;
constexpr int FFN = 2816, FFN2 = 5632;
constexpr float EPS = 1e-6f;

constexpr size_t SZ_WIN = (size_t)NP * 1024 * 2, SZ_WPA = (size_t)1024 * 1024 * 2, SZ_WPS = (size_t)1024 * 2048 * 2, SZ_WO = SZ_WPA,
                 SZ_WUP = (size_t)FFN2 * 1024 * 2, SZ_WDN = (size_t)1024 * FFN * 2;
constexpr size_t SZ_WL = SZ_WIN + SZ_WPA + SZ_WPS + SZ_WO + SZ_WUP + SZ_WDN;
constexpr size_t OFF_W = 0;
constexpr size_t OFF_ROPE = OFF_W + 2 * SZ_WL;
constexpr size_t OFF_H = OFF_ROPE + (size_t)4096 * 48 * 4;
constexpr size_t OFF_PROJ = OFF_H + (size_t)SLAB * 1024 * 2;
constexpr size_t OFF_MISC = OFF_PROJ + (size_t)SLAB * NP * 2;
constexpr size_t OFF_MASK = OFF_MISC + (size_t)SLAB * 256 * 4;
constexpr size_t OFF_SEL = OFF_MASK + (size_t)SLAB * 128 * 4;
constexpr size_t OFF_SSQ = OFF_SEL + (size_t)SLAB * 256 * 4;
constexpr size_t OFF_VT = OFF_SSQ + (size_t)SLAB * 64 * 4;
constexpr size_t OFF_BTG = OFF_VT + (size_t)4 * 2 * 128 * 4096 * 2;
constexpr size_t OFF_END = OFF_BTG + (size_t)4 * 512 * 4096 * 2;
static_assert(OFF_END <= (size_t)536870912, "workspace budget");
constexpr size_t OFF_GL = OFF_PROJ + (size_t)SLAB * FFN2 * 2;

constexpr int LDS_BYTES = 150528;
#ifndef PROBE
#define PROBE 0
#endif
#define TIC(k) do { if (PROBE == (k)) tst = __builtin_amdgcn_s_memrealtime(); } while (0)
#define TOC(k) do { if (PROBE == (k)) tacc += __builtin_amdgcn_s_memrealtime() - tst; } while (0)

struct Params {
    const float* x; const float* norm_mix_w; const float* w_in; const float* ssd_conv_w; const float* ssd_conv_b;
    const float* ssd_dt_bias; const float* ssd_a_log; const float* ssd_d; const float* ssd_norm_w;
    const float* w_proj_attn; const float* w_proj_ssd; const float* w_out; const float* norm_ffn_w;
    const float* ffn_w_up; const float* ffn_conv_w; const float* ffn_conv_b; const float* ffn_w_down; const float* norm_final_w;
    float* out; unsigned char* ws;
    float invA[16]; float invI[8];
};
typedef const __attribute__((address_space(4))) Params* KParams;

__device__ __forceinline__ int opaque_tid(int wv) { int t; asm volatile("v_mbcnt_lo_u32_b32 %0, -1, 0\n\tv_mbcnt_hi_u32_b32 %0, -1, %0" : "=v"(t)); return wv * 64 + t; }
__device__ __forceinline__ float bf2f(bf16_t b) { return __uint_as_float(((unsigned)b) << 16); }
__device__ __forceinline__ bf16_t f2bf(float f) { unsigned u = __float_as_uint(f); u += 0x7FFFu + ((u >> 16) & 1u); return (bf16_t)(u >> 16); }
__device__ __forceinline__ unsigned pack2(float lo, float hi) { return (unsigned)f2bf(lo) | ((unsigned)f2bf(hi) << 16); }
__device__ __forceinline__ float lo16(unsigned w) { return __uint_as_float(w << 16); }
__device__ __forceinline__ float hi16(unsigned w) { return __uint_as_float(w & 0xffff0000u); }
__device__ __forceinline__ float silu_f(float v) { return v * __builtin_amdgcn_rcpf(1.0f + __expf(-v)); }
__device__ __forceinline__ float sigmoid_f(float v) { return __builtin_amdgcn_rcpf(1.0f + __expf(-v)); }
__device__ __forceinline__ void wave_lds_sync() { __builtin_amdgcn_fence(__ATOMIC_SEQ_CST, "wavefront"); __builtin_amdgcn_wave_barrier(); }
__device__ __forceinline__ float wave_sum(float v) {
#pragma unroll
    for (int o = 32; o >= 1; o >>= 1) v += __shfl_xor(v, o);
    return v;
}
__device__ __forceinline__ float wave_max(float v) {
#pragma unroll
    for (int o = 32; o >= 1; o >>= 1) v = fmaxf(v, __shfl_xor(v, o));
    return v;
}
__device__ __forceinline__ int permA(int s) { return 16 * ((s >> 2) & 1) + 4 * (s >> 3) + (s & 3); }
__device__ __forceinline__ int permI(int s) { return s < 16 ? 8 * ((s >> 2) & 1) + 4 * (s >> 3) + (s & 3) : s; }
__device__ __forceinline__ int perm32(int rho) { const int n = rho >> 4, i = rho & 15; return 8 * (i >> 2) + 4 * n + (i & 3); }
__device__ __forceinline__ int inproj_map(int n) {
    if (n < C_V) { const int sd = n & 127; return (sd < 32) ? (n & ~127) + permA(sd) : n; }
    if (n < C_QI) return n;
    if (n < C_MISC) { const int r = n - C_QI; return C_QI + (r & ~63) + permI(r & 63); }
    if (n < C_Z) { const int c = n - C_MISC; if (c < 64) return 2048 + permI(c); if (c < 72) return 2112 + (c - 64); if (c < 104) return 7240 + (c - 72); return -1; }
    if (n < C_XBC) return 2120 + (n - C_Z);
    if (n < C_GA) return 4168 + (n - C_XBC);
    if (n < C_GS) return 7272 + (n - C_GA);
    return 8296 + (n - C_GS);
}

namespace pg8 {
constexpr int BM = 256, BK = 64, HALF = 128, HTB = HALF * BK * 2, NXCD = 8, WGM = 2;
__device__ __forceinline__ int lds_byte(int r, int c) { const int st = (r >> 4) * 2 + (c >> 5), rr = r & 15, cc = c & 31, ob = rr * 64 + cc * 2; return st * 1024 + (ob ^ (((ob >> 9) & 1) << 5)); }
__device__ __forceinline__ void stage_rc(int b, int& R, int& C) { const int st = b / 1024, sb = b % 1024, swz = sb ^ (((sb >> 9) & 1) << 5); R = (st >> 1) * 16 + swz / 64; C = (st & 1) * 32 + (swz % 64) / 2; }
struct Unit { int pm, pn; };
struct StaticOrder {
    int nM, nN, nwg, G, c;
    __device__ void init(int M, int N, int G_, int c_) { nM = M / BM; nN = N / BM; nwg = nM * nN; G = G_; c = c_; }
    __device__ bool next(int i, Unit& u) const {
        const long L = (long)i * G + c; if (L >= nwg) return false;
        int wgid = (int)L; { const int q = nwg / NXCD, r = nwg % NXCD, xcd = wgid % NXCD, off = wgid / NXCD; wgid = (xcd < r ? xcd * (q + 1) : r * (q + 1) + (xcd - r) * q) + off; }
        const int nig = WGM * nN, gid = wgid / nig, fm = gid * WGM, gsz = (nM - fm) < WGM ? (nM - fm) : WGM;
        u.pm = fm + ((wgid % nig) % gsz); u.pn = (wgid % nig) / gsz; return true;
    }
};
__device__ __forceinline__ unsigned cvt_pk_bf16(float lo, float hi) { unsigned r; asm volatile("v_cvt_pk_bf16_f32 %0, %1, %2" : "=v"(r) : "v"(lo), "v"(hi)); return r; }

template <class Epi>
__device__ __forceinline__ void gemm_phase(int wv, LAS unsigned char* lds, const bf16_t* A, int lda, const bf16_t* Bt, int M, int N, int K, const Epi& E) {
    const int tid = opaque_tid(wv), wid = __builtin_amdgcn_readfirstlane(tid >> 6), lane = tid & 63, wr = wid >> 2, wc = wid & 3, fr = lane & 15, fq = lane >> 4;
    const int nt = K / BK;
    StaticOrder S; S.init(M, N, (int)gridDim.x, (int)blockIdx.x);
    unsigned voffA[2], voffB[2];
#pragma unroll
    for (int i = 0; i < 2; ++i) { int R, C; stage_rc(tid * 16 + i * 8192, R, C); voffA[i] = (unsigned)(R * lda + C) * 2u; voffB[i] = (unsigned)(R * K + C) * 2u; }
    const size_t kstep = (size_t)(BK * 2);
    const size_t hstepA = (size_t)HALF * lda * 2, hstepB = (size_t)HALF * K * 2;
    const size_t tstepA = 2 * hstepA, tstepB = 2 * hstepB;
    const unsigned ldsw = (unsigned)wid * 1024u;
    const int aoff = lds_byte(wr * 64 + fr, fq * 8), boff = lds_byte(wc * 32 + fr, fq * 8);
#define PG8_SA(b, h) (((b) * 2 + (h)) * HTB)
#define PG8_SB(b, h) ((4 + (b) * 2 + (h)) * HTB)
#define PG8_STAGE(bufoff, gbase, voff) do { _Pragma("unroll") for (int _i = 0; _i < 2; ++_i) \
        __builtin_amdgcn_global_load_lds((const unsigned*)((const char*)(gbase) + (voff)[_i]), (LAS unsigned*)(lds + (bufoff) + ldsw + _i * 8192), 16, 0, 0); } while (0)
#define PG8_LDA(dst, b, h) do { _Pragma("unroll") for (int m = 0; m < 4; ++m) _Pragma("unroll") for (int k = 0; k < 2; ++k) dst[m][k] = *(const LAS bf16x8*)(lds + PG8_SA(b, h) + aoff + m * 2048 + k * 1024); } while (0)
#define PG8_LDB(dst, b, h) do { _Pragma("unroll") for (int n = 0; n < 2; ++n) _Pragma("unroll") for (int k = 0; k < 2; ++k) dst[n][k] = *(const LAS bf16x8*)(lds + PG8_SB(b, h) + boff + n * 2048 + k * 1024); } while (0)
#define PG8_MMA(ai, bj, At, Bt_) do { __builtin_amdgcn_s_setprio(1); _Pragma("unroll") for (int m = 0; m < 4; ++m) _Pragma("unroll") for (int n = 0; n < 2; ++n) _Pragma("unroll") for (int k = 0; k < 2; ++k) \
        acc[ai][bj][m][n] = __builtin_amdgcn_mfma_f32_16x16x32_bf16(Bt_[n][k], At[m][k], acc[ai][bj][m][n], 0, 0, 0); __builtin_amdgcn_s_setprio(0); } while (0)
#define PG8_WAIT_V(n) asm volatile("s_waitcnt vmcnt(" #n ")" ::: "memory")
#define PG8_WAIT_L(n) asm volatile("s_waitcnt lgkmcnt(" #n ")" ::: "memory")
#define PG8_BAR __builtin_amdgcn_s_barrier()
#define PG8_SCHED __builtin_amdgcn_sched_barrier(0)
    Unit cur, nxt; int ui = 0;
    if (!S.next(0, cur)) return;
    f32x4 acc[2][2][4][2];
#pragma unroll
    for (int a = 0; a < 2; ++a)
#pragma unroll
        for (int b = 0; b < 2; ++b)
#pragma unroll
            for (int m = 0; m < 4; ++m)
#pragma unroll
                for (int n = 0; n < 2; ++n) acc[a][b][m][n] = (f32x4){0.f, 0.f, 0.f, 0.f};
    bf16x8 At[4][2], B0[2][2], B1[2][2];
    const char* cA = (const char*)A + (size_t)cur.pm * tstepA; const char* cB = (const char*)Bt + (size_t)cur.pn * tstepB;
    PG8_STAGE(PG8_SB(0, 0), cB, voffB); PG8_STAGE(PG8_SB(0, 1), cB + hstepB, voffB); PG8_STAGE(PG8_SA(0, 0), cA, voffA); PG8_STAGE(PG8_SA(0, 1), cA + hstepA, voffA);
    if (wr == 1) PG8_BAR;
    PG8_WAIT_V(2); PG8_BAR;
    PG8_STAGE(PG8_SB(1, 0), cB + kstep, voffB); PG8_STAGE(PG8_SA(1, 0), cA + kstep, voffA); PG8_STAGE(PG8_SB(1, 1), cB + hstepB + kstep, voffB);
    PG8_WAIT_V(6); PG8_BAR;
    for (;;) {
        const bool has_next = S.next(ui + 1, nxt);
        const char* nA = has_next ? (const char*)A + (size_t)nxt.pm * tstepA : cA; const char* nB = has_next ? (const char*)Bt + (size_t)nxt.pn * tstepB : cB;
        const int TG = Epi::GS ? 8 : nt;
        for (int tg = 0; tg < nt; tg += TG) {
        for (int t = tg; t < tg + TG; t += 2) {
            const bool last = (t == nt - 2);
            const char* a1 = cA + (size_t)(t + 1) * kstep;
            const char* a2 = last ? nA : cA + (size_t)(t + 2) * kstep; const char* b2 = last ? nB : cB + (size_t)(t + 2) * kstep;
            const char* a3 = a2 + kstep; const char* b3 = b2 + kstep;
            PG8_LDB(B0, 0, 0); PG8_LDB(B1, 0, 1); PG8_SCHED; PG8_LDA(At, 0, 0); PG8_STAGE(PG8_SA(1, 1), a1 + hstepA, voffA);
            PG8_WAIT_V(8); PG8_WAIT_L(0); PG8_BAR; PG8_MMA(0, 0, At, B0); PG8_MMA(0, 1, At, B1); PG8_BAR; PG8_SCHED;
            PG8_LDA(At, 0, 1); PG8_STAGE(PG8_SB(0, 0), b2, voffB); PG8_STAGE(PG8_SB(0, 1), b2 + hstepB, voffB); PG8_STAGE(PG8_SA(0, 0), a2, voffA);
            PG8_WAIT_V(8); PG8_WAIT_L(0); PG8_BAR; PG8_MMA(1, 0, At, B0); PG8_MMA(1, 1, At, B1); PG8_BAR; PG8_SCHED;
            PG8_LDB(B0, 1, 0); PG8_LDB(B1, 1, 1); PG8_SCHED; PG8_LDA(At, 1, 0); PG8_STAGE(PG8_SA(0, 1), a2 + hstepA, voffA);
            PG8_WAIT_V(8); PG8_WAIT_L(0); PG8_BAR; PG8_MMA(0, 0, At, B0); PG8_MMA(0, 1, At, B1); PG8_BAR; PG8_SCHED;
            PG8_LDA(At, 1, 1); PG8_STAGE(PG8_SB(1, 0), b3, voffB); PG8_STAGE(PG8_SB(1, 1), b3 + hstepB, voffB); PG8_STAGE(PG8_SA(1, 0), a3, voffA);
            PG8_WAIT_V(8); PG8_WAIT_L(0); PG8_BAR; PG8_MMA(1, 0, At, B0); PG8_MMA(1, 1, At, B1); PG8_BAR; PG8_SCHED;
        }
        if constexpr (Epi::GS) { if (tg + TG < nt) E.group_scale(acc, ui, tg >> 3, wr, fr); }
        }
        if (wr == 0) PG8_BAR;
        if constexpr (Epi::GS) E.run(acc, cur, wr, wc, fr, fq, ui); else E(acc, cur, wr, wc, fr, fq);
        if (!has_next) break;
#pragma unroll
        for (int a = 0; a < 2; ++a)
#pragma unroll
            for (int b = 0; b < 2; ++b)
#pragma unroll
                for (int m = 0; m < 4; ++m)
#pragma unroll
                    for (int n = 0; n < 2; ++n) acc[a][b][m][n] = (f32x4){0.f, 0.f, 0.f, 0.f};
        cur = nxt; cA = nA; cB = nB; ++ui;
        if (wr == 1) PG8_BAR;
    }
    PG8_WAIT_V(0);
    PG8_BAR;
#undef PG8_SA
#undef PG8_SB
#undef PG8_STAGE
#undef PG8_LDA
#undef PG8_LDB
#undef PG8_MMA
#undef PG8_WAIT_V
#undef PG8_WAIT_L
#undef PG8_BAR
#undef PG8_SCHED
}
}
using pg8::Unit;

struct EpiInProj {
    static constexpr bool GS = false;
    bf16_t* proj; float* misc; const float* cosA; const float* sinA; const float* cosI; const float* sinI; bf16_t* vt;
    __device__ __forceinline__ void operator()(const f32x4 (&acc)[2][2][4][2], const Unit& u, int wr, int wc, int fr, int fq) const {
        const int pn = u.pn, row0 = u.pm * 256 + wr * 64 + fr;
        const bool is_misc = (pn == 8), is_sig = (pn >= 29);
#pragma unroll
        for (int ai = 0; ai < 2; ++ai)
#pragma unroll
            for (int m = 0; m < 4; ++m) {
                const int r = row0 + ai * 128 + m * 16, pos = r & (SEQ - 1);
#pragma unroll
                for (int bj = 0; bj < 2; ++bj) {
                    int kind = 0;
                    if (pn <= 4) kind = (wc == 0) ? 1 : 0;
                    else if (pn == 6 || pn == 7) kind = (((wc & 1) == 0) && fq < 2) ? 2 : 0;
                    else if (pn == 8) kind = (bj == 0 && wc == 0 && fq < 2) ? 2 : 0;
                    f32x4 c4 = (f32x4){1.f, 1.f, 1.f, 1.f}, s4 = (f32x4){0.f, 0.f, 0.f, 0.f};
                    if (kind == 1) { c4 = *(const f32x4*)(cosA + pos * 16 + 4 * fq); s4 = *(const f32x4*)(sinA + pos * 16 + 4 * fq); }
                    else if (kind == 2) { c4 = *(const f32x4*)(cosI + pos * 8 + 4 * fq); s4 = *(const f32x4*)(sinI + pos * 8 + 4 * fq); }
                    const f32x4 v0 = acc[ai][bj][m][0], v1 = acc[ai][bj][m][1];
                    f32x4 o0 = v0 * c4 - v1 * s4, o1 = v1 * c4 + v0 * s4;
                    if (is_sig) {
#pragma unroll
                        for (int j = 0; j < 4; ++j) { o0[j] = sigmoid_f(o0[j]); o1[j] = sigmoid_f(o1[j]); }
                    }
                    const int cc = bj * 128 + wc * 32 + 8 * fq;
                    u32x4 pk; pk.x = pg8::cvt_pk_bf16(o0[0], o0[1]); pk.y = pg8::cvt_pk_bf16(o0[2], o0[3]); pk.z = pg8::cvt_pk_bf16(o1[0], o1[1]); pk.w = pg8::cvt_pk_bf16(o1[2], o1[3]);
                    if (is_misc) {
                        float* mp = misc + (size_t)r * 256 + cc;
                        *(f32x4*)mp = o0; *(f32x4*)(mp + 4) = o1;
                        if (bj == 0 && wc < 2) *(u32x4*)(proj + (size_t)r * NP + C_MISC + cc) = pk;
                    } else {
                        if (pn == 5) {
                            bf16_t* vp = vt + ((size_t)((r >> 12) * 2 + bj) * 128 + wc * 32 + 8 * fq) * SEQ + pos;
#pragma unroll
                            for (int j = 0; j < 4; ++j) { vp[(size_t)j * SEQ] = f2bf(o0[j]); vp[(size_t)(4 + j) * SEQ] = f2bf(o1[j]); }
                        }
                        *(u32x4*)(proj + (size_t)r * NP + pn * 256 + cc) = pk;
                    }
                }
            }
    }
};
struct EpiGateA {
    static constexpr bool GS = false;
    bf16_t* proj;
    __device__ __forceinline__ void operator()(const f32x4 (&acc)[2][2][4][2], const Unit& u, int wr, int wc, int fr, int fq) const {
        const int row0 = u.pm * 256 + wr * 64 + fr, col0 = u.pn * 256 + wc * 32 + 8 * fq;
#pragma unroll
        for (int ai = 0; ai < 2; ++ai)
#pragma unroll
            for (int m = 0; m < 4; ++m)
#pragma unroll
                for (int bj = 0; bj < 2; ++bj) {
                    bf16_t* pp = proj + (size_t)(row0 + ai * 128 + m * 16) * NP + C_GA + col0 + bj * 128;
                    const u32x4 g = *(const u32x4*)pp; const f32x4 a = acc[ai][bj][m][0], b = acc[ai][bj][m][1];
                    u32x4 w; w.x = pg8::cvt_pk_bf16(lo16(g.x) * a[0], hi16(g.x) * a[1]); w.y = pg8::cvt_pk_bf16(lo16(g.y) * a[2], hi16(g.y) * a[3]);
                    w.z = pg8::cvt_pk_bf16(lo16(g.z) * b[0], hi16(g.z) * b[1]); w.w = pg8::cvt_pk_bf16(lo16(g.w) * b[2], hi16(g.w) * b[3]);
                    *(u32x4*)pp = w;
                }
    }
};
struct EpiGateS {
    static constexpr bool GS = true;
    bf16_t* proj; const float* gtab;
    __device__ __forceinline__ void group_scale(f32x4 (&acc)[2][2][4][2], int u, int g, int wr, int fr) const {
        const float* tp = gtab + (u * 4 + g) * 256 + wr * 64 + fr;
#pragma unroll
        for (int ai = 0; ai < 2; ++ai)
#pragma unroll
            for (int m = 0; m < 4; ++m) {
                const float f = tp[ai * 128 + m * 16];
#pragma unroll
                for (int bj = 0; bj < 2; ++bj) { acc[ai][bj][m][0] *= f; acc[ai][bj][m][1] *= f; }
            }
    }
    __device__ __forceinline__ void run(const f32x4 (&acc)[2][2][4][2], const Unit& u, int wr, int wc, int fr, int fq, int ui) const {
        const int row0 = u.pm * 256 + wr * 64 + fr, col0 = u.pn * 256 + wc * 32 + 8 * fq;
        const float* tp = gtab + (ui * 4 + 3) * 256 + wr * 64 + fr;
#pragma unroll
        for (int ai = 0; ai < 2; ++ai)
#pragma unroll
            for (int m = 0; m < 4; ++m) {
                const float rl = tp[ai * 128 + m * 16];
#pragma unroll
                for (int bj = 0; bj < 2; ++bj) {
                    bf16_t* pa = proj + (size_t)(row0 + ai * 128 + m * 16) * NP + C_GA + col0 + bj * 128;
                    bf16_t* ps = pa + (C_GS - C_GA);
                    const u32x4 m1 = *(const u32x4*)pa; const u32x4 g = *(const u32x4*)ps; const f32x4 a = acc[ai][bj][m][0] * rl, b = acc[ai][bj][m][1] * rl;
                    u32x4 w; w.x = pg8::cvt_pk_bf16(lo16(m1.x) + lo16(g.x) * a[0], hi16(m1.x) + hi16(g.x) * a[1]);
                    w.y = pg8::cvt_pk_bf16(lo16(m1.y) + lo16(g.y) * a[2], hi16(m1.y) + hi16(g.y) * a[3]);
                    w.z = pg8::cvt_pk_bf16(lo16(m1.z) + lo16(g.z) * b[0], hi16(m1.z) + hi16(g.z) * b[1]);
                    w.w = pg8::cvt_pk_bf16(lo16(m1.w) + lo16(g.w) * b[2], hi16(m1.w) + hi16(g.w) * b[3]);
                    *(u32x4*)ps = w;
                }
            }
    }
};
struct EpiResid {
    static constexpr bool GS = false;
    const float* xin; float* xout;
    __device__ __forceinline__ void operator()(const f32x4 (&acc)[2][2][4][2], const Unit& u, int wr, int wc, int fr, int fq) const {
        const int row0 = u.pm * 256 + wr * 64 + fr, col0 = u.pn * 256 + wc * 32 + 8 * fq;
#pragma unroll
        for (int ai = 0; ai < 2; ++ai)
#pragma unroll
            for (int m = 0; m < 4; ++m)
#pragma unroll
                for (int bj = 0; bj < 2; ++bj)
#pragma unroll
                    for (int n = 0; n < 2; ++n) {
                        const size_t off = (size_t)(row0 + ai * 128 + m * 16) * 1024 + col0 + bj * 128 + n * 4;
                        *(f32x4*)(xout + off) = *(const f32x4*)(xin + off) + acc[ai][bj][m][n];
                    }
    }
};
struct EpiBf16 {
    static constexpr bool GS = false;
    bf16_t* O; int ldc;
    __device__ __forceinline__ void operator()(const f32x4 (&acc)[2][2][4][2], const Unit& u, int wr, int wc, int fr, int fq) const {
        const int row0 = u.pm * 256 + wr * 64 + fr, col0 = u.pn * 256 + wc * 32 + 8 * fq;
#pragma unroll
        for (int ai = 0; ai < 2; ++ai)
#pragma unroll
            for (int m = 0; m < 4; ++m)
#pragma unroll
                for (int bj = 0; bj < 2; ++bj) {
                    const f32x4 a = acc[ai][bj][m][0], b = acc[ai][bj][m][1];
                    u32x4 w; w.x = pg8::cvt_pk_bf16(a[0], a[1]); w.y = pg8::cvt_pk_bf16(a[2], a[3]); w.z = pg8::cvt_pk_bf16(b[0], b[1]); w.w = pg8::cvt_pk_bf16(b[2], b[3]);
                    *(u32x4*)(O + (size_t)(row0 + ai * 128 + m * 16) * ldc + col0 + bj * 128) = w;
                }
    }
};

template <int MODE>
__device__ __forceinline__ void convT(int wv, const float* src, int K, int Nsrc, bf16_t* dst, int Ndst, const float* kscale, float* tile) {
    const int tid = opaque_tid(wv), kt = K / 64, ntiles = (Ndst / 64) * kt;
    for (int ti = blockIdx.x; ti < ntiles; ti += gridDim.x) {
        const int n0 = (ti / kt) * 64, k0 = (ti % kt) * 64;
        {
            const int nn = tid & 63; const int nd = n0 + nn; const int n = (nd & ~31) + perm32(nd & 31); const int ns = MODE ? inproj_map(n) : n;
#pragma unroll
            for (int i = 0; i < 8; ++i) {
                const int kk = (tid >> 6) + 8 * i;
                float v = (ns >= 0) ? src[(size_t)(k0 + kk) * Nsrc + ns] : 0.f;
                if (kscale) v *= kscale[k0 + kk];
                tile[nn * 65 + kk] = v;
            }
        }
        __syncthreads();
        {
            const int kk = tid & 63;
#pragma unroll
            for (int i = 0; i < 8; ++i) { const int nn = (tid >> 6) + 8 * i; dst[(size_t)(n0 + nn) * K + k0 + kk] = f2bf(tile[nn * 65 + kk]); }
        }
        __syncthreads();
    }
}

__device__ __forceinline__ void phase_convert(int wv, KParams p, float* tile) {
    for (int l = 0; l < DEPTH; ++l) {
        unsigned char* wl = p->ws + OFF_W + (size_t)l * SZ_WL;
        bf16_t* win = (bf16_t*)wl; bf16_t* wpa = (bf16_t*)(wl + SZ_WIN); bf16_t* wps = (bf16_t*)(wl + SZ_WIN + SZ_WPA);
        bf16_t* wo = (bf16_t*)(wl + SZ_WIN + SZ_WPA + SZ_WPS); bf16_t* wup = (bf16_t*)(wl + SZ_WIN + SZ_WPA + SZ_WPS + SZ_WO); bf16_t* wdn = (bf16_t*)(wl + SZ_WIN + SZ_WPA + SZ_WPS + SZ_WO + SZ_WUP);
        convT<1>(wv, p->w_in + (size_t)l * 1024 * IN_COLS, 1024, IN_COLS, win, NP, nullptr, tile);
        convT<0>(wv, p->w_proj_attn + (size_t)l * 1024 * 1024, 1024, 1024, wpa, 1024, nullptr, tile);
        convT<0>(wv, p->w_proj_ssd + (size_t)l * 2048 * 1024, 2048, 1024, wps, 1024, p->ssd_norm_w + l * 2048, tile);
        convT<0>(wv, p->w_out + (size_t)l * 1024 * 1024, 1024, 1024, wo, 1024, nullptr, tile);
        convT<0>(wv, p->ffn_w_up + (size_t)l * 1024 * FFN2, 1024, FFN2, wup, FFN2, nullptr, tile);
        convT<0>(wv, p->ffn_w_down + (size_t)l * FFN * 1024, FFN, 1024, wdn, 1024, nullptr, tile);
    }
    float* rope = (float*)(p->ws + OFF_ROPE);
    float* cosA = rope; float* sinA = rope + 4096 * 16; float* cosI = rope + 4096 * 32; float* sinI = rope + 4096 * 40;
    for (int i = blockIdx.x * 512 + opaque_tid(wv); i < 4096 * 24; i += gridDim.x * 512) {
        int pos, f; float inv;
        if (i < 4096 * 16) { pos = i >> 4; f = i & 15; inv = p->invA[f]; } else { const int j = i - 4096 * 16; pos = j >> 3; f = j & 7; inv = p->invI[f]; }
        const float ang = (float)pos * inv;
        double rev = (double)ang * 0.15915494309189535; rev -= rint(rev);
        const float c = __builtin_amdgcn_cosf((float)rev), s = __builtin_amdgcn_sinf((float)rev);
        if (i < 4096 * 16) { cosA[pos * 16 + f] = c; sinA[pos * 16 + f] = s; } else { cosI[pos * 8 + f] = c; sinI[pos * 8 + f] = s; }
    }
}

template <bool F32OUT>
__device__ __forceinline__ void phase_norm(int wv, const float* xin, const float* w, bf16_t* hout, float* fout, int nrows) {
    const int tid = opaque_tid(wv); const int wave = tid >> 6, lane = tid & 63;
    const int stride = gridDim.x * 8;
    for (int row0 = blockIdx.x * 8 + wave; row0 < nrows; row0 += stride * 4) {
        f32x4 v[4][4];
#pragma unroll
        for (int u = 0; u < 4; ++u) {
            const int row = row0 + u * stride;
            if (row < nrows) {
                const f32x4* xr = (const f32x4*)(xin + (size_t)row * 1024);
#pragma unroll
                for (int i = 0; i < 4; ++i) v[u][i] = xr[lane + 64 * i];
            }
        }
        f32x4 w4[4];
#pragma unroll
        for (int i = 0; i < 4; ++i) w4[i] = ((const f32x4*)w)[lane + 64 * i];
#pragma unroll
        for (int u = 0; u < 4; ++u) {
            const int row = row0 + u * stride;
            if (row < nrows) {
                float ss = 0.f;
#pragma unroll
                for (int i = 0; i < 4; ++i) ss += v[u][i][0] * v[u][i][0] + v[u][i][1] * v[u][i][1] + v[u][i][2] * v[u][i][2] + v[u][i][3] * v[u][i][3];
                ss = wave_sum(ss);
                const float rstd = rsqrtf(ss * (1.0f / 1024.0f) + EPS);
#pragma unroll
                for (int i = 0; i < 4; ++i) {
                    const f32x4 o = v[u][i] * rstd * w4[i];
                    if (F32OUT) ((f32x4*)(fout + (size_t)row * 1024))[lane + 64 * i] = o;
                    else { u32x2 pk; pk.x = pack2(o[0], o[1]); pk.y = pack2(o[2], o[3]); *(u32x2*)(hout + (size_t)row * 1024 + 4 * (lane + 64 * i)) = pk; }
                }
            }
        }
    }
}

__device__ __forceinline__ unsigned fkey(float s) { s += 0.0f; const unsigned u = __float_as_uint(s); return (u & 0x80000000u) ? ~u : (u | 0x80000000u); }

__device__ __forceinline__ void phase_idx_simple(int wv, const bf16_t* proj, const float* misc, unsigned* mask, int* sel, unsigned char* shm) {
    const int tid = opaque_tid(wv); const int wave = tid >> 6, lane = tid & 63;
    float* qs = (float*)(shm + wave * 18432); unsigned* sk = (unsigned*)(shm + wave * 18432 + 2048);
    const unsigned long long lt_mask = (1ull << lane) - 1ull;
    for (int q = blockIdx.x * 8 + wave; q < SLAB; q += gridDim.x * 8) {
        const int bl = q >> 12, t = q & (SEQ - 1), n = t + 1;
        wave_lds_sync();
        {
            const u32x4 raw = *(const u32x4*)(proj + (size_t)q * NP + C_QI + lane * 8);
            f32x4 a, b; a[0] = lo16(raw.x); a[1] = hi16(raw.x); a[2] = lo16(raw.y); a[3] = hi16(raw.y); b[0] = lo16(raw.z); b[1] = hi16(raw.z); b[2] = lo16(raw.w); b[3] = hi16(raw.w);
            *(f32x4*)(qs + lane * 8) = a; *(f32x4*)(qs + lane * 8 + 4) = b;
        }
        float wv[8];
        { const f32x4 w0 = *(const f32x4*)(misc + (size_t)q * 256 + 64), w1 = *(const f32x4*)(misc + (size_t)q * 256 + 68);
#pragma unroll
          for (int j = 0; j < 4; ++j) { wv[j] = w0[j]; wv[4 + j] = w1[j]; } }
        wave_lds_sync();
        const int nr = (n + 63) & ~63;
        for (int s = lane; s < nr; s += 64) {
            if (s < n) {
                const f32x4* kp = (const f32x4*)(misc + (size_t)(bl * SEQ + s) * 256);
                f32x4 kv[16];
#pragma unroll
                for (int i = 0; i < 16; ++i) kv[i] = kp[i];
                float sc = 0.f;
#pragma unroll
                for (int h = 0; h < 8; ++h) {
                    float d = 0.f;
#pragma unroll
                    for (int i = 0; i < 16; ++i) { const f32x4 qv = *(const f32x4*)(qs + h * 64 + i * 4); d += kv[i][0] * qv[0] + kv[i][1] * qv[1] + kv[i][2] * qv[2] + kv[i][3] * qv[3]; }
                    sc += wv[h] * fmaxf(d, 0.f);
                }
                sk[s] = fkey(sc);
            }
        }
        wave_lds_sync();
        unsigned cur = 0u; int need = 1 << 30;
        if (n > 256) {
            for (int bit = 31; bit >= 0; --bit) {
                const unsigned cand = cur | (1u << bit); int cnt = 0;
                for (int s = lane; s < nr; s += 64) { const bool pr = (s < n) && (sk[s] >= cand); cnt += __popcll(__ballot(pr)); }
                if (cnt >= 256) cur = cand;
            }
            int cgt = 0;
            for (int s = lane; s < nr; s += 64) { const bool pr = (s < n) && (sk[s] > cur); cgt += __popcll(__ballot(pr)); }
            need = 256 - cgt;
        }
        int run_eq = 0, run_sel = 0; unsigned long long mybal = 0ull;
        for (int s = lane, c = 0; s < nr; s += 64, ++c) {
            const bool in = s < n; const unsigned k = in ? sk[s] : 0u;
            const bool gt = in && (k > cur), eq = in && (k == cur);
            const unsigned long long beq = __ballot(eq);
            const int rank = run_eq + __popcll(beq & lt_mask);
            const bool se = gt || (eq && rank < need);
            const unsigned long long bs = __ballot(se);
            const int pos = run_sel + __popcll(bs & lt_mask);
            if (se && pos < 256) sel[(size_t)q * 256 + pos] = s;
            run_eq += __popcll(beq); run_sel += __popcll(bs);
            if (lane == c) mybal = bs;
        }
        u32x2 mw; mw.x = (unsigned)mybal; mw.y = (unsigned)(mybal >> 32);
        *(u32x2*)(mask + (size_t)q * 128 + lane * 2) = mw;
        for (int j = run_sel + lane; j < 256; j += 64) sel[(size_t)q * 256 + j] = -1;
    }
}

__device__ __forceinline__ void phase_att_simple(int wv, bf16_t* proj, const int* sel, unsigned char* shm) {
    const int tid = opaque_tid(wv); const int wave = tid >> 6, lane = tid & 63, h = wave, kvh = h >> 2;
    float* qf = (float*)(shm + wave * 2560); float* pj = qf + 128; int* kj = (int*)(pj + 256);
    const float scale = 0.08838834764831845f;
    for (int q = blockIdx.x; q < SLAB; q += gridDim.x) {
        const int bl = q >> 12;
        wave_lds_sync();
        { const unsigned raw = *(const unsigned*)(proj + (size_t)q * NP + C_Q + h * 128 + 2 * lane); qf[2 * lane] = lo16(raw); qf[2 * lane + 1] = hi16(raw); }
        int keys[4];
#pragma unroll
        for (int i = 0; i < 4; ++i) { keys[i] = sel[(size_t)q * 256 + lane + 64 * i]; kj[lane + 64 * i] = keys[i]; }
        wave_lds_sync();
        float lg[4]; float mx = -INFINITY;
#pragma unroll
        for (int i = 0; i < 4; ++i) {
            lg[i] = -INFINITY;
            if (keys[i] >= 0) {
                const u32x4* kp = (const u32x4*)(proj + (size_t)(bl * SEQ + keys[i]) * NP + C_K + kvh * 128);
                float d = 0.f;
#pragma unroll
                for (int c = 0; c < 16; ++c) {
                    const u32x4 raw = kp[c]; const f32x4 q0 = *(const f32x4*)(qf + c * 8), q1 = *(const f32x4*)(qf + c * 8 + 4);
                    d += lo16(raw.x) * q0[0] + hi16(raw.x) * q0[1] + lo16(raw.y) * q0[2] + hi16(raw.y) * q0[3] + lo16(raw.z) * q1[0] + hi16(raw.z) * q1[1] + lo16(raw.w) * q1[2] + hi16(raw.w) * q1[3];
                }
                lg[i] = d * scale;
            }
            mx = fmaxf(mx, lg[i]);
        }
        mx = wave_max(mx);
        float sm = 0.f; float pe[4];
#pragma unroll
        for (int i = 0; i < 4; ++i) { pe[i] = (keys[i] >= 0) ? __expf(lg[i] - mx) : 0.f; sm += pe[i]; }
        sm = wave_sum(sm);
        const float inv = 1.0f / sm;
#pragma unroll
        for (int i = 0; i < 4; ++i) pj[lane + 64 * i] = pe[i] * inv;
        wave_lds_sync();
        float a0 = 0.f, a1 = 0.f;
        const bf16_t* vb = proj + (size_t)(bl * SEQ) * NP + C_V + kvh * 128 + 2 * lane;
        for (int j0 = 0; j0 < 256; j0 += 16) {
            if (kj[j0] < 0) break;
            unsigned raw[16]; float pv[16];
#pragma unroll
            for (int u = 0; u < 16; ++u) { const int key = max(kj[j0 + u], 0); pv[u] = pj[j0 + u]; raw[u] = *(const unsigned*)(vb + (size_t)key * NP); }
#pragma unroll
            for (int u = 0; u < 16; ++u) { a0 += pv[u] * lo16(raw[u]); a1 += pv[u] * hi16(raw[u]); }
        }
        *(unsigned*)(proj + (size_t)q * NP + C_Q + h * 128 + 2 * lane) = pack2(a0, a1);
    }
}


typedef short bf16x4 __attribute__((ext_vector_type(4)));
__device__ __forceinline__ void phase_idx(int wv, const bf16_t* proj, const float* misc, unsigned* mask, unsigned char* shm) {
    const int tid = opaque_tid(wv), wave = __builtin_amdgcn_readfirstlane(tid >> 6), lane = tid & 63, fr = lane & 15, fq = lane >> 4;
    int* cntbuf = (int*)shm;
    int* cbuf2 = cntbuf + 256;
    volatile int* tieflag = (volatile int*)(shm + 149760);
    for (int it = blockIdx.x; it < 256; it += gridDim.x) {
        for (int pass = 0; pass < 4; ++pass) {
            const int i = (pass == 0) ? it : (pass == 1) ? 511 - it : (pass == 2) ? 512 + it : 1023 - it;
            const int qt = 255 - (i >> 2), bl = i & 3;
            const int q0 = qt * 16, nch = (q0 + 15) / 64 + 1, t = q0 + fr;
            const size_t qrow = (size_t)bl * SEQ + q0 + fr;
            int lb = wave * 64 + fq * 4; asm volatile("" : "+v"(lb));
            u32x4 key[4][4];
            u32x4* klds = (u32x4*)(shm + 18688) + tid;
#define KGET(dst, ip, tt) do { if ((ip) < 4) dst = key[(ip) < 4 ? (ip) : 0][tt]; else dst = klds[(((ip) - 4) * 4 + (tt)) * 512]; } while (0)
            {
                float wv[8];
                { const f32x4 w0 = *(const f32x4*)(misc + qrow * 256 + 64), w1 = *(const f32x4*)(misc + qrow * 256 + 68);
#pragma unroll
                  for (int j = 0; j < 4; ++j) { wv[j] = w0[j]; wv[4 + j] = w1[j]; } }
#pragma unroll
                for (int u = 0; u < 2; ++u) { const int ch = tid + 512 * u, r = ch >> 6, cc = ch & 63;
                    *(u32x4*)(shm + 2048 + r * 1040 + cc * 16) = *(const u32x4*)(proj + ((size_t)bl * SEQ + q0 + r) * NP + C_QI + cc * 8); }
                if (tid == 0) tieflag[0] = 0;
                __syncthreads();
                const unsigned char* ql = shm + 2048 + fr * 1040 + fq * 16;
#pragma unroll
                for (int ip = 0; ip < 8; ++ip) {
                    int c = wave + 8 * ip; asm volatile("" : "+s"(c));
                    if (c < nch) {
                        const int trel = t - (c - wave) * 64 - lb;
                        const bf16_t* kp0 = proj + ((size_t)bl * SEQ + c * 64 + fr) * NP + C_MISC + fq * 8;
#pragma unroll
                        for (int tp = 0; tp < 2; ++tp) {
                            bf16x8 kf[2][2];
#pragma unroll
                            for (int u = 0; u < 2; ++u) { const bf16_t* kp = kp0 + (size_t)((tp * 2 + u) * 16) * NP; kf[u][0] = *(const bf16x8*)kp; kf[u][1] = *(const bf16x8*)(kp + 32); }
                            f32x4 sc[2];
                            sc[0] = (f32x4){0.f, 0.f, 0.f, 0.f}; sc[1] = (f32x4){0.f, 0.f, 0.f, 0.f};
#pragma unroll
                            for (int h = 0; h < 8; ++h) {
                                const bf16x8 q0f = *(const bf16x8*)(ql + h * 128), q1f = *(const bf16x8*)(ql + h * 128 + 64);
#pragma unroll
                                for (int u = 0; u < 2; ++u) {
                                    f32x4 d = __builtin_amdgcn_mfma_f32_16x16x32_bf16(kf[u][0], q0f, (f32x4){0.f, 0.f, 0.f, 0.f}, 0, 0, 0);
                                    d = __builtin_amdgcn_mfma_f32_16x16x32_bf16(kf[u][1], q1f, d, 0, 0, 0);
#pragma unroll
                                    for (int j = 0; j < 4; ++j) sc[u][j] += wv[h] * fmaxf(d[j], 0.f);
                                }
                                if ((h & 3) == 3) asm volatile("" ::: "memory");
                            }
#pragma unroll
                            for (int u = 0; u < 2; ++u) {
                                u32x4 kk;
#pragma unroll
                                for (int j = 0; j < 4; ++j) kk[j] = ((tp * 2 + u) * 16 + j <= trel) ? fkey(sc[u][j]) : 0u;
                                if (ip < 4) key[ip < 4 ? ip : 0][tp * 2 + u] = kk; else klds[((ip - 4) * 4 + tp * 2 + u) * 512] = kk;
                            }
                        }
                    } else if (ip < 4) {
#pragma unroll
                        for (int tt = 0; tt < 4; ++tt) key[ip < 4 ? ip : 0][tt] = (u32x4){0u, 0u, 0u, 0u};
                    }
                    asm volatile("" ::: "memory");
                }
            }
            __syncthreads();
            unsigned cur = 0u;
            bool rdone = (t + 1 <= 256);
            for (int bit = 31; bit >= 0; --bit) {
                if (__ballot(rdone) == ~0ull) break;
                const unsigned cand = cur | (1u << bit);
                int cnt = 0;
#pragma unroll
                for (int hp2 = 0; hp2 < 2; ++hp2) {
                    if (wave + 8 * (4 + 2 * hp2) < nch) {
                        u32x4 kl[8];
#pragma unroll
                        for (int q = 0; q < 8; ++q) kl[q] = klds[(hp2 * 8 + q) * 512];
                        const bool second = (wave + 8 * (5 + 2 * hp2) < nch);
#pragma unroll
                        for (int q = 0; q < 4; ++q)
#pragma unroll
                            for (int j = 0; j < 4; ++j) cnt += (kl[q][j] >= cand) ? 1 : 0;
                        if (second) {
#pragma unroll
                            for (int q = 4; q < 8; ++q)
#pragma unroll
                                for (int j = 0; j < 4; ++j) cnt += (kl[q][j] >= cand) ? 1 : 0;
                        }
                    }
                }
#pragma unroll
                for (int ip = 0; ip < 4; ++ip)
                    if (wave + 8 * ip < nch) {
#pragma unroll
                        for (int tt = 0; tt < 4; ++tt)
#pragma unroll
                            for (int j = 0; j < 4; ++j) cnt += (key[ip][tt][j] >= cand) ? 1 : 0;
                    }
                cnt += __shfl_xor(cnt, 16); cnt += __shfl_xor(cnt, 32);
                int* cb = cntbuf + (bit & 1) * 128;
                if (fq == 0) cb[fr * 8 + wave] = cnt;
                __syncthreads();
                const int4 a = *(const int4*)(cb + fr * 8), b = *(const int4*)(cb + fr * 8 + 4);
                const int tot = a.x + a.y + a.z + a.w + b.x + b.y + b.z + b.w;
                if (!rdone && tot >= 256) { cur = cand; if (tot == 256) rdone = true; }
            }
            int cg = 0, ce = 0;
#pragma unroll
            for (int ip = 0; ip < 8; ++ip)
                if (wave + 8 * ip < nch) {
#pragma unroll
                    for (int tt = 0; tt < 4; ++tt) { u32x4 kv; KGET(kv, ip, tt);
#pragma unroll
                        for (int j = 0; j < 4; ++j) { cg += (kv[j] > cur) ? 1 : 0; ce += (kv[j] == cur) ? 1 : 0; } }
                }
            cg += __shfl_xor(cg, 16); cg += __shfl_xor(cg, 32); ce += __shfl_xor(ce, 16); ce += __shfl_xor(ce, 32);
            if (fq == 0) { cbuf2[fr * 8 + wave] = cg; cbuf2[128 + fr * 8 + wave] = ce; }
            __syncthreads();
            int need, ceq;
            { const int4 a = *(const int4*)(cbuf2 + fr * 8), b = *(const int4*)(cbuf2 + fr * 8 + 4);
              need = 256 - (a.x + a.y + a.z + a.w + b.x + b.y + b.z + b.w);
              const int4 c4 = *(const int4*)(cbuf2 + 128 + fr * 8), d4 = *(const int4*)(cbuf2 + 128 + fr * 8 + 4);
              ceq = c4.x + c4.y + c4.z + c4.w + d4.x + d4.y + d4.z + d4.w; }
            const bool ties = (cur != 0u) && (ceq > need);
            unsigned J = 4095u;
            if (ties) tieflag[0] = 1;
            __syncthreads();
            if (tieflag[0] != 0) {
                unsigned Jt = 0u;
                for (int bit = 11; bit >= 0; --bit) {
                    const unsigned cand = Jt | (1u << bit);
                    const int crel = (int)cand - lb;
                    int cnt = 0;
#pragma unroll
                    for (int ip = 0; ip < 8; ++ip)
                        if (wave + 8 * ip < nch) {
#pragma unroll
                            for (int tt = 0; tt < 4; ++tt) { u32x4 kv; KGET(kv, ip, tt);
#pragma unroll
                                for (int j = 0; j < 4; ++j) cnt += (kv[j] == cur && (ip * 512 + tt * 16 + j) < crel) ? 1 : 0; }
                        }
                    cnt += __shfl_xor(cnt, 16); cnt += __shfl_xor(cnt, 32);
                    int* cb = cntbuf + (bit & 1) * 128;
                    if (fq == 0) cb[fr * 8 + wave] = cnt;
                    __syncthreads();
                    const int4 a = *(const int4*)(cb + fr * 8), b = *(const int4*)(cb + fr * 8 + 4);
                    const int tot = a.x + a.y + a.z + a.w + b.x + b.y + b.z + b.w;
                    if (tot < need) Jt = cand;
                }
                if (ties) J = Jt;
            }
#pragma unroll
            for (int ip = 0; ip < 8; ++ip) {
                const int c = wave + 8 * ip;
                if (c < nch) {
                    unsigned lo = 0u, hi = 0u;
                    const int jrel = (int)J - lb;
#pragma unroll
                    for (int tt = 0; tt < 4; ++tt) { u32x4 kv; KGET(kv, ip, tt);
#pragma unroll
                        for (int j = 0; j < 4; ++j) {
                            const unsigned k = kv[j];
                            const bool se = (k > cur) || (k == cur && cur != 0u && (ip * 512 + tt * 16 + j) <= jrel);
                            const unsigned b = se ? 1u : 0u;
                            if (tt < 2) lo |= b << (tt * 16 + j); else hi |= b << ((tt - 2) * 16 + j);
                        } }
                    lo <<= (lb & 15); hi <<= (lb & 15);
                    lo |= __shfl_xor(lo, 16); lo |= __shfl_xor(lo, 32); hi |= __shfl_xor(hi, 16); hi |= __shfl_xor(hi, 32);
                    if (fq == 0) { u32x2 mw; mw.x = lo; mw.y = hi; *(u32x2*)(mask + qrow * 128 + c * 2) = mw; }
                }
            }
            __syncthreads();
        }
    }
#undef KGET
}

__device__ __forceinline__ void phase_att(int wv, bf16_t* proj, const bf16_t* vt, const unsigned* mask, unsigned char* shm) {
    const int tid = opaque_tid(wv), wave = tid >> 6, lane = tid & 63, fr = lane & 15, fq = lane >> 4;
    const int qs = wave & 3, hp = wave >> 2;
    constexpr int KROW = 272, VROW = 272, KBYTES = 128 * KROW, VBYTES = 128 * VROW, BUF = KBYTES + VBYTES;
    const float sc2 = 0.08838834764831845f * 1.4426950408889634f;
    for (int it = blockIdx.x; it < 256; it += gridDim.x) {
        for (int pass = 0; pass < 2; ++pass) {
            const int i = (pass == 0) ? it : 511 - it;
            const int qb = 63 - (i >> 3), sub = i & 7, bl = sub >> 1, kvh = sub & 1, nkt = qb + 1;
            const size_t qrow = (size_t)bl * SEQ + qb * 64 + qs * 16 + fr;
            bf16x8 qf[2][4];
#pragma unroll
            for (int hh = 0; hh < 2; ++hh)
#pragma unroll
                for (int ks = 0; ks < 4; ++ks) qf[hh][ks] = *(const bf16x8*)(proj + qrow * NP + C_Q + (kvh * 4 + hp * 2 + hh) * 128 + ks * 32 + fq * 8);
            f32x4 o[2][8];
#pragma unroll
            for (int hh = 0; hh < 2; ++hh)
#pragma unroll
                for (int dt = 0; dt < 8; ++dt) o[hh][dt] = (f32x4){0.f, 0.f, 0.f, 0.f};
            float mrow[2] = {-1e30f, -1e30f}, lrow[2] = {0.f, 0.f};
            const int sr0 = tid >> 4, sc = tid & 15;
            const bf16_t* kg = proj + ((size_t)bl * SEQ + sr0) * NP + C_K + kvh * 128 + sc * 8;
            const bf16_t* vg = vt + ((size_t)(bl * 2 + kvh) * 128 + sr0) * SEQ + sc * 8;
            const int klds = sr0 * KROW + sc * 16, vlds = KBYTES + sr0 * VROW + sc * 16;
            const int nst = (nkt + 1) >> 1;
            u32x4 kreg[4], vreg[4];
            __syncthreads();
#pragma unroll
            for (int u = 0; u < 4; ++u) { kreg[u] = *(const u32x4*)(kg + (size_t)(32 * u) * NP); vreg[u] = *(const u32x4*)(vg + (size_t)(32 * u) * SEQ); }
#pragma unroll
            for (int u = 0; u < 4; ++u) { *(u32x4*)(shm + klds + 32 * u * KROW) = kreg[u]; *(u32x4*)(shm + vlds + 32 * u * VROW) = vreg[u]; }
            __syncthreads();
            u32x4 mknext = *(const u32x4*)(mask + qrow * 128);
            for (int st = 0; st < nst; ++st) {
                const unsigned char* sbuf = shm + (st & 1) * BUF;
                const bool more = (st + 1 < nst);
                if (more) {
                    const bf16_t* kg2 = kg + (size_t)(st + 1) * 128 * NP; const bf16_t* vg2 = vg + (st + 1) * 128;
#pragma unroll
                    for (int u = 0; u < 4; ++u) { kreg[u] = *(const u32x4*)(kg2 + (size_t)(32 * u) * NP); vreg[u] = *(const u32x4*)(vg2 + (size_t)(32 * u) * SEQ); }
                }
                const u32x4 mk4 = mknext;
                if (more) mknext = *(const u32x4*)(mask + qrow * 128 + (st + 1) * 4);
#pragma unroll
                for (int h2 = 0; h2 < 2; ++h2) {
                if (2 * st + h2 >= nkt) break;
                const unsigned char* buf = sbuf + h2 * 64 * KROW;
                const unsigned char* vbuf = sbuf + KBYTES + h2 * 128;
                const unsigned mlo = (h2 ? mk4.z : mk4.x) >> (fq * 4), mhi = (h2 ? mk4.w : mk4.y) >> (fq * 4);
                f32x4 s[2][4];
#pragma unroll
                for (int nt = 0; nt < 4; ++nt) {
                    s[0][nt] = (f32x4){0.f, 0.f, 0.f, 0.f}; s[1][nt] = (f32x4){0.f, 0.f, 0.f, 0.f};
#pragma unroll
                    for (int ks = 0; ks < 4; ++ks) {
                        const bf16x8 kf = *(const bf16x8*)(buf + (nt * 16 + fr) * KROW + (ks * 32 + fq * 8) * 2);
                        s[0][nt] = __builtin_amdgcn_mfma_f32_16x16x32_bf16(kf, qf[0][ks], s[0][nt], 0, 0, 0);
                        s[1][nt] = __builtin_amdgcn_mfma_f32_16x16x32_bf16(kf, qf[1][ks], s[1][nt], 0, 0, 0);
                    }
                }
                bf16x8 pf[2][2];
                f32x4 bias[4];
#pragma unroll
                for (int nt = 0; nt < 4; ++nt)
#pragma unroll
                    for (int j = 0; j < 4; ++j) { const unsigned w = (nt < 2) ? mlo : mhi; bias[nt][j] = ((w >> ((nt & 1) * 16 + j)) & 1u) ? 0.f : -INFINITY; }
#pragma unroll
                for (int hh = 0; hh < 2; ++hh) {
                    float mx = -INFINITY;
#pragma unroll
                    for (int nt = 0; nt < 4; ++nt)
#pragma unroll
                        for (int j = 0; j < 4; ++j) { const float tv = __builtin_fmaf(s[hh][nt][j], sc2, bias[nt][j]); s[hh][nt][j] = tv; mx = fmaxf(mx, tv); }
                    mx = fmaxf(mx, __shfl_xor(mx, 16)); mx = fmaxf(mx, __shfl_xor(mx, 32));
                    const float mnew = fmaxf(mrow[hh], mx);
                    const float alpha = __builtin_amdgcn_exp2f(mrow[hh] - mnew);
                    mrow[hh] = mnew;
                    float ls = 0.f;
#pragma unroll
                    for (int nt = 0; nt < 4; ++nt)
#pragma unroll
                        for (int j = 0; j < 4; ++j) { const float pv = __builtin_amdgcn_exp2f(s[hh][nt][j] - mnew); s[hh][nt][j] = pv; ls += pv; }
                    lrow[hh] = lrow[hh] * alpha + ls;
                    if (__ballot(alpha != 1.0f) != 0ull) {
#pragma unroll
                        for (int dt = 0; dt < 8; ++dt) o[hh][dt] *= alpha;
                    }
#pragma unroll
                    for (int kk = 0; kk < 2; ++kk) {
                        u32x4 pk;
                        pk.x = pg8::cvt_pk_bf16(s[hh][2 * kk][0], s[hh][2 * kk][1]); pk.y = pg8::cvt_pk_bf16(s[hh][2 * kk][2], s[hh][2 * kk][3]);
                        pk.z = pg8::cvt_pk_bf16(s[hh][2 * kk + 1][0], s[hh][2 * kk + 1][1]); pk.w = pg8::cvt_pk_bf16(s[hh][2 * kk + 1][2], s[hh][2 * kk + 1][3]);
                        pf[hh][kk] = __builtin_bit_cast(bf16x8, pk);
                    }
                }
#pragma unroll
                for (int kk = 0; kk < 2; ++kk)
#pragma unroll
                    for (int dt = 0; dt < 8; ++dt) {
                        const unsigned char* vp = vbuf + (dt * 16 + fr) * VROW + (kk * 32 + fq * 4) * 2;
                        const bf16x4 v0 = *(const bf16x4*)vp, v1 = *(const bf16x4*)(vp + 32);
                        const bf16x8 vf = __builtin_shufflevector(v0, v1, 0, 1, 2, 3, 4, 5, 6, 7);
                        o[0][dt] = __builtin_amdgcn_mfma_f32_16x16x32_bf16(vf, pf[0][kk], o[0][dt], 0, 0, 0);
                        o[1][dt] = __builtin_amdgcn_mfma_f32_16x16x32_bf16(vf, pf[1][kk], o[1][dt], 0, 0, 0);
                    }
                }
                if (more) {
                    unsigned char* nb = shm + ((st + 1) & 1) * BUF;
#pragma unroll
                    for (int u = 0; u < 4; ++u) { *(u32x4*)(nb + klds + 32 * u * KROW) = kreg[u]; *(u32x4*)(nb + vlds + 32 * u * VROW) = vreg[u]; }
                }
                __syncthreads();
            }
#pragma unroll
            for (int hh = 0; hh < 2; ++hh) {
                float lt = lrow[hh]; lt += __shfl_xor(lt, 16); lt += __shfl_xor(lt, 32);
                const float inv = 1.0f / lt;
                bf16_t* op = proj + qrow * NP + C_Q + (kvh * 4 + hp * 2 + hh) * 128 + fq * 4;
#pragma unroll
                for (int dt = 0; dt < 8; ++dt) {
                    u32x2 w; w.x = pg8::cvt_pk_bf16(o[hh][dt][0] * inv, o[hh][dt][1] * inv); w.y = pg8::cvt_pk_bf16(o[hh][dt][2] * inv, o[hh][dt][3] * inv);
                    *(u32x2*)(op + dt * 16) = w;
                }
            }
        }
    }
}

__device__ __forceinline__ void phase_ssd_simple(int wv, KParams p, int l, bf16_t* proj, const float* misc, float* ssq, unsigned char* shm) {
    const int tid = opaque_tid(wv), lane = tid & 63;
    float* xs = (float*)shm; float* Bs = xs + 64 * 64; float* Cs = Bs + 64 * 128; float* dts = Cs + 64 * 128; float* decs = dts + 64; float* ybuf = decs + 64;
    const float* cw = p->ssd_conv_w + (size_t)l * 4 * 3072; const float* cb = p->ssd_conv_b + (size_t)l * 3072;
    for (int item = blockIdx.x; item < 128; item += gridDim.x) {
        const int bl = item >> 5, head = item & 31, g = head >> 3;
        const float Aneg = -__expf(p->ssd_a_log[l * 32 + head]), dtb = p->ssd_dt_bias[l * 32 + head], Dsk = p->ssd_d[l * 32 + head];
        const int pp = tid >> 3, ng = tid & 7;
        float hs[16];
#pragma unroll
        for (int k = 0; k < 16; ++k) hs[k] = 0.f;
        for (int c = 0; c < 64; ++c) {
            const int t0 = c * 64;
            __syncthreads();
            for (int i = 0; i < 40; ++i) {
                const int idx = tid + 512 * i, tok = idx / 320, cc = idx - tok * 320;
                int ch; float* dstp;
                if (cc < 64) { ch = head * 64 + cc; dstp = xs + tok * 64 + cc; }
                else if (cc < 192) { ch = 2048 + g * 128 + (cc - 64); dstp = Bs + tok * 128 + (cc - 64); }
                else { ch = 2560 + g * 128 + (cc - 192); dstp = Cs + tok * 128 + (cc - 192); }
                float a = cb[ch];
#pragma unroll
                for (int j = 0; j < 4; ++j) { const int tt = t0 + tok - 3 + j; if (tt >= 0) a += cw[j * 3072 + ch] * bf2f(proj[(size_t)(bl * SEQ + tt) * NP + C_XBC + ch]); }
                *dstp = silu_f(a);
            }
            if (tid < 64) {
                const float v = misc[(size_t)(bl * SEQ + t0 + tid) * 256 + 72 + head] + dtb;
                const float dt = (v > 20.f) ? v : log1pf(__expf(v));
                dts[tid] = dt; decs[tid] = __expf(dt * Aneg);
            }
            __syncthreads();
            for (int tok = 0; tok < 64; ++tok) {
                const float xv = xs[tok * 64 + pp], dt = dts[tok], dec = decs[tok], xdt = xv * dt;
                float y = 0.f;
#pragma unroll
                for (int k4 = 0; k4 < 4; ++k4) {
                    const f32x4 b4 = *(const f32x4*)(Bs + tok * 128 + ng * 16 + k4 * 4), c4 = *(const f32x4*)(Cs + tok * 128 + ng * 16 + k4 * 4);
#pragma unroll
                    for (int j = 0; j < 4; ++j) { float& hh = hs[k4 * 4 + j]; hh = hh * dec + xdt * b4[j]; y += c4[j] * hh; }
                }
                y += __shfl_xor(y, 1); y += __shfl_xor(y, 2); y += __shfl_xor(y, 4);
                if (ng == 0) ybuf[tok * 65 + pp] = y + Dsk * xv;
            }
            __syncthreads();
#pragma unroll
            for (int i = 0; i < 8; ++i) {
                const int idx = tid + 512 * i, tok = idx >> 6, p2 = idx & 63;
                bf16_t* zp = proj + (size_t)(bl * SEQ + t0 + tok) * NP + C_Z + head * 64 + p2;
                const float yg = ybuf[tok * 65 + p2] * silu_f(bf2f(*zp));
                *zp = f2bf(yg);
                const float s2 = wave_sum(yg * yg);
                if (lane == 0) ssq[(size_t)(bl * SEQ + t0 + tok) * 32 + head] = s2;
            }
        }
    }
}


__device__ __forceinline__ void phase_bcconv(int wv, KParams p, int l, const bf16_t* proj, bf16_t* bc, bf16_t* btg) {
    const int tid = opaque_tid(wv);
    const float* cw = p->ssd_conv_w + (size_t)l * 4 * 3072 + 2048; const float* cb = p->ssd_conv_b + (size_t)l * 3072 + 2048;
    for (int idx = blockIdx.x * 512 + tid; idx < 128 * (SLAB / 16); idx += gridDim.x * 512) {
        const int run = idx >> 7, c = (idx & 127) * 8, t0 = run * 16;
        float wt[4][8], bias[8];
#pragma unroll
        for (int e = 0; e < 8; ++e) { bias[e] = cb[c + e];
#pragma unroll
            for (int j = 0; j < 4; ++j) wt[j][e] = cw[j * 3072 + c + e]; }
        const bf16_t* xb = proj + (size_t)t0 * NP + C_XBC + 2048 + c;
        u32x4 r0 = (u32x4){0u, 0u, 0u, 0u}, r1 = r0, r2 = r0;
        if ((t0 & (SEQ - 1)) != 0) { r0 = *(const u32x4*)(xb - 3 * (ptrdiff_t)NP); r1 = *(const u32x4*)(xb - 2 * (ptrdiff_t)NP); r2 = *(const u32x4*)(xb - (ptrdiff_t)NP); }
        unsigned W[16][4];
#pragma unroll
        for (int tb = 0; tb < 16; tb += 4) {
            u32x4 rn[4];
#pragma unroll
            for (int u = 0; u < 4; ++u) rn[u] = *(const u32x4*)(xb + (size_t)(tb + u) * NP);
#pragma unroll
            for (int u = 0; u < 4; ++u) {
                const unsigned a0[4] = {r0.x, r0.y, r0.z, r0.w}, a1[4] = {r1.x, r1.y, r1.z, r1.w}, a2[4] = {r2.x, r2.y, r2.z, r2.w}, a3[4] = {rn[u].x, rn[u].y, rn[u].z, rn[u].w};
#pragma unroll
                for (int e = 0; e < 4; ++e) {
                    const float lo = bias[2 * e] + wt[0][2 * e] * lo16(a0[e]) + wt[1][2 * e] * lo16(a1[e]) + wt[2][2 * e] * lo16(a2[e]) + wt[3][2 * e] * lo16(a3[e]);
                    const float hi = bias[2 * e + 1] + wt[0][2 * e + 1] * hi16(a0[e]) + wt[1][2 * e + 1] * hi16(a1[e]) + wt[2][2 * e + 1] * hi16(a2[e]) + wt[3][2 * e + 1] * hi16(a3[e]);
                    W[tb + u][e] = pack2(silu_f(lo), silu_f(hi));
                }
                u32x4 o; o.x = W[tb + u][0]; o.y = W[tb + u][1]; o.z = W[tb + u][2]; o.w = W[tb + u][3];
                *(u32x4*)(bc + (size_t)(t0 + tb + u) * 1024 + c) = o;
                r0 = r1; r1 = r2; r2 = rn[u];
            }
        }
        if (c < 512) {
            bf16_t* tp = btg + ((size_t)((t0 >> 12) * 512 + c)) * SEQ + (t0 & (SEQ - 1));
#pragma unroll
            for (int e = 0; e < 4; ++e) {
                u32x4 lo0, lo1, hi0, hi1;
                lo0.x = (W[0][e] & 0xffffu) | (W[1][e] << 16); lo0.y = (W[2][e] & 0xffffu) | (W[3][e] << 16); lo0.z = (W[4][e] & 0xffffu) | (W[5][e] << 16); lo0.w = (W[6][e] & 0xffffu) | (W[7][e] << 16);
                lo1.x = (W[8][e] & 0xffffu) | (W[9][e] << 16); lo1.y = (W[10][e] & 0xffffu) | (W[11][e] << 16); lo1.z = (W[12][e] & 0xffffu) | (W[13][e] << 16); lo1.w = (W[14][e] & 0xffffu) | (W[15][e] << 16);
                hi0.x = (W[0][e] >> 16) | (W[1][e] & 0xffff0000u); hi0.y = (W[2][e] >> 16) | (W[3][e] & 0xffff0000u); hi0.z = (W[4][e] >> 16) | (W[5][e] & 0xffff0000u); hi0.w = (W[6][e] >> 16) | (W[7][e] & 0xffff0000u);
                hi1.x = (W[8][e] >> 16) | (W[9][e] & 0xffff0000u); hi1.y = (W[10][e] >> 16) | (W[11][e] & 0xffff0000u); hi1.z = (W[12][e] >> 16) | (W[13][e] & 0xffff0000u); hi1.w = (W[14][e] >> 16) | (W[15][e] & 0xffff0000u);
                *(u32x4*)(tp + (size_t)(2 * e) * SEQ) = lo0; *(u32x4*)(tp + (size_t)(2 * e) * SEQ + 8) = lo1;
                *(u32x4*)(tp + (size_t)(2 * e + 1) * SEQ) = hi0; *(u32x4*)(tp + (size_t)(2 * e + 1) * SEQ + 8) = hi1;
            }
        }
    }
}

#define SSD_SCAN(cc) do { float* dts_ = dbase + ((cc) & 1) * 384; float* acs_ = dts_ + 128; float* wdec_ = acs_ + 128; \
                const float v0 = dtr0 + dtb, v1 = dtr1 + dtb; \
                const float dt0 = (v0 > 20.f) ? v0 : log1pf(__expf(v0)), dt1 = (v1 > 20.f) ? v1 : log1pf(__expf(v1)); \
                const float a0 = dt0 * Aneg, a1 = dt1 * Aneg; \
                float sc = a0 + a1; \
                _Pragma("unroll") for (int o = 1; o < 64; o <<= 1) { const float tv = __shfl_up(sc, o); if (lane >= o) sc += tv; } \
                const float atot = __shfl(sc, 63); \
                dts_[2 * lane] = dt0; dts_[2 * lane + 1] = dt1; acs_[2 * lane] = sc - a1; acs_[2 * lane + 1] = sc; \
                wdec_[2 * lane] = dt0 * __expf(atot - (sc - a1)); wdec_[2 * lane + 1] = dt1 * __expf(atot - sc); } while (0)
__device__ __forceinline__ void phase_ssd(int wv, KParams p, int l, bf16_t* proj, const float* misc, const bf16_t* bc, const bf16_t* btg, float* ssq, unsigned char* shm, unsigned long long& tacc, unsigned long long& tst) {
    const int tid = opaque_tid(wv), wave = __builtin_amdgcn_readfirstlane(tid >> 6), lane = tid & 63, fr = lane & 15, fq = lane >> 4;
    constexpr int ROW = 272;
    unsigned char* Cr = shm; unsigned char* Br = Cr + 128 * ROW; unsigned char* BT = Br + 128 * ROW;
    unsigned char* XT = BT + 128 * ROW; unsigned char* Hb = XT + 32 * ROW;
    float* wtab = (float*)(Hb + 32 * ROW) + 768;
    float* dbase = (float*)(Hb + 32 * ROW);
    const float* cw = p->ssd_conv_w + (size_t)l * 4 * 3072; const float* cb = p->ssd_conv_b + (size_t)l * 3072;
    for (int item = blockIdx.x; item < 256; item += gridDim.x) {
        const int bl = item >> 6, head = (item >> 1) & 31, ph = item & 1, g = head >> 3;
        const float Aneg = -__expf(p->ssd_a_log[l * 32 + head]), dtb = p->ssd_dt_bias[l * 32 + head], Dsk = p->ssd_d[l * 32 + head];
        const int lx = tid >> 2, cgx = tid & 3, chx = head * 64 + ph * 32 + cgx * 8;
        const int sr = tid >> 4, sc16 = tid & 15;
        f32x4 Hacc[2][2];
#pragma unroll
        for (int q2 = 0; q2 < 2; ++q2) { Hacc[q2][0] = (f32x4){0.f, 0.f, 0.f, 0.f}; Hacc[q2][1] = (f32x4){0.f, 0.f, 0.f, 0.f}; }
        __syncthreads();
        for (int i = tid; i < 32 * ROW / 4; i += 512) ((unsigned*)Hb)[i] = 0u;
        if (tid < 160) { const int cgi = tid / 40, r = tid - cgi * 40, j = r >> 3, chn = head * 64 + ph * 32 + cgi * 8 + (r & 7); wtab[tid] = (j == 0) ? cb[chn] : cw[(j - 1) * 3072 + chn]; }
        __syncthreads();
        u32x4 xr[4], br[12]; float dtr0 = 0.f, dtr1 = 0.f;
        {
            const char* gb = (const char*)(proj + ((ptrdiff_t)bl * SEQ - 3) * NP + C_XBC);
            unsigned vo = (unsigned)((lx * NP + chx) * 2); asm volatile("" : "+v"(vo));
#pragma unroll
            for (int j = 0; j < 4; ++j) { xr[j] = (u32x4){0u, 0u, 0u, 0u}; if (lx - 3 + j >= 0) xr[j] = *(const u32x4*)(gb + (vo + (unsigned)(j * NP * 2))); }
            const char* hb2 = (const char*)(bc + ((size_t)bl * SEQ) * 1024);
            unsigned vb = (unsigned)((sr * 1024 + g * 128 + sc16 * 8) * 2); asm volatile("" : "+v"(vb));
            const char* tb2 = (const char*)(btg + ((size_t)(bl * 512 + g * 128)) * SEQ);
            unsigned vt2 = (unsigned)((sr * SEQ + sc16 * 8) * 2); asm volatile("" : "+v"(vt2));
#pragma unroll
            for (int u = 0; u < 4; ++u) { br[u] = *(const u32x4*)(hb2 + (vb + (unsigned)(u * 32 * 1024 * 2))); br[4 + u] = *(const u32x4*)(hb2 + (vb + (unsigned)(u * 32 * 1024 * 2 + 1024)));
                br[8 + u] = *(const u32x4*)(tb2 + (vt2 + (unsigned)(u * 32 * SEQ * 2))); }
            if (wave == 0) { const float* mp = misc + ((size_t)bl * SEQ + 2 * lane) * 256 + 72 + head; dtr0 = mp[0]; dtr1 = mp[256];
                SSD_SCAN(0);
                dtr0 = mp[128 * 256]; dtr1 = mp[128 * 256 + 256]; }
        }
        for (int c = 0; c < 32; ++c) {
            TIC(12);
            const int t0 = c * 128;
            const size_t rbase = (size_t)bl * SEQ + t0;
            const float* dts = dbase + (c & 1) * 384; const float* acs = dts + 128; const float* wdec = acs + 128;
            {
                float wt[4][8], bias[8];
                { const float* wl = wtab + cgx * 40;
                  const f32x4 b0 = *(const f32x4*)wl, b1 = *(const f32x4*)(wl + 4);
#pragma unroll
                  for (int e = 0; e < 4; ++e) { bias[e] = b0[e]; bias[4 + e] = b1[e]; }
#pragma unroll
                  for (int j = 0; j < 4; ++j) { const f32x4 w0 = *(const f32x4*)(wl + 8 + j * 8), w1 = *(const f32x4*)(wl + 12 + j * 8);
#pragma unroll
                      for (int e = 0; e < 4; ++e) { wt[j][e] = w0[e]; wt[j][4 + e] = w1[e]; } } }
                const unsigned a0[4] = {xr[0].x, xr[0].y, xr[0].z, xr[0].w}, a1[4] = {xr[1].x, xr[1].y, xr[1].z, xr[1].w}, a2[4] = {xr[2].x, xr[2].y, xr[2].z, xr[2].w}, a3[4] = {xr[3].x, xr[3].y, xr[3].z, xr[3].w};
                unsigned char* xp = XT + (cgx * 8) * ROW + lx * 2;
#pragma unroll
                for (int e = 0; e < 4; ++e) {
                    const float lo = bias[2 * e] + wt[0][2 * e] * lo16(a0[e]) + wt[1][2 * e] * lo16(a1[e]) + wt[2][2 * e] * lo16(a2[e]) + wt[3][2 * e] * lo16(a3[e]);
                    const float hi = bias[2 * e + 1] + wt[0][2 * e + 1] * hi16(a0[e]) + wt[1][2 * e + 1] * hi16(a1[e]) + wt[2][2 * e + 1] * hi16(a2[e]) + wt[3][2 * e + 1] * hi16(a3[e]);
                    *(bf16_t*)(xp + (2 * e) * ROW) = f2bf(silu_f(lo)); *(bf16_t*)(xp + (2 * e + 1) * ROW) = f2bf(silu_f(hi));
                }
            }
            {
#pragma unroll
                for (int u = 0; u < 4; ++u) {
                    *(u32x4*)(Br + (sr + 32 * u) * ROW + sc16 * 16) = br[u];
                    *(u32x4*)(Cr + (sr + 32 * u) * ROW + sc16 * 16) = br[4 + u];
                    *(u32x4*)(BT + (sr + 32 * u) * ROW + sc16 * 16) = br[8 + u];
                }
            }
            __syncthreads(); TOC(12); TIC(11);
            {
                const size_t rnext = rbase + ((c + 1 < 32) ? 128 : 0);
                const char* gb = (const char*)(proj + ((ptrdiff_t)rnext - 3) * NP + C_XBC);
                unsigned vo = (unsigned)((lx * NP + chx) * 2); asm volatile("" : "+v"(vo));
#pragma unroll
                for (int j = 0; j < 4; ++j) xr[j] = *(const u32x4*)(gb + (vo + (unsigned)(j * NP * 2)));
                const char* hb2 = (const char*)(bc + rnext * 1024);
                unsigned vb = (unsigned)((sr * 1024 + g * 128 + sc16 * 8) * 2); asm volatile("" : "+v"(vb));
                const char* tb2 = (const char*)(btg + ((size_t)(bl * 512 + g * 128)) * SEQ + (rnext - (size_t)bl * SEQ));
                unsigned vt2 = (unsigned)((sr * SEQ + sc16 * 8) * 2); asm volatile("" : "+v"(vt2));
#pragma unroll
                for (int u = 0; u < 4; ++u) { br[u] = *(const u32x4*)(hb2 + (vb + (unsigned)(u * 32 * 1024 * 2))); br[4 + u] = *(const u32x4*)(hb2 + (vb + (unsigned)(u * 32 * 1024 * 2 + 1024)));
                    br[8 + u] = *(const u32x4*)(tb2 + (vt2 + (unsigned)(u * 32 * SEQ * 2))); }
            }
            {
                const int lt = (wave < 4) ? wave : 11 - wave;
                bf16_t* zp = proj + (rbase + lt * 16 + fr) * NP + C_Z + head * 64 + ph * 32 + fq * 4;
                const u32x2 zr0 = *(const u32x2*)zp, zr1 = *(const u32x2*)(zp + 16);
                const float acs_l = acs[lt * 16 + fr];
                bf16x8 cf[4];
#pragma unroll
                for (int ks = 0; ks < 4; ++ks) cf[ks] = *(const bf16x8*)(Cr + (lt * 16 + fr) * ROW + (ks * 32 + fq * 8) * 2);
                f32x4 yacc[2];
                {
                    bf16x8 hf[2][4];
#pragma unroll
                    for (int pt = 0; pt < 2; ++pt)
#pragma unroll
                        for (int ks = 0; ks < 4; ++ks) hf[pt][ks] = *(const bf16x8*)(Hb + (pt * 16 + fr) * ROW + (ks * 32 + fq * 8) * 2);
                    const float el = __expf(acs_l);
#pragma unroll
                    for (int pt = 0; pt < 2; ++pt) {
                        yacc[pt] = (f32x4){0.f, 0.f, 0.f, 0.f};
#pragma unroll
                        for (int ks = 0; ks < 4; ++ks) yacc[pt] = __builtin_amdgcn_mfma_f32_16x16x32_bf16(hf[pt][ks], cf[ks], yacc[pt], 0, 0, 0);
                        yacc[pt] *= el;
                    }
                    __builtin_amdgcn_sched_group_barrier(0x100, 12, 0); __builtin_amdgcn_sched_group_barrier(0x008, 8, 0);
                }
                const int lloc = fr - fq * 4;
                f32x4 cbt[8];
#pragma unroll
                for (int kk = 0; kk < 4; ++kk) {
                    cbt[2 * kk] = (f32x4){0.f, 0.f, 0.f, 0.f}; cbt[2 * kk + 1] = (f32x4){0.f, 0.f, 0.f, 0.f};
                    if (2 * kk <= lt) {
                        bf16x8 bfr[2][4];
#pragma unroll
                        for (int h2 = 0; h2 < 2; ++h2)
#pragma unroll
                            for (int ks = 0; ks < 4; ++ks) bfr[h2][ks] = *(const bf16x8*)(Br + ((2 * kk + h2) * 16 + fr) * ROW + (ks * 32 + fq * 8) * 2);
#pragma unroll
                        for (int ks = 0; ks < 4; ++ks) {
                            cbt[2 * kk] = __builtin_amdgcn_mfma_f32_16x16x32_bf16(bfr[0][ks], cf[ks], cbt[2 * kk], 0, 0, 0);
                            cbt[2 * kk + 1] = __builtin_amdgcn_mfma_f32_16x16x32_bf16(bfr[1][ks], cf[ks], cbt[2 * kk + 1], 0, 0, 0);
                        }
                        __builtin_amdgcn_sched_group_barrier(0x100, 8, 0); __builtin_amdgcn_sched_group_barrier(0x008, 8, 0);
                    }
                }
                unsigned mp[8][2];
#pragma unroll
                for (int st = 0; st < 8; ++st) {
                    mp[st][0] = 0u; mp[st][1] = 0u;
                    if (st <= lt) {
                        const f32x4 av = *(const f32x4*)(acs + st * 16 + fq * 4), dv = *(const f32x4*)(dts + st * 16 + fq * 4);
                        float mv[4];
#pragma unroll
                        for (int r = 0; r < 4; ++r) {
                            const int dl = (lt - st) * 16 + lloc - r;
                            float m = (dl >= 0) ? cbt[st][r] * __expf(acs_l - av[r]) * dv[r] : 0.f;
                            if (dl == 0) m += Dsk;
                            mv[r] = m;
                        }
                        mp[st][0] = pg8::cvt_pk_bf16(mv[0], mv[1]); mp[st][1] = pg8::cvt_pk_bf16(mv[2], mv[3]);
                    }
                }
#pragma unroll
                for (int kk = 0; kk < 4; ++kk) {
                    if (2 * kk <= lt) {
                        u32x4 pk; pk.x = mp[2 * kk][0]; pk.y = mp[2 * kk][1]; pk.z = mp[2 * kk + 1][0]; pk.w = mp[2 * kk + 1][1];
                        const bf16x8 pf = __builtin_bit_cast(bf16x8, pk);
#pragma unroll
                        for (int pt = 0; pt < 2; ++pt) {
                            const unsigned char* xp = XT + (pt * 16 + fr) * ROW + (kk * 32 + fq * 4) * 2;
                            const bf16x4 v0 = *(const bf16x4*)xp, v1 = *(const bf16x4*)(xp + 32);
                            const bf16x8 xf = __builtin_shufflevector(v0, v1, 0, 1, 2, 3, 4, 5, 6, 7);
                            yacc[pt] = __builtin_amdgcn_mfma_f32_16x16x32_bf16(xf, pf, yacc[pt], 0, 0, 0);
                        }
                    }
                }
                float sq = 0.f;
#pragma unroll
                for (int pt = 0; pt < 2; ++pt) {
                    const u32x2 zr = pt ? zr1 : zr0;
                    const float y0 = yacc[pt][0] * silu_f(lo16(zr.x)), y1 = yacc[pt][1] * silu_f(hi16(zr.x)), y2 = yacc[pt][2] * silu_f(lo16(zr.y)), y3 = yacc[pt][3] * silu_f(hi16(zr.y));
                    sq += y0 * y0 + y1 * y1 + y2 * y2 + y3 * y3;
                    u32x2 w; w.x = pg8::cvt_pk_bf16(y0, y1); w.y = pg8::cvt_pk_bf16(y2, y3);
                    *(u32x2*)(zp + pt * 16) = w;
                }
                sq += __shfl_xor(sq, 16); sq += __shfl_xor(sq, 32);
                if (fq == 0) ssq[(rbase + lt * 16 + fr) * 64 + head * 2 + ph] = sq;
                if (wave < 4) {
                    const float dec = __expf(acs[127]);
#pragma unroll
                    for (int q2 = 0; q2 < 2; ++q2) { Hacc[q2][0] *= dec; Hacc[q2][1] *= dec; }
#pragma unroll
                    for (int ks = 0; ks < 4; ++ks) {
                        const f32x4 w0 = *(const f32x4*)(wdec + ks * 32 + fq * 8), w1 = *(const f32x4*)(wdec + ks * 32 + fq * 8 + 4);
                        bf16x8 xw[2];
#pragma unroll
                        for (int pt = 0; pt < 2; ++pt) {
                            const u32x4 raw = *(const u32x4*)(XT + (pt * 16 + fr) * ROW + (ks * 32 + fq * 8) * 2);
                            u32x4 sc4;
                            sc4.x = pg8::cvt_pk_bf16(lo16(raw.x) * w0[0], hi16(raw.x) * w0[1]); sc4.y = pg8::cvt_pk_bf16(lo16(raw.y) * w0[2], hi16(raw.y) * w0[3]);
                            sc4.z = pg8::cvt_pk_bf16(lo16(raw.z) * w1[0], hi16(raw.z) * w1[1]); sc4.w = pg8::cvt_pk_bf16(lo16(raw.w) * w1[2], hi16(raw.w) * w1[3]);
                            xw[pt] = __builtin_bit_cast(bf16x8, sc4);
                        }
#pragma unroll
                        for (int q2 = 0; q2 < 2; ++q2) {
                            const bf16x8 btf = *(const bf16x8*)(BT + ((wave * 2 + q2) * 16 + fr) * ROW + (ks * 32 + fq * 8) * 2);
                            Hacc[q2][0] = __builtin_amdgcn_mfma_f32_16x16x32_bf16(xw[0], btf, Hacc[q2][0], 0, 0, 0);
                            Hacc[q2][1] = __builtin_amdgcn_mfma_f32_16x16x32_bf16(xw[1], btf, Hacc[q2][1], 0, 0, 0);
                        }
                    }
                }
            }
            TOC(11); TIC(13);
            if (wave == 0 && c + 1 < 32) {
                SSD_SCAN(c + 1);
                if (c + 2 < 32) { const float* mp = misc + (rbase + 256 + 2 * lane) * 256 + 72 + head; dtr0 = mp[0]; dtr1 = mp[256]; }
            }
            __syncthreads();
            if (wave < 4) {
#pragma unroll
                for (int q2 = 0; q2 < 2; ++q2)
#pragma unroll
                    for (int pt = 0; pt < 2; ++pt)
#pragma unroll
                        for (int r = 0; r < 4; ++r) *(bf16_t*)(Hb + (pt * 16 + fq * 4 + r) * ROW + ((wave * 2 + q2) * 16 + fr) * 2) = f2bf(Hacc[q2][pt][r]);
            }
            TOC(13);
        }
    }
}

#undef SSD_SCAN
__device__ __forceinline__ void phase_gtab(int wv, const float* ssq, float* gtab) {
    const int tid = opaque_tid(wv);
    pg8::StaticOrder S; S.init(SLAB, 1024, (int)gridDim.x, (int)blockIdx.x);
    pg8::Unit u;
    for (int ui = 0; ui < 4 && S.next(ui, u); ++ui) {
        if (tid < 256) {
            const float* sp = ssq + (size_t)(u.pm * 256 + tid) * 64;
            float r[4];
#pragma unroll
            for (int g = 0; g < 4; ++g) {
                const f32x4 s0 = *(const f32x4*)(sp + g * 16), s1 = *(const f32x4*)(sp + g * 16 + 4), s2 = *(const f32x4*)(sp + g * 16 + 8), s3 = *(const f32x4*)(sp + g * 16 + 12);
                const float tot = s0[0] + s0[1] + s0[2] + s0[3] + s1[0] + s1[1] + s1[2] + s1[3] + s2[0] + s2[1] + s2[2] + s2[3] + s3[0] + s3[1] + s3[2] + s3[3];
                r[g] = rsqrtf(tot * (1.0f / 512.0f) + EPS);
            }
            float* tp = gtab + ui * 1024 + tid;
            tp[0] = r[0] / r[1]; tp[256] = r[1] / r[2]; tp[512] = r[2] / r[3]; tp[768] = r[3];
        }
    }
    __syncthreads();
}

__device__ __forceinline__ void phase_convglu(int wv, const bf16_t* U, bf16_t* GL, const float* cw, const float* cb) {
    const int tid = opaque_tid(wv);
    for (int idx = blockIdx.x * 512 + tid; idx < 352 * (SLAB / 32); idx += gridDim.x * 512) {
        const int run = idx / 352, f = (idx - run * 352) * 8, t0 = run * 32;
        float wg[3][8], wvv[3][8], bg[8], bv[8];
#pragma unroll
        for (int e = 0; e < 8; ++e) { bg[e] = cb[f + e]; bv[e] = cb[FFN + f + e];
#pragma unroll
            for (int j = 0; j < 3; ++j) { wg[j][e] = cw[j * FFN2 + f + e]; wvv[j][e] = cw[j * FFN2 + FFN + f + e]; } }
        u32x4 g0 = (u32x4){0u, 0u, 0u, 0u}, g1 = g0, v0 = g0, v1 = g0;
        if ((t0 & (SEQ - 1)) != 0) {
            const bf16_t* up = U + (size_t)(t0 - 2) * FFN2 + f;
            g0 = *(const u32x4*)up; v0 = *(const u32x4*)(up + FFN); g1 = *(const u32x4*)(up + FFN2); v1 = *(const u32x4*)(up + FFN2 + FFN);
        }
        for (int tb = 0; tb < 32; tb += 4) {
            u32x4 gn[4], vn[4];
#pragma unroll
            for (int u = 0; u < 4; ++u) { const bf16_t* up = U + (size_t)(t0 + tb + u) * FFN2 + f; gn[u] = *(const u32x4*)up; vn[u] = *(const u32x4*)(up + FFN); }
#pragma unroll
            for (int u = 0; u < 4; ++u) {
                const unsigned ga0[4] = {g0.x, g0.y, g0.z, g0.w}, ga1[4] = {g1.x, g1.y, g1.z, g1.w}, ga2[4] = {gn[u].x, gn[u].y, gn[u].z, gn[u].w};
                const unsigned va0[4] = {v0.x, v0.y, v0.z, v0.w}, va1[4] = {v1.x, v1.y, v1.z, v1.w}, va2[4] = {vn[u].x, vn[u].y, vn[u].z, vn[u].w};
                unsigned ow[4];
#pragma unroll
                for (int e = 0; e < 4; ++e) {
                    const float gl = bg[2 * e] + wg[0][2 * e] * lo16(ga0[e]) + wg[1][2 * e] * lo16(ga1[e]) + wg[2][2 * e] * lo16(ga2[e]);
                    const float gh = bg[2 * e + 1] + wg[0][2 * e + 1] * hi16(ga0[e]) + wg[1][2 * e + 1] * hi16(ga1[e]) + wg[2][2 * e + 1] * hi16(ga2[e]);
                    const float vl = bv[2 * e] + wvv[0][2 * e] * lo16(va0[e]) + wvv[1][2 * e] * lo16(va1[e]) + wvv[2][2 * e] * lo16(va2[e]);
                    const float vh = bv[2 * e + 1] + wvv[0][2 * e + 1] * hi16(va0[e]) + wvv[1][2 * e + 1] * hi16(va1[e]) + wvv[2][2 * e + 1] * hi16(va2[e]);
                    ow[e] = pack2(silu_f(gl) * vl, silu_f(gh) * vh);
                }
                u32x4 o; o.x = ow[0]; o.y = ow[1]; o.z = ow[2]; o.w = ow[3];
                *(u32x4*)(GL + (size_t)(t0 + tb + u) * FFN + f) = o;
                g0 = g1; g1 = gn[u]; v0 = v1; v1 = vn[u];
            }
        }
    }
}

__device__ __forceinline__ KParams kparams() { KParams k = (KParams)__builtin_amdgcn_kernarg_segment_ptr(); asm volatile("" : "+s"(k)); return k; }
#define WSP(T, off) ((T*)(kparams()->ws + (off)))

__global__ void __launch_bounds__(512, 2) mega(Params p_unused) {
    extern __shared__ __attribute__((aligned(16))) unsigned char shm[];
    cg::grid_group grid = cg::this_grid();
    const int wv = __builtin_amdgcn_readfirstlane((int)(threadIdx.x >> 6));
    LAS unsigned char* lds = (LAS unsigned char*)shm;
    unsigned long long tacc = 0ull, tst = 0ull;

#define NORM_MIX(l_, half_) do { KParams k_ = kparams(); const float* xi_ = ((l_) == 0) ? k_->x : k_->out; \
        phase_norm<false>(wv, xi_ + (size_t)(half_) * SLAB * 1024, k_->norm_mix_w + (l_) * 1024, WSP(bf16_t, OFF_H), nullptr, SLAB); } while (0)
#define NORM_FFN(l_, half_) do { KParams k_ = kparams(); \
        phase_norm<false>(wv, k_->out + (size_t)(half_) * SLAB * 1024, k_->norm_ffn_w + (l_) * 1024, WSP(bf16_t, OFF_H), nullptr, SLAB); } while (0)
    TIC(9); phase_convert(wv, kparams(), (float*)shm);
    NORM_MIX(0, 0);
    grid.sync(); TOC(9);
    for (int l = 0; l < DEPTH; ++l) {
        for (int half = 0; half < NSLAB; ++half) {
            const size_t r0 = (size_t)half * SLAB;
            TIC(1);
            { const float* rope = WSP(const float, OFF_ROPE);
              EpiInProj E{WSP(bf16_t, OFF_PROJ), WSP(float, OFF_MISC), rope, rope + 4096 * 16, rope + 4096 * 32, rope + 4096 * 40, WSP(bf16_t, OFF_VT)};
              pg8::gemm_phase(wv, lds, WSP(const bf16_t, OFF_H), 1024, WSP(const bf16_t, OFF_W + (size_t)l * SZ_WL), SLAB, NP, 1024, E); }
            grid.sync(); TOC(1); TIC(2);
            phase_bcconv(wv, kparams(), l, WSP(const bf16_t, OFF_PROJ), WSP(bf16_t, OFF_H), WSP(bf16_t, OFF_BTG));
            phase_idx(wv, WSP(const bf16_t, OFF_PROJ), WSP(const float, OFF_MISC), WSP(unsigned, OFF_MASK), shm);
            grid.sync(); TOC(2); TIC(3);
            phase_att(wv, WSP(bf16_t, OFF_PROJ), WSP(const bf16_t, OFF_VT), WSP(const unsigned, OFF_MASK), shm);
            __syncthreads(); TOC(3); TIC(4);
            { phase_ssd(wv, kparams(), l, WSP(bf16_t, OFF_PROJ), WSP(const float, OFF_MISC), WSP(const bf16_t, OFF_H), WSP(const bf16_t, OFF_BTG), WSP(float, OFF_SSQ), shm, tacc, tst); }
            TOC(4); TIC(10); grid.sync(); TOC(10); TIC(5);
            phase_gtab(wv, WSP(const float, OFF_SSQ), (float*)(shm + 131072));
            { EpiGateA E{WSP(bf16_t, OFF_PROJ)}; pg8::gemm_phase(wv, lds, WSP(const bf16_t, OFF_PROJ) + C_Q, NP, WSP(const bf16_t, OFF_W + (size_t)l * SZ_WL + SZ_WIN), SLAB, 1024, 1024, E); }
            { EpiGateS E{WSP(bf16_t, OFF_PROJ), (const float*)(shm + 131072)}; pg8::gemm_phase(wv, lds, WSP(const bf16_t, OFF_PROJ) + C_Z, NP, WSP(const bf16_t, OFF_W + (size_t)l * SZ_WL + SZ_WIN + SZ_WPA), SLAB, 1024, 2048, E); }
            grid.sync();
            { KParams k = kparams(); const float* xin = (l == 0) ? k->x : k->out;
              EpiResid E{xin + r0 * 1024, k->out + r0 * 1024};
              pg8::gemm_phase(wv, lds, WSP(const bf16_t, OFF_PROJ) + C_GS, NP, WSP(const bf16_t, OFF_W + (size_t)l * SZ_WL + SZ_WIN + SZ_WPA + SZ_WPS), SLAB, 1024, 1024, E); }
            if (half == 0) NORM_MIX(l, 1); else NORM_FFN(l, 0);
            grid.sync(); TOC(5);
        }
        for (int half = 0; half < NSLAB; ++half) {
            const size_t r0 = (size_t)half * SLAB;
            TIC(6);
            { EpiBf16 E{WSP(bf16_t, OFF_PROJ), FFN2};
              pg8::gemm_phase(wv, lds, WSP(const bf16_t, OFF_H), 1024, WSP(const bf16_t, OFF_W + (size_t)l * SZ_WL + SZ_WIN + SZ_WPA + SZ_WPS + SZ_WO), SLAB, FFN2, 1024, E); }
            grid.sync(); TOC(6); TIC(7);
            { KParams k = kparams(); phase_convglu(wv, WSP(const bf16_t, OFF_PROJ), WSP(bf16_t, OFF_GL), k->ffn_conv_w + (size_t)l * 3 * FFN2, k->ffn_conv_b + (size_t)l * FFN2); }
            grid.sync(); TOC(7); TIC(6);
            { KParams k = kparams(); EpiResid E{k->out + r0 * 1024, k->out + r0 * 1024};
              pg8::gemm_phase(wv, lds, WSP(const bf16_t, OFF_GL), FFN, WSP(const bf16_t, OFF_W + (size_t)l * SZ_WL + SZ_WIN + SZ_WPA + SZ_WPS + SZ_WO + SZ_WUP), SLAB, 1024, FFN, E); }
            if (half == 0) NORM_FFN(l, 1); else if (l + 1 < DEPTH) NORM_MIX(l + 1, 0);
            grid.sync(); TOC(6);
        }
    }
    { KParams k = kparams(); phase_norm<true>(wv, k->out, k->norm_final_w, nullptr, k->out, NTOK); }
    if (PROBE != 0 && blockIdx.x == 0) { const unsigned long long tend = __builtin_amdgcn_s_memrealtime() + 4ull * tacc; while (__builtin_amdgcn_s_memrealtime() < tend) __builtin_amdgcn_s_sleep(8); }
}

extern "C" void kernel_launch(void* const* d_in, const int* in_sizes, int n_in, void* d_out, int out_size, void* d_ws, size_t ws_size, hipStream_t stream) {
    static int grid_blocks = 0;
    if (!grid_blocks) {
        int dev = 0, cus = 0, per_cu = 0;
        hipGetDevice(&dev);
        hipDeviceGetAttribute(&cus, hipDeviceAttributeMultiprocessorCount, dev);
        hipFuncSetAttribute((const void*)mega, hipFuncAttributeMaxDynamicSharedMemorySize, LDS_BYTES);
        hipOccupancyMaxActiveBlocksPerMultiprocessor(&per_cu, mega, 512, LDS_BYTES);
        if (per_cu < 1) per_cu = 1;
        grid_blocks = cus * 1;
    }
    if (ws_size < OFF_END) { fprintf(stderr, "workspace too small: %zu < %zu\n", ws_size, (size_t)OFF_END); return; }
    Params p{};
    p.x = (const float*)d_in[0]; p.norm_mix_w = (const float*)d_in[1]; p.w_in = (const float*)d_in[2]; p.ssd_conv_w = (const float*)d_in[3]; p.ssd_conv_b = (const float*)d_in[4];
    p.ssd_dt_bias = (const float*)d_in[5]; p.ssd_a_log = (const float*)d_in[6]; p.ssd_d = (const float*)d_in[7]; p.ssd_norm_w = (const float*)d_in[8];
    p.w_proj_attn = (const float*)d_in[9]; p.w_proj_ssd = (const float*)d_in[10]; p.w_out = (const float*)d_in[11]; p.norm_ffn_w = (const float*)d_in[12];
    p.ffn_w_up = (const float*)d_in[13]; p.ffn_conv_w = (const float*)d_in[14]; p.ffn_conv_b = (const float*)d_in[15]; p.ffn_w_down = (const float*)d_in[16]; p.norm_final_w = (const float*)d_in[17];
    p.out = (float*)d_out; p.ws = (unsigned char*)d_ws;
    for (int i = 0; i < 16; ++i) p.invA[i] = powf(500000.0f, -(float)(2 * i) / 32.0f);
    for (int i = 0; i < 8; ++i) p.invI[i] = powf(500000.0f, -(float)(2 * i) / 16.0f);
    void* args[] = {&p};
    hipError_t e = hipLaunchCooperativeKernel((const void*)mega, dim3(grid_blocks), dim3(512), args, LDS_BYTES, stream);
    if (e != hipSuccess) fprintf(stderr, "cooperative launch failed: %s (grid %d)\n", hipGetErrorString(e), grid_blocks);
}
```

```cpp
#include <hip/hip_runtime.h>
#include <hip/hip_cooperative_groups.h>
#include <cstdio>
#include <cmath>
namespace cg = cooperative_groups;

#define LAS __attribute__((address_space(3)))
typedef unsigned short bf16_t;
typedef short bf16x8 __attribute__((ext_vector_type(8)));
typedef float f32x4 __attribute__((ext_vector_type(4)));
typedef unsigned u32x2 __attribute__((ext_vector_type(2)));
typedef unsigned u32x4 __attribute__((ext_vector_type(4)));

constexpr int D_MODEL = 1024, SEQ = 4096, NTOK = 32768, SLAB = 16384, NSLAB = 2, DEPTH = 2;
constexpr int IN_COLS = 9320, NP = 9472;
constexpr int C_Q = 0, C_K = 1024, C_V = 1280, C_QI = 1536, C_MISC = 2048, C_Z = 2304, C_XBC = 4352, C_GA = 7424, C_GS = 8448;
constexpr int FFN = 2816, FFN2 = 5632;
constexpr float EPS = 1e-6f;

constexpr size_t SZ_WIN = (size_t)NP * 1024 * 2, SZ_WPA = (size_t)1024 * 1024 * 2, SZ_WPS = (size_t)1024 * 2048 * 2, SZ_WO = SZ_WPA,
                 SZ_WUP = (size_t)FFN2 * 1024 * 2, SZ_WDN = (size_t)1024 * FFN * 2;
constexpr size_t SZ_WL = SZ_WIN + SZ_WPA + SZ_WPS + SZ_WO + SZ_WUP + SZ_WDN;
constexpr size_t OFF_W = 0;
constexpr size_t OFF_ROPE = OFF_W + 2 * SZ_WL;
constexpr size_t OFF_H = OFF_ROPE + (size_t)4096 * 48 * 4;
constexpr size_t OFF_PROJ = OFF_H + (size_t)SLAB * 1024 * 2;
constexpr size_t OFF_MISC = OFF_PROJ + (size_t)SLAB * NP * 2;
constexpr size_t OFF_MASK = OFF_MISC + (size_t)SLAB * 256 * 4;
constexpr size_t OFF_SEL = OFF_MASK + (size_t)SLAB * 128 * 4;
constexpr size_t OFF_SSQ = OFF_SEL + (size_t)SLAB * 256 * 4;
constexpr size_t OFF_VT = OFF_SSQ + (size_t)SLAB * 64 * 4;
constexpr size_t OFF_BTG = OFF_VT + (size_t)4 * 2 * 128 * 4096 * 2;
constexpr size_t OFF_END = OFF_BTG + (size_t)4 * 512 * 4096 * 2;
static_assert(OFF_END <= (size_t)536870912, "workspace budget");
constexpr size_t OFF_GL = OFF_PROJ + (size_t)SLAB * FFN2 * 2;

constexpr int LDS_BYTES = 150528;
#ifndef PROBE
#define PROBE 0
#endif
#define TIC(k) do { if (PROBE == (k)) tst = __builtin_amdgcn_s_memrealtime(); } while (0)
#define TOC(k) do { if (PROBE == (k)) tacc += __builtin_amdgcn_s_memrealtime() - tst; } while (0)

struct Params {
    const float* x; const float* norm_mix_w; const float* w_in; const float* ssd_conv_w; const float* ssd_conv_b;
    const float* ssd_dt_bias; const float* ssd_a_log; const float* ssd_d; const float* ssd_norm_w;
    const float* w_proj_attn; const float* w_proj_ssd; const float* w_out; const float* norm_ffn_w;
    const float* ffn_w_up; const float* ffn_conv_w; const float* ffn_conv_b; const float* ffn_w_down; const float* norm_final_w;
    float* out; unsigned char* ws;
    float invA[16]; float invI[8];
};
typedef const __attribute__((address_space(4))) Params* KParams;

__device__ __forceinline__ int opaque_tid(int wv) { int t; asm volatile("v_mbcnt_lo_u32_b32 %0, -1, 0\n\tv_mbcnt_hi_u32_b32 %0, -1, %0" : "=v"(t)); return wv * 64 + t; }
__device__ __forceinline__ float bf2f(bf16_t b) { return __uint_as_float(((unsigned)b) << 16); }
__device__ __forceinline__ bf16_t f2bf(float f) { unsigned u = __float_as_uint(f); u += 0x7FFFu + ((u >> 16) & 1u); return (bf16_t)(u >> 16); }
__device__ __forceinline__ unsigned pack2(float lo, float hi) { return (unsigned)f2bf(lo) | ((unsigned)f2bf(hi) << 16); }
__device__ __forceinline__ float lo16(unsigned w) { return __uint_as_float(w << 16); }
__device__ __forceinline__ float hi16(unsigned w) { return __uint_as_float(w & 0xffff0000u); }
__device__ __forceinline__ float silu_f(float v) { return v * __builtin_amdgcn_rcpf(1.0f + __expf(-v)); }
__device__ __forceinline__ float sigmoid_f(float v) { return __builtin_amdgcn_rcpf(1.0f + __expf(-v)); }
__device__ __forceinline__ void wave_lds_sync() { __builtin_amdgcn_fence(__ATOMIC_SEQ_CST, "wavefront"); __builtin_amdgcn_wave_barrier(); }
__device__ __forceinline__ float wave_sum(float v) {
#pragma unroll
    for (int o = 32; o >= 1; o >>= 1) v += __shfl_xor(v, o);
    return v;
}
__device__ __forceinline__ float wave_max(float v) {
#pragma unroll
    for (int o = 32; o >= 1; o >>= 1) v = fmaxf(v, __shfl_xor(v, o));
    return v;
}
__device__ __forceinline__ int permA(int s) { return 16 * ((s >> 2) & 1) + 4 * (s >> 3) + (s & 3); }
__device__ __forceinline__ int permI(int s) { return s < 16 ? 8 * ((s >> 2) & 1) + 4 * (s >> 3) + (s & 3) : s; }
__device__ __forceinline__ int perm32(int rho) { const int n = rho >> 4, i = rho & 15; return 8 * (i >> 2) + 4 * n + (i & 3); }
__device__ __forceinline__ int inproj_map(int n) {
    if (n < C_V) { const int sd = n & 127; return (sd < 32) ? (n & ~127) + permA(sd) : n; }
    if (n < C_QI) return n;
    if (n < C_MISC) { const int r = n - C_QI; return C_QI + (r & ~63) + permI(r & 63); }
    if (n < C_Z) { const int c = n - C_MISC; if (c < 64) return 2048 + permI(c); if (c < 72) return 2112 + (c - 64); if (c < 104) return 7240 + (c - 72); return -1; }
    if (n < C_XBC) return 2120 + (n - C_Z);
    if (n < C_GA) return 4168 + (n - C_XBC);
    if (n < C_GS) return 7272 + (n - C_GA);
    return 8296 + (n - C_GS);
}

namespace pg8 {
constexpr int BM = 256, BK = 64, HALF = 128, HTB = HALF * BK * 2, NXCD = 8, WGM = 2;
__device__ __forceinline__ int lds_byte(int r, int c) { const int st = (r >> 4) * 2 + (c >> 5), rr = r & 15, cc = c & 31, ob = rr * 64 + cc * 2; return st * 1024 + (ob ^ (((ob >> 9) & 1) << 5)); }
__device__ __forceinline__ void stage_rc(int b, int& R, int& C) { const int st = b / 1024, sb = b % 1024, swz = sb ^ (((sb >> 9) & 1) << 5); R = (st >> 1) * 16 + swz / 64; C = (st & 1) * 32 + (swz % 64) / 2; }
struct Unit { int pm, pn; };
struct StaticOrder {
    int nM, nN, nwg, G, c;
    __device__ void init(int M, int N, int G_, int c_) { nM = M / BM; nN = N / BM; nwg = nM * nN; G = G_; c = c_; }
    __device__ bool next(int i, Unit& u) const {
        const long L = (long)i * G + c; if (L >= nwg) return false;
        int wgid = (int)L; { const int q = nwg / NXCD, r = nwg % NXCD, xcd = wgid % NXCD, off = wgid / NXCD; wgid = (xcd < r ? xcd * (q + 1) : r * (q + 1) + (xcd - r) * q) + off; }
        const int nig = WGM * nN, gid = wgid / nig, fm = gid * WGM, gsz = (nM - fm) < WGM ? (nM - fm) : WGM;
        u.pm = fm + ((wgid % nig) % gsz); u.pn = (wgid % nig) / gsz; return true;
    }
};
__device__ __forceinline__ unsigned cvt_pk_bf16(float lo, float hi) { unsigned r; asm volatile("v_cvt_pk_bf16_f32 %0, %1, %2" : "=v"(r) : "v"(lo), "v"(hi)); return r; }

template <class Epi>
__device__ __forceinline__ void gemm_phase(int wv, LAS unsigned char* lds, const bf16_t* A, int lda, const bf16_t* Bt, int M, int N, int K, const Epi& E) {
    const int tid = opaque_tid(wv), wid = __builtin_amdgcn_readfirstlane(tid >> 6), lane = tid & 63, wr = wid >> 2, wc = wid & 3, fr = lane & 15, fq = lane >> 4;
    const int nt = K / BK;
    StaticOrder S; S.init(M, N, (int)gridDim.x, (int)blockIdx.x);
    unsigned voffA[2], voffB[2];
#pragma unroll
    for (int i = 0; i < 2; ++i) { int R, C; stage_rc(tid * 16 + i * 8192, R, C); voffA[i] = (unsigned)(R * lda + C) * 2u; voffB[i] = (unsigned)(R * K + C) * 2u; }
    const size_t kstep = (size_t)(BK * 2);
    const size_t hstepA = (size_t)HALF * lda * 2, hstepB = (size_t)HALF * K * 2;
    const size_t tstepA = 2 * hstepA, tstepB = 2 * hstepB;
    const unsigned ldsw = (unsigned)wid * 1024u;
    const int aoff = lds_byte(wr * 64 + fr, fq * 8), boff = lds_byte(wc * 32 + fr, fq * 8);
#define PG8_SA(b, h) (((b) * 2 + (h)) * HTB)
#define PG8_SB(b, h) ((4 + (b) * 2 + (h)) * HTB)
#define PG8_STAGE(bufoff, gbase, voff) do { _Pragma("unroll") for (int _i = 0; _i < 2; ++_i) \
        __builtin_amdgcn_global_load_lds((const unsigned*)((const char*)(gbase) + (voff)[_i]), (LAS unsigned*)(lds + (bufoff) + ldsw + _i * 8192), 16, 0, 0); } while (0)
#define PG8_LDA(dst, b, h) do { _Pragma("unroll") for (int m = 0; m < 4; ++m) _Pragma("unroll") for (int k = 0; k < 2; ++k) dst[m][k] = *(const LAS bf16x8*)(lds + PG8_SA(b, h) + aoff + m * 2048 + k * 1024); } while (0)
#define PG8_LDB(dst, b, h) do { _Pragma("unroll") for (int n = 0; n < 2; ++n) _Pragma("unroll") for (int k = 0; k < 2; ++k) dst[n][k] = *(const LAS bf16x8*)(lds + PG8_SB(b, h) + boff + n * 2048 + k * 1024); } while (0)
#define PG8_MMA(ai, bj, At, Bt_) do { __builtin_amdgcn_s_setprio(1); _Pragma("unroll") for (int m = 0; m < 4; ++m) _Pragma("unroll") for (int n = 0; n < 2; ++n) _Pragma("unroll") for (int k = 0; k < 2; ++k) \
        acc[ai][bj][m][n] = __builtin_amdgcn_mfma_f32_16x16x32_bf16(Bt_[n][k], At[m][k], acc[ai][bj][m][n], 0, 0, 0); __builtin_amdgcn_s_setprio(0); } while (0)
#define PG8_WAIT_V(n) asm volatile("s_waitcnt vmcnt(" #n ")" ::: "memory")
#define PG8_WAIT_L(n) asm volatile("s_waitcnt lgkmcnt(" #n ")" ::: "memory")
#define PG8_BAR __builtin_amdgcn_s_barrier()
#define PG8_SCHED __builtin_amdgcn_sched_barrier(0)
    Unit cur, nxt; int ui = 0;
    if (!S.next(0, cur)) return;
    f32x4 acc[2][2][4][2];
#pragma unroll
    for (int a = 0; a < 2; ++a)
#pragma unroll
        for (int b = 0; b < 2; ++b)
#pragma unroll
            for (int m = 0; m < 4; ++m)
#pragma unroll
                for (int n = 0; n < 2; ++n) acc[a][b][m][n] = (f32x4){0.f, 0.f, 0.f, 0.f};
    bf16x8 At[4][2], B0[2][2], B1[2][2];
    const char* cA = (const char*)A + (size_t)cur.pm * tstepA; const char* cB = (const char*)Bt + (size_t)cur.pn * tstepB;
    PG8_STAGE(PG8_SB(0, 0), cB, voffB); PG8_STAGE(PG8_SB(0, 1), cB + hstepB, voffB); PG8_STAGE(PG8_SA(0, 0), cA, voffA); PG8_STAGE(PG8_SA(0, 1), cA + hstepA, voffA);
    if (wr == 1) PG8_BAR;
    PG8_WAIT_V(2); PG8_BAR;
    PG8_STAGE(PG8_SB(1, 0), cB + kstep, voffB); PG8_STAGE(PG8_SA(1, 0), cA + kstep, voffA); PG8_STAGE(PG8_SB(1, 1), cB + hstepB + kstep, voffB);
    PG8_WAIT_V(6); PG8_BAR;
    for (;;) {
        const bool has_next = S.next(ui + 1, nxt);
        const char* nA = has_next ? (const char*)A + (size_t)nxt.pm * tstepA : cA; const char* nB = has_next ? (const char*)Bt + (size_t)nxt.pn * tstepB : cB;
        const int TG = Epi::GS ? 8 : nt;
        for (int tg = 0; tg < nt; tg += TG) {
        for (int t = tg; t < tg + TG; t += 2) {
            const bool last = (t == nt - 2);
            const char* a1 = cA + (size_t)(t + 1) * kstep;
            const char* a2 = last ? nA : cA + (size_t)(t + 2) * kstep; const char* b2 = last ? nB : cB + (size_t)(t + 2) * kstep;
            const char* a3 = a2 + kstep; const char* b3 = b2 + kstep;
            PG8_LDB(B0, 0, 0); PG8_LDB(B1, 0, 1); PG8_SCHED; PG8_LDA(At, 0, 0); PG8_STAGE(PG8_SA(1, 1), a1 + hstepA, voffA);
            PG8_WAIT_V(8); PG8_WAIT_L(0); PG8_BAR; PG8_MMA(0, 0, At, B0); PG8_MMA(0, 1, At, B1); PG8_BAR; PG8_SCHED;
            PG8_LDA(At, 0, 1); PG8_STAGE(PG8_SB(0, 0), b2, voffB); PG8_STAGE(PG8_SB(0, 1), b2 + hstepB, voffB); PG8_STAGE(PG8_SA(0, 0), a2, voffA);
            PG8_WAIT_V(8); PG8_WAIT_L(0); PG8_BAR; PG8_MMA(1, 0, At, B0); PG8_MMA(1, 1, At, B1); PG8_BAR; PG8_SCHED;
            PG8_LDB(B0, 1, 0); PG8_LDB(B1, 1, 1); PG8_SCHED; PG8_LDA(At, 1, 0); PG8_STAGE(PG8_SA(0, 1), a2 + hstepA, voffA);
            PG8_WAIT_V(8); PG8_WAIT_L(0); PG8_BAR; PG8_MMA(0, 0, At, B0); PG8_MMA(0, 1, At, B1); PG8_BAR; PG8_SCHED;
            PG8_LDA(At, 1, 1); PG8_STAGE(PG8_SB(1, 0), b3, voffB); PG8_STAGE(PG8_SB(1, 1), b3 + hstepB, voffB); PG8_STAGE(PG8_SA(1, 0), a3, voffA);
            PG8_WAIT_V(8); PG8_WAIT_L(0); PG8_BAR; PG8_MMA(1, 0, At, B0); PG8_MMA(1, 1, At, B1); PG8_BAR; PG8_SCHED;
        }
        if constexpr (Epi::GS) { if (tg + TG < nt) E.group_scale(acc, ui, tg >> 3, wr, fr); }
        }
        if (wr == 0) PG8_BAR;
        if constexpr (Epi::GS) E.run(acc, cur, wr, wc, fr, fq, ui); else E(acc, cur, wr, wc, fr, fq);
        if (!has_next) break;
#pragma unroll
        for (int a = 0; a < 2; ++a)
#pragma unroll
            for (int b = 0; b < 2; ++b)
#pragma unroll
                for (int m = 0; m < 4; ++m)
#pragma unroll
                    for (int n = 0; n < 2; ++n) acc[a][b][m][n] = (f32x4){0.f, 0.f, 0.f, 0.f};
        cur = nxt; cA = nA; cB = nB; ++ui;
        if (wr == 1) PG8_BAR;
    }
    PG8_WAIT_V(0);
    PG8_BAR;
#undef PG8_SA
#undef PG8_SB
#undef PG8_STAGE
#undef PG8_LDA
#undef PG8_LDB
#undef PG8_MMA
#undef PG8_WAIT_V
#undef PG8_WAIT_L
#undef PG8_BAR
#undef PG8_SCHED
}
}
using pg8::Unit;

struct EpiInProj {
    static constexpr bool GS = false;
    bf16_t* proj; float* misc; const float* cosA; const float* sinA; const float* cosI; const float* sinI; bf16_t* vt;
    __device__ __forceinline__ void operator()(const f32x4 (&acc)[2][2][4][2], const Unit& u, int wr, int wc, int fr, int fq) const {
        const int pn = u.pn, row0 = u.pm * 256 + wr * 64 + fr;
        const bool is_misc = (pn == 8), is_sig = (pn >= 29);
#pragma unroll
        for (int ai = 0; ai < 2; ++ai)
#pragma unroll
            for (int m = 0; m < 4; ++m) {
                const int r = row0 + ai * 128 + m * 16, pos = r & (SEQ - 1);
#pragma unroll
                for (int bj = 0; bj < 2; ++bj) {
                    int kind = 0;
                    if (pn <= 4) kind = (wc == 0) ? 1 : 0;
                    else if (pn == 6 || pn == 7) kind = (((wc & 1) == 0) && fq < 2) ? 2 : 0;
                    else if (pn == 8) kind = (bj == 0 && wc == 0 && fq < 2) ? 2 : 0;
                    f32x4 c4 = (f32x4){1.f, 1.f, 1.f, 1.f}, s4 = (f32x4){0.f, 0.f, 0.f, 0.f};
                    if (kind == 1) { c4 = *(const f32x4*)(cosA + pos * 16 + 4 * fq); s4 = *(const f32x4*)(sinA + pos * 16 + 4 * fq); }
                    else if (kind == 2) { c4 = *(const f32x4*)(cosI + pos * 8 + 4 * fq); s4 = *(const f32x4*)(sinI + pos * 8 + 4 * fq); }
                    const f32x4 v0 = acc[ai][bj][m][0], v1 = acc[ai][bj][m][1];
                    f32x4 o0 = v0 * c4 - v1 * s4, o1 = v1 * c4 + v0 * s4;
                    if (is_sig) {
#pragma unroll
                        for (int j = 0; j < 4; ++j) { o0[j] = sigmoid_f(o0[j]); o1[j] = sigmoid_f(o1[j]); }
                    }
                    const int cc = bj * 128 + wc * 32 + 8 * fq;
                    u32x4 pk; pk.x = pg8::cvt_pk_bf16(o0[0], o0[1]); pk.y = pg8::cvt_pk_bf16(o0[2], o0[3]); pk.z = pg8::cvt_pk_bf16(o1[0], o1[1]); pk.w = pg8::cvt_pk_bf16(o1[2], o1[3]);
                    if (is_misc) {
                        float* mp = misc + (size_t)r * 256 + cc;
                        *(f32x4*)mp = o0; *(f32x4*)(mp + 4) = o1;
                        if (bj == 0 && wc < 2) *(u32x4*)(proj + (size_t)r * NP + C_MISC + cc) = pk;
                    } else {
                        if (pn == 5) {
                            bf16_t* vp = vt + ((size_t)((r >> 12) * 2 + bj) * 128 + wc * 32 + 8 * fq) * SEQ + pos;
#pragma unroll
                            for (int j = 0; j < 4; ++j) { vp[(size_t)j * SEQ] = f2bf(o0[j]); vp[(size_t)(4 + j) * SEQ] = f2bf(o1[j]); }
                        }
                        *(u32x4*)(proj + (size_t)r * NP + pn * 256 + cc) = pk;
                    }
                }
            }
    }
};
struct EpiGateA {
    static constexpr bool GS = false;
    bf16_t* proj;
    __device__ __forceinline__ void operator()(const f32x4 (&acc)[2][2][4][2], const Unit& u, int wr, int wc, int fr, int fq) const {
        const int row0 = u.pm * 256 + wr * 64 + fr, col0 = u.pn * 256 + wc * 32 + 8 * fq;
#pragma unroll
        for (int ai = 0; ai < 2; ++ai)
#pragma unroll
            for (int m = 0; m < 4; ++m)
#pragma unroll
                for (int bj = 0; bj < 2; ++bj) {
                    bf16_t* pp = proj + (size_t)(row0 + ai * 128 + m * 16) * NP + C_GA + col0 + bj * 128;
                    const u32x4 g = *(const u32x4*)pp; const f32x4 a = acc[ai][bj][m][0], b = acc[ai][bj][m][1];
                    u32x4 w; w.x = pg8::cvt_pk_bf16(lo16(g.x) * a[0], hi16(g.x) * a[1]); w.y = pg8::cvt_pk_bf16(lo16(g.y) * a[2], hi16(g.y) * a[3]);
                    w.z = pg8::cvt_pk_bf16(lo16(g.z) * b[0], hi16(g.z) * b[1]); w.w = pg8::cvt_pk_bf16(lo16(g.w) * b[2], hi16(g.w) * b[3]);
                    *(u32x4*)pp = w;
                }
    }
};
struct EpiGateS {
    static constexpr bool GS = true;
    bf16_t* proj; const float* gtab;
    __device__ __forceinline__ void group_scale(f32x4 (&acc)[2][2][4][2], int u, int g, int wr, int fr) const {
        const float* tp = gtab + (u * 4 + g) * 256 + wr * 64 + fr;
#pragma unroll
        for (int ai = 0; ai < 2; ++ai)
#pragma unroll
            for (int m = 0; m < 4; ++m) {
                const float f = tp[ai * 128 + m * 16];
#pragma unroll
                for (int bj = 0; bj < 2; ++bj) { acc[ai][bj][m][0] *= f; acc[ai][bj][m][1] *= f; }
            }
    }
    __device__ __forceinline__ void run(const f32x4 (&acc)[2][2][4][2], const Unit& u, int wr, int wc, int fr, int fq, int ui) const {
        const int row0 = u.pm * 256 + wr * 64 + fr, col0 = u.pn * 256 + wc * 32 + 8 * fq;
        const float* tp = gtab + (ui * 4 + 3) * 256 + wr * 64 + fr;
#pragma unroll
        for (int ai = 0; ai < 2; ++ai)
#pragma unroll
            for (int m = 0; m < 4; ++m) {
                const float rl = tp[ai * 128 + m * 16];
#pragma unroll
                for (int bj = 0; bj < 2; ++bj) {
                    bf16_t* pa = proj + (size_t)(row0 + ai * 128 + m * 16) * NP + C_GA + col0 + bj * 128;
                    bf16_t* ps = pa + (C_GS - C_GA);
                    const u32x4 m1 = *(const u32x4*)pa; const u32x4 g = *(const u32x4*)ps; const f32x4 a = acc[ai][bj][m][0] * rl, b = acc[ai][bj][m][1] * rl;
                    u32x4 w; w.x = pg8::cvt_pk_bf16(lo16(m1.x) + lo16(g.x) * a[0], hi16(m1.x) + hi16(g.x) * a[1]);
                    w.y = pg8::cvt_pk_bf16(lo16(m1.y) + lo16(g.y) * a[2], hi16(m1.y) + hi16(g.y) * a[3]);
                    w.z = pg8::cvt_pk_bf16(lo16(m1.z) + lo16(g.z) * b[0], hi16(m1.z) + hi16(g.z) * b[1]);
                    w.w = pg8::cvt_pk_bf16(lo16(m1.w) + lo16(g.w) * b[2], hi16(m1.w) + hi16(g.w) * b[3]);
                    *(u32x4*)ps = w;
                }
            }
    }
};
struct EpiResid {
    static constexpr bool GS = false;
    const float* xin; float* xout;
    __device__ __forceinline__ void operator()(const f32x4 (&acc)[2][2][4][2], const Unit& u, int wr, int wc, int fr, int fq) const {
        const int row0 = u.pm * 256 + wr * 64 + fr, col0 = u.pn * 256 + wc * 32 + 8 * fq;
#pragma unroll
        for (int ai = 0; ai < 2; ++ai)
#pragma unroll
            for (int m = 0; m < 4; ++m)
#pragma unroll
                for (int bj = 0; bj < 2; ++bj)
#pragma unroll
                    for (int n = 0; n < 2; ++n) {
                        const size_t off = (size_t)(row0 + ai * 128 + m * 16) * 1024 + col0 + bj * 128 + n * 4;
                        *(f32x4*)(xout + off) = *(const f32x4*)(xin + off) + acc[ai][bj][m][n];
                    }
    }
};
struct EpiBf16 {
    static constexpr bool GS = false;
    bf16_t* O; int ldc;
    __device__ __forceinline__ void operator()(const f32x4 (&acc)[2][2][4][2], const Unit& u, int wr, int wc, int fr, int fq) const {
        const int row0 = u.pm * 256 + wr * 64 + fr, col0 = u.pn * 256 + wc * 32 + 8 * fq;
#pragma unroll
        for (int ai = 0; ai < 2; ++ai)
#pragma unroll
            for (int m = 0; m < 4; ++m)
#pragma unroll
                for (int bj = 0; bj < 2; ++bj) {
                    const f32x4 a = acc[ai][bj][m][0], b = acc[ai][bj][m][1];
                    u32x4 w; w.x = pg8::cvt_pk_bf16(a[0], a[1]); w.y = pg8::cvt_pk_bf16(a[2], a[3]); w.z = pg8::cvt_pk_bf16(b[0], b[1]); w.w = pg8::cvt_pk_bf16(b[2], b[3]);
                    *(u32x4*)(O + (size_t)(row0 + ai * 128 + m * 16) * ldc + col0 + bj * 128) = w;
                }
    }
};

template <int MODE>
__device__ __forceinline__ void convT(int wv, const float* src, int K, int Nsrc, bf16_t* dst, int Ndst, const float* kscale, float* tile) {
    const int tid = opaque_tid(wv), kt = K / 64, ntiles = (Ndst / 64) * kt;
    for (int ti = blockIdx.x; ti < ntiles; ti += gridDim.x) {
        const int n0 = (ti / kt) * 64, k0 = (ti % kt) * 64;
        {
            const int nn = tid & 63; const int nd = n0 + nn; const int n = (nd & ~31) + perm32(nd & 31); const int ns = MODE ? inproj_map(n) : n;
#pragma unroll
            for (int i = 0; i < 8; ++i) {
                const int kk = (tid >> 6) + 8 * i;
                float v = (ns >= 0) ? src[(size_t)(k0 + kk) * Nsrc + ns] : 0.f;
                if (kscale) v *= kscale[k0 + kk];
                tile[nn * 65 + kk] = v;
            }
        }
        __syncthreads();
        {
            const int kk = tid & 63;
#pragma unroll
            for (int i = 0; i < 8; ++i) { const int nn = (tid >> 6) + 8 * i; dst[(size_t)(n0 + nn) * K + k0 + kk] = f2bf(tile[nn * 65 + kk]); }
        }
        __syncthreads();
    }
}

__device__ __forceinline__ void phase_convert(int wv, KParams p, float* tile) {
    for (int l = 0; l < DEPTH; ++l) {
        unsigned char* wl = p->ws + OFF_W + (size_t)l * SZ_WL;
        bf16_t* win = (bf16_t*)wl; bf16_t* wpa = (bf16_t*)(wl + SZ_WIN); bf16_t* wps = (bf16_t*)(wl + SZ_WIN + SZ_WPA);
        bf16_t* wo = (bf16_t*)(wl + SZ_WIN + SZ_WPA + SZ_WPS); bf16_t* wup = (bf16_t*)(wl + SZ_WIN + SZ_WPA + SZ_WPS + SZ_WO); bf16_t* wdn = (bf16_t*)(wl + SZ_WIN + SZ_WPA + SZ_WPS + SZ_WO + SZ_WUP);
        convT<1>(wv, p->w_in + (size_t)l * 1024 * IN_COLS, 1024, IN_COLS, win, NP, nullptr, tile);
        convT<0>(wv, p->w_proj_attn + (size_t)l * 1024 * 1024, 1024, 1024, wpa, 1024, nullptr, tile);
        convT<0>(wv, p->w_proj_ssd + (size_t)l * 2048 * 1024, 2048, 1024, wps, 1024, p->ssd_norm_w + l * 2048, tile);
        convT<0>(wv, p->w_out + (size_t)l * 1024 * 1024, 1024, 1024, wo, 1024, nullptr, tile);
        convT<0>(wv, p->ffn_w_up + (size_t)l * 1024 * FFN2, 1024, FFN2, wup, FFN2, nullptr, tile);
        convT<0>(wv, p->ffn_w_down + (size_t)l * FFN * 1024, FFN, 1024, wdn, 1024, nullptr, tile);
    }
    float* rope = (float*)(p->ws + OFF_ROPE);
    float* cosA = rope; float* sinA = rope + 4096 * 16; float* cosI = rope + 4096 * 32; float* sinI = rope + 4096 * 40;
    for (int i = blockIdx.x * 512 + opaque_tid(wv); i < 4096 * 24; i += gridDim.x * 512) {
        int pos, f; float inv;
        if (i < 4096 * 16) { pos = i >> 4; f = i & 15; inv = p->invA[f]; } else { const int j = i - 4096 * 16; pos = j >> 3; f = j & 7; inv = p->invI[f]; }
        const float ang = (float)pos * inv;
        double rev = (double)ang * 0.15915494309189535; rev -= rint(rev);
        const float c = __builtin_amdgcn_cosf((float)rev), s = __builtin_amdgcn_sinf((float)rev);
        if (i < 4096 * 16) { cosA[pos * 16 + f] = c; sinA[pos * 16 + f] = s; } else { cosI[pos * 8 + f] = c; sinI[pos * 8 + f] = s; }
    }
}

template <bool F32OUT>
__device__ __forceinline__ void phase_norm(int wv, const float* xin, const float* w, bf16_t* hout, float* fout, int nrows) {
    const int tid = opaque_tid(wv); const int wave = tid >> 6, lane = tid & 63;
    const int stride = gridDim.x * 8;
    for (int row0 = blockIdx.x * 8 + wave; row0 < nrows; row0 += stride * 4) {
        f32x4 v[4][4];
#pragma unroll
        for (int u = 0; u < 4; ++u) {
            const int row = row0 + u * stride;
            if (row < nrows) {
                const f32x4* xr = (const f32x4*)(xin + (size_t)row * 1024);
#pragma unroll
                for (int i = 0; i < 4; ++i) v[u][i] = xr[lane + 64 * i];
            }
        }
        f32x4 w4[4];
#pragma unroll
        for (int i = 0; i < 4; ++i) w4[i] = ((const f32x4*)w)[lane + 64 * i];
#pragma unroll
        for (int u = 0; u < 4; ++u) {
            const int row = row0 + u * stride;
            if (row < nrows) {
                float ss = 0.f;
#pragma unroll
                for (int i = 0; i < 4; ++i) ss += v[u][i][0] * v[u][i][0] + v[u][i][1] * v[u][i][1] + v[u][i][2] * v[u][i][2] + v[u][i][3] * v[u][i][3];
                ss = wave_sum(ss);
                const float rstd = rsqrtf(ss * (1.0f / 1024.0f) + EPS);
#pragma unroll
                for (int i = 0; i < 4; ++i) {
                    const f32x4 o = v[u][i] * rstd * w4[i];
                    if (F32OUT) ((f32x4*)(fout + (size_t)row * 1024))[lane + 64 * i] = o;
                    else { u32x2 pk; pk.x = pack2(o[0], o[1]); pk.y = pack2(o[2], o[3]); *(u32x2*)(hout + (size_t)row * 1024 + 4 * (lane + 64 * i)) = pk; }
                }
            }
        }
    }
}

__device__ __forceinline__ unsigned fkey(float s) { s += 0.0f; const unsigned u = __float_as_uint(s); return (u & 0x80000000u) ? ~u : (u | 0x80000000u); }

__device__ __forceinline__ void phase_idx_simple(int wv, const bf16_t* proj, const float* misc, unsigned* mask, int* sel, unsigned char* shm) {
    const int tid = opaque_tid(wv); const int wave = tid >> 6, lane = tid & 63;
    float* qs = (float*)(shm + wave * 18432); unsigned* sk = (unsigned*)(shm + wave * 18432 + 2048);
    const unsigned long long lt_mask = (1ull << lane) - 1ull;
    for (int q = blockIdx.x * 8 + wave; q < SLAB; q += gridDim.x * 8) {
        const int bl = q >> 12, t = q & (SEQ - 1), n = t + 1;
        wave_lds_sync();
        {
            const u32x4 raw = *(const u32x4*)(proj + (size_t)q * NP + C_QI + lane * 8);
            f32x4 a, b; a[0] = lo16(raw.x); a[1] = hi16(raw.x); a[2] = lo16(raw.y); a[3] = hi16(raw.y); b[0] = lo16(raw.z); b[1] = hi16(raw.z); b[2] = lo16(raw.w); b[3] = hi16(raw.w);
            *(f32x4*)(qs + lane * 8) = a; *(f32x4*)(qs + lane * 8 + 4) = b;
        }
        float wv[8];
        { const f32x4 w0 = *(const f32x4*)(misc + (size_t)q * 256 + 64), w1 = *(const f32x4*)(misc + (size_t)q * 256 + 68);
#pragma unroll
          for (int j = 0; j < 4; ++j) { wv[j] = w0[j]; wv[4 + j] = w1[j]; } }
        wave_lds_sync();
        const int nr = (n + 63) & ~63;
        for (int s = lane; s < nr; s += 64) {
            if (s < n) {
                const f32x4* kp = (const f32x4*)(misc + (size_t)(bl * SEQ + s) * 256);
                f32x4 kv[16];
#pragma unroll
                for (int i = 0; i < 16; ++i) kv[i] = kp[i];
                float sc = 0.f;
#pragma unroll
                for (int h = 0; h < 8; ++h) {
                    float d = 0.f;
#pragma unroll
                    for (int i = 0; i < 16; ++i) { const f32x4 qv = *(const f32x4*)(qs + h * 64 + i * 4); d += kv[i][0] * qv[0] + kv[i][1] * qv[1] + kv[i][2] * qv[2] + kv[i][3] * qv[3]; }
                    sc += wv[h] * fmaxf(d, 0.f);
                }
                sk[s] = fkey(sc);
            }
        }
        wave_lds_sync();
        unsigned cur = 0u; int need = 1 << 30;
        if (n > 256) {
            for (int bit = 31; bit >= 0; --bit) {
                const unsigned cand = cur | (1u << bit); int cnt = 0;
                for (int s = lane; s < nr; s += 64) { const bool pr = (s < n) && (sk[s] >= cand); cnt += __popcll(__ballot(pr)); }
                if (cnt >= 256) cur = cand;
            }
            int cgt = 0;
            for (int s = lane; s < nr; s += 64) { const bool pr = (s < n) && (sk[s] > cur); cgt += __popcll(__ballot(pr)); }
            need = 256 - cgt;
        }
        int run_eq = 0, run_sel = 0; unsigned long long mybal = 0ull;
        for (int s = lane, c = 0; s < nr; s += 64, ++c) {
            const bool in = s < n; const unsigned k = in ? sk[s] : 0u;
            const bool gt = in && (k > cur), eq = in && (k == cur);
            const unsigned long long beq = __ballot(eq);
            const int rank = run_eq + __popcll(beq & lt_mask);
            const bool se = gt || (eq && rank < need);
            const unsigned long long bs = __ballot(se);
            const int pos = run_sel + __popcll(bs & lt_mask);
            if (se && pos < 256) sel[(size_t)q * 256 + pos] = s;
            run_eq += __popcll(beq); run_sel += __popcll(bs);
            if (lane == c) mybal = bs;
        }
        u32x2 mw; mw.x = (unsigned)mybal; mw.y = (unsigned)(mybal >> 32);
        *(u32x2*)(mask + (size_t)q * 128 + lane * 2) = mw;
        for (int j = run_sel + lane; j < 256; j += 64) sel[(size_t)q * 256 + j] = -1;
    }
}

__device__ __forceinline__ void phase_att_simple(int wv, bf16_t* proj, const int* sel, unsigned char* shm) {
    const int tid = opaque_tid(wv); const int wave = tid >> 6, lane = tid & 63, h = wave, kvh = h >> 2;
    float* qf = (float*)(shm + wave * 2560); float* pj = qf + 128; int* kj = (int*)(pj + 256);
    const float scale = 0.08838834764831845f;
    for (int q = blockIdx.x; q < SLAB; q += gridDim.x) {
        const int bl = q >> 12;
        wave_lds_sync();
        { const unsigned raw = *(const unsigned*)(proj + (size_t)q * NP + C_Q + h * 128 + 2 * lane); qf[2 * lane] = lo16(raw); qf[2 * lane + 1] = hi16(raw); }
        int keys[4];
#pragma unroll
        for (int i = 0; i < 4; ++i) { keys[i] = sel[(size_t)q * 256 + lane + 64 * i]; kj[lane + 64 * i] = keys[i]; }
        wave_lds_sync();
        float lg[4]; float mx = -INFINITY;
#pragma unroll
        for (int i = 0; i < 4; ++i) {
            lg[i] = -INFINITY;
            if (keys[i] >= 0) {
                const u32x4* kp = (const u32x4*)(proj + (size_t)(bl * SEQ + keys[i]) * NP + C_K + kvh * 128);
                float d = 0.f;
#pragma unroll
                for (int c = 0; c < 16; ++c) {
                    const u32x4 raw = kp[c]; const f32x4 q0 = *(const f32x4*)(qf + c * 8), q1 = *(const f32x4*)(qf + c * 8 + 4);
                    d += lo16(raw.x) * q0[0] + hi16(raw.x) * q0[1] + lo16(raw.y) * q0[2] + hi16(raw.y) * q0[3] + lo16(raw.z) * q1[0] + hi16(raw.z) * q1[1] + lo16(raw.w) * q1[2] + hi16(raw.w) * q1[3];
                }
                lg[i] = d * scale;
            }
            mx = fmaxf(mx, lg[i]);
        }
        mx = wave_max(mx);
        float sm = 0.f; float pe[4];
#pragma unroll
        for (int i = 0; i < 4; ++i) { pe[i] = (keys[i] >= 0) ? __expf(lg[i] - mx) : 0.f; sm += pe[i]; }
        sm = wave_sum(sm);
        const float inv = 1.0f / sm;
#pragma unroll
        for (int i = 0; i < 4; ++i) pj[lane + 64 * i] = pe[i] * inv;
        wave_lds_sync();
        float a0 = 0.f, a1 = 0.f;
        const bf16_t* vb = proj + (size_t)(bl * SEQ) * NP + C_V + kvh * 128 + 2 * lane;
        for (int j0 = 0; j0 < 256; j0 += 16) {
            if (kj[j0] < 0) break;
            unsigned raw[16]; float pv[16];
#pragma unroll
            for (int u = 0; u < 16; ++u) { const int key = max(kj[j0 + u], 0); pv[u] = pj[j0 + u]; raw[u] = *(const unsigned*)(vb + (size_t)key * NP); }
#pragma unroll
            for (int u = 0; u < 16; ++u) { a0 += pv[u] * lo16(raw[u]); a1 += pv[u] * hi16(raw[u]); }
        }
        *(unsigned*)(proj + (size_t)q * NP + C_Q + h * 128 + 2 * lane) = pack2(a0, a1);
    }
}


typedef short bf16x4 __attribute__((ext_vector_type(4)));
__device__ __forceinline__ void phase_idx(int wv, const bf16_t* proj, const float* misc, unsigned* mask, unsigned char* shm) {
    const int tid = opaque_tid(wv), wave = __builtin_amdgcn_readfirstlane(tid >> 6), lane = tid & 63, fr = lane & 15, fq = lane >> 4;
    int* cntbuf = (int*)shm;
    int* cbuf2 = cntbuf + 256;
    volatile int* tieflag = (volatile int*)(shm + 149760);
    for (int it = blockIdx.x; it < 256; it += gridDim.x) {
        for (int pass = 0; pass < 4; ++pass) {
            const int i = (pass == 0) ? it : (pass == 1) ? 511 - it : (pass == 2) ? 512 + it : 1023 - it;
            const int qt = 255 - (i >> 2), bl = i & 3;
            const int q0 = qt * 16, nch = (q0 + 15) / 64 + 1, t = q0 + fr;
            const size_t qrow = (size_t)bl * SEQ + q0 + fr;
            int lb = wave * 64 + fq * 4; asm volatile("" : "+v"(lb));
            u32x4 key[4][4];
            u32x4* klds = (u32x4*)(shm + 18688) + tid;
#define KGET(dst, ip, tt) do { if ((ip) < 4) dst = key[(ip) < 4 ? (ip) : 0][tt]; else dst = klds[(((ip) - 4) * 4 + (tt)) * 512]; } while (0)
            {
                float wv[8];
                { const f32x4 w0 = *(const f32x4*)(misc + qrow * 256 + 64), w1 = *(const f32x4*)(misc + qrow * 256 + 68);
#pragma unroll
                  for (int j = 0; j < 4; ++j) { wv[j] = w0[j]; wv[4 + j] = w1[j]; } }
#pragma unroll
                for (int u = 0; u < 2; ++u) { const int ch = tid + 512 * u, r = ch >> 6, cc = ch & 63;
                    *(u32x4*)(shm + 2048 + r * 1040 + cc * 16) = *(const u32x4*)(proj + ((size_t)bl * SEQ + q0 + r) * NP + C_QI + cc * 8); }
                if (tid == 0) tieflag[0] = 0;
                __syncthreads();
                const unsigned char* ql = shm + 2048 + fr * 1040 + fq * 16;
#pragma unroll
                for (int ip = 0; ip < 8; ++ip) {
                    int c = wave + 8 * ip; asm volatile("" : "+s"(c));
                    if (c < nch) {
                        const int trel = t - (c - wave) * 64 - lb;
                        const bf16_t* kp0 = proj + ((size_t)bl * SEQ + c * 64 + fr) * NP + C_MISC + fq * 8;
#pragma unroll
                        for (int tp = 0; tp < 2; ++tp) {
                            bf16x8 kf[2][2];
#pragma unroll
                            for (int u = 0; u < 2; ++u) { const bf16_t* kp = kp0 + (size_t)((tp * 2 + u) * 16) * NP; kf[u][0] = *(const bf16x8*)kp; kf[u][1] = *(const bf16x8*)(kp + 32); }
                            f32x4 sc[2];
                            sc[0] = (f32x4){0.f, 0.f, 0.f, 0.f}; sc[1] = (f32x4){0.f, 0.f, 0.f, 0.f};
#pragma unroll
                            for (int h = 0; h < 8; ++h) {
                                const bf16x8 q0f = *(const bf16x8*)(ql + h * 128), q1f = *(const bf16x8*)(ql + h * 128 + 64);
#pragma unroll
                                for (int u = 0; u < 2; ++u) {
                                    f32x4 d = __builtin_amdgcn_mfma_f32_16x16x32_bf16(kf[u][0], q0f, (f32x4){0.f, 0.f, 0.f, 0.f}, 0, 0, 0);
                                    d = __builtin_amdgcn_mfma_f32_16x16x32_bf16(kf[u][1], q1f, d, 0, 0, 0);
#pragma unroll
                                    for (int j = 0; j < 4; ++j) sc[u][j] += wv[h] * fmaxf(d[j], 0.f);
                                }
                                if ((h & 3) == 3) asm volatile("" ::: "memory");
                            }
#pragma unroll
                            for (int u = 0; u < 2; ++u) {
                                u32x4 kk;
#pragma unroll
                                for (int j = 0; j < 4; ++j) kk[j] = ((tp * 2 + u) * 16 + j <= trel) ? fkey(sc[u][j]) : 0u;
                                if (ip < 4) key[ip < 4 ? ip : 0][tp * 2 + u] = kk; else klds[((ip - 4) * 4 + tp * 2 + u) * 512] = kk;
                            }
                        }
                    } else if (ip < 4) {
#pragma unroll
                        for (int tt = 0; tt < 4; ++tt) key[ip < 4 ? ip : 0][tt] = (u32x4){0u, 0u, 0u, 0u};
                    }
                    asm volatile("" ::: "memory");
                }
            }
            __syncthreads();
            unsigned cur = 0u;
            bool rdone = (t + 1 <= 256);
            for (int bit = 31; bit >= 0; --bit) {
                if (__ballot(rdone) == ~0ull) break;
                const unsigned cand = cur | (1u << bit);
                int cnt = 0;
#pragma unroll
                for (int hp2 = 0; hp2 < 2; ++hp2) {
                    if (wave + 8 * (4 + 2 * hp2) < nch) {
                        u32x4 kl[8];
#pragma unroll
                        for (int q = 0; q < 8; ++q) kl[q] = klds[(hp2 * 8 + q) * 512];
                        const bool second = (wave + 8 * (5 + 2 * hp2) < nch);
#pragma unroll
                        for (int q = 0; q < 4; ++q)
#pragma unroll
                            for (int j = 0; j < 4; ++j) cnt += (kl[q][j] >= cand) ? 1 : 0;
                        if (second) {
#pragma unroll
                            for (int q = 4; q < 8; ++q)
#pragma unroll
                                for (int j = 0; j < 4; ++j) cnt += (kl[q][j] >= cand) ? 1 : 0;
                        }
                    }
                }
#pragma unroll
                for (int ip = 0; ip < 4; ++ip)
                    if (wave + 8 * ip < nch) {
#pragma unroll
                        for (int tt = 0; tt < 4; ++tt)
#pragma unroll
                            for (int j = 0; j < 4; ++j) cnt += (key[ip][tt][j] >= cand) ? 1 : 0;
                    }
                cnt += __shfl_xor(cnt, 16); cnt += __shfl_xor(cnt, 32);
                int* cb = cntbuf + (bit & 1) * 128;
                if (fq == 0) cb[fr * 8 + wave] = cnt;
                __syncthreads();
                const int4 a = *(const int4*)(cb + fr * 8), b = *(const int4*)(cb + fr * 8 + 4);
                const int tot = a.x + a.y + a.z + a.w + b.x + b.y + b.z + b.w;
                if (!rdone && tot >= 256) { cur = cand; if (tot == 256) rdone = true; }
            }
            int cg = 0, ce = 0;
#pragma unroll
            for (int ip = 0; ip < 8; ++ip)
                if (wave + 8 * ip < nch) {
#pragma unroll
                    for (int tt = 0; tt < 4; ++tt) { u32x4 kv; KGET(kv, ip, tt);
#pragma unroll
                        for (int j = 0; j < 4; ++j) { cg += (kv[j] > cur) ? 1 : 0; ce += (kv[j] == cur) ? 1 : 0; } }
                }
            cg += __shfl_xor(cg, 16); cg += __shfl_xor(cg, 32); ce += __shfl_xor(ce, 16); ce += __shfl_xor(ce, 32);
            if (fq == 0) { cbuf2[fr * 8 + wave] = cg; cbuf2[128 + fr * 8 + wave] = ce; }
            __syncthreads();
            int need, ceq;
            { const int4 a = *(const int4*)(cbuf2 + fr * 8), b = *(const int4*)(cbuf2 + fr * 8 + 4);
              need = 256 - (a.x + a.y + a.z + a.w + b.x + b.y + b.z + b.w);
              const int4 c4 = *(const int4*)(cbuf2 + 128 + fr * 8), d4 = *(const int4*)(cbuf2 + 128 + fr * 8 + 4);
              ceq = c4.x + c4.y + c4.z + c4.w + d4.x + d4.y + d4.z + d4.w; }
            const bool ties = (cur != 0u) && (ceq > need);
            unsigned J = 4095u;
            if (ties) tieflag[0] = 1;
            __syncthreads();
            if (tieflag[0] != 0) {
                unsigned Jt = 0u;
                for (int bit = 11; bit >= 0; --bit) {
                    const unsigned cand = Jt | (1u << bit);
                    const int crel = (int)cand - lb;
                    int cnt = 0;
#pragma unroll
                    for (int ip = 0; ip < 8; ++ip)
                        if (wave + 8 * ip < nch) {
#pragma unroll
                            for (int tt = 0; tt < 4; ++tt) { u32x4 kv; KGET(kv, ip, tt);
#pragma unroll
                                for (int j = 0; j < 4; ++j) cnt += (kv[j] == cur && (ip * 512 + tt * 16 + j) < crel) ? 1 : 0; }
                        }
                    cnt += __shfl_xor(cnt, 16); cnt += __shfl_xor(cnt, 32);
                    int* cb = cntbuf + (bit & 1) * 128;
                    if (fq == 0) cb[fr * 8 + wave] = cnt;
                    __syncthreads();
                    const int4 a = *(const int4*)(cb + fr * 8), b = *(const int4*)(cb + fr * 8 + 4);
                    const int tot = a.x + a.y + a.z + a.w + b.x + b.y + b.z + b.w;
                    if (tot < need) Jt = cand;
                }
                if (ties) J = Jt;
            }
#pragma unroll
            for (int ip = 0; ip < 8; ++ip) {
                const int c = wave + 8 * ip;
                if (c < nch) {
                    unsigned lo = 0u, hi = 0u;
                    const int jrel = (int)J - lb;
#pragma unroll
                    for (int tt = 0; tt < 4; ++tt) { u32x4 kv; KGET(kv, ip, tt);
#pragma unroll
                        for (int j = 0; j < 4; ++j) {
                            const unsigned k = kv[j];
                            const bool se = (k > cur) || (k == cur && cur != 0u && (ip * 512 + tt * 16 + j) <= jrel);
                            const unsigned b = se ? 1u : 0u;
                            if (tt < 2) lo |= b << (tt * 16 + j); else hi |= b << ((tt - 2) * 16 + j);
                        } }
                    lo <<= (lb & 15); hi <<= (lb & 15);
                    lo |= __shfl_xor(lo, 16); lo |= __shfl_xor(lo, 32); hi |= __shfl_xor(hi, 16); hi |= __shfl_xor(hi, 32);
                    if (fq == 0) { u32x2 mw; mw.x = lo; mw.y = hi; *(u32x2*)(mask + qrow * 128 + c * 2) = mw; }
                }
            }
            __syncthreads();
        }
    }
#undef KGET
}

__device__ __forceinline__ void phase_att(int wv, bf16_t* proj, const bf16_t* vt, const unsigned* mask, unsigned char* shm) {
    const int tid = opaque_tid(wv), wave = tid >> 6, lane = tid & 63, fr = lane & 15, fq = lane >> 4;
    const int qs = wave & 3, hp = wave >> 2;
    constexpr int KROW = 272, VROW = 272, KBYTES = 128 * KROW, VBYTES = 128 * VROW, BUF = KBYTES + VBYTES;
    const float sc2 = 0.08838834764831845f * 1.4426950408889634f;
    for (int it = blockIdx.x; it < 256; it += gridDim.x) {
        for (int pass = 0; pass < 2; ++pass) {
            const int i = (pass == 0) ? it : 511 - it;
            const int qb = 63 - (i >> 3), sub = i & 7, bl = sub >> 1, kvh = sub & 1, nkt = qb + 1;
            const size_t qrow = (size_t)bl * SEQ + qb * 64 + qs * 16 + fr;
            bf16x8 qf[2][4];
#pragma unroll
            for (int hh = 0; hh < 2; ++hh)
#pragma unroll
                for (int ks = 0; ks < 4; ++ks) qf[hh][ks] = *(const bf16x8*)(proj + qrow * NP + C_Q + (kvh * 4 + hp * 2 + hh) * 128 + ks * 32 + fq * 8);
            f32x4 o[2][8];
#pragma unroll
            for (int hh = 0; hh < 2; ++hh)
#pragma unroll
                for (int dt = 0; dt < 8; ++dt) o[hh][dt] = (f32x4){0.f, 0.f, 0.f, 0.f};
            float mrow[2] = {-1e30f, -1e30f}, lrow[2] = {0.f, 0.f};
            const int sr0 = tid >> 4, sc = tid & 15;
            const bf16_t* kg = proj + ((size_t)bl * SEQ + sr0) * NP + C_K + kvh * 128 + sc * 8;
            const bf16_t* vg = vt + ((size_t)(bl * 2 + kvh) * 128 + sr0) * SEQ + sc * 8;
            const int klds = sr0 * KROW + sc * 16, vlds = KBYTES + sr0 * VROW + sc * 16;
            const int nst = (nkt + 1) >> 1;
            u32x4 kreg[4], vreg[4];
            __syncthreads();
#pragma unroll
            for (int u = 0; u < 4; ++u) { kreg[u] = *(const u32x4*)(kg + (size_t)(32 * u) * NP); vreg[u] = *(const u32x4*)(vg + (size_t)(32 * u) * SEQ); }
#pragma unroll
            for (int u = 0; u < 4; ++u) { *(u32x4*)(shm + klds + 32 * u * KROW) = kreg[u]; *(u32x4*)(shm + vlds + 32 * u * VROW) = vreg[u]; }
            __syncthreads();
            u32x4 mknext = *(const u32x4*)(mask + qrow * 128);
            for (int st = 0; st < nst; ++st) {
                const unsigned char* sbuf = shm + (st & 1) * BUF;
                const bool more = (st + 1 < nst);
                if (more) {
                    const bf16_t* kg2 = kg + (size_t)(st + 1) * 128 * NP; const bf16_t* vg2 = vg + (st + 1) * 128;
#pragma unroll
                    for (int u = 0; u < 4; ++u) { kreg[u] = *(const u32x4*)(kg2 + (size_t)(32 * u) * NP); vreg[u] = *(const u32x4*)(vg2 + (size_t)(32 * u) * SEQ); }
                }
                const u32x4 mk4 = mknext;
                if (more) mknext = *(const u32x4*)(mask + qrow * 128 + (st + 1) * 4);
#pragma unroll
                for (int h2 = 0; h2 < 2; ++h2) {
                if (2 * st + h2 >= nkt) break;
                const unsigned char* buf = sbuf + h2 * 64 * KROW;
                const unsigned char* vbuf = sbuf + KBYTES + h2 * 128;
                const unsigned mlo = (h2 ? mk4.z : mk4.x) >> (fq * 4), mhi = (h2 ? mk4.w : mk4.y) >> (fq * 4);
                f32x4 s[2][4];
#pragma unroll
                for (int nt = 0; nt < 4; ++nt) {
                    s[0][nt] = (f32x4){0.f, 0.f, 0.f, 0.f}; s[1][nt] = (f32x4){0.f, 0.f, 0.f, 0.f};
#pragma unroll
                    for (int ks = 0; ks < 4; ++ks) {
                        const bf16x8 kf = *(const bf16x8*)(buf + (nt * 16 + fr) * KROW + (ks * 32 + fq * 8) * 2);
                        s[0][nt] = __builtin_amdgcn_mfma_f32_16x16x32_bf16(kf, qf[0][ks], s[0][nt], 0, 0, 0);
                        s[1][nt] = __builtin_amdgcn_mfma_f32_16x16x32_bf16(kf, qf[1][ks], s[1][nt], 0, 0, 0);
                    }
                }
                bf16x8 pf[2][2];
                f32x4 bias[4];
#pragma unroll
                for (int nt = 0; nt < 4; ++nt)
#pragma unroll
                    for (int j = 0; j < 4; ++j) { const unsigned w = (nt < 2) ? mlo : mhi; bias[nt][j] = ((w >> ((nt & 1) * 16 + j)) & 1u) ? 0.f : -INFINITY; }
#pragma unroll
                for (int hh = 0; hh < 2; ++hh) {
                    float mx = -INFINITY;
#pragma unroll
                    for (int nt = 0; nt < 4; ++nt)
#pragma unroll
                        for (int j = 0; j < 4; ++j) { const float tv = __builtin_fmaf(s[hh][nt][j], sc2, bias[nt][j]); s[hh][nt][j] = tv; mx = fmaxf(mx, tv); }
                    mx = fmaxf(mx, __shfl_xor(mx, 16)); mx = fmaxf(mx, __shfl_xor(mx, 32));
                    const float mnew = fmaxf(mrow[hh], mx);
                    const float alpha = __builtin_amdgcn_exp2f(mrow[hh] - mnew);
                    mrow[hh] = mnew;
                    float ls = 0.f;
#pragma unroll
                    for (int nt = 0; nt < 4; ++nt)
#pragma unroll
                        for (int j = 0; j < 4; ++j) { const float pv = __builtin_amdgcn_exp2f(s[hh][nt][j] - mnew); s[hh][nt][j] = pv; ls += pv; }
                    lrow[hh] = lrow[hh] * alpha + ls;
                    if (__ballot(alpha != 1.0f) != 0ull) {
#pragma unroll
                        for (int dt = 0; dt < 8; ++dt) o[hh][dt] *= alpha;
                    }
#pragma unroll
                    for (int kk = 0; kk < 2; ++kk) {
                        u32x4 pk;
                        pk.x = pg8::cvt_pk_bf16(s[hh][2 * kk][0], s[hh][2 * kk][1]); pk.y = pg8::cvt_pk_bf16(s[hh][2 * kk][2], s[hh][2 * kk][3]);
                        pk.z = pg8::cvt_pk_bf16(s[hh][2 * kk + 1][0], s[hh][2 * kk + 1][1]); pk.w = pg8::cvt_pk_bf16(s[hh][2 * kk + 1][2], s[hh][2 * kk + 1][3]);
                        pf[hh][kk] = __builtin_bit_cast(bf16x8, pk);
                    }
                }
#pragma unroll
                for (int kk = 0; kk < 2; ++kk)
#pragma unroll
                    for (int dt = 0; dt < 8; ++dt) {
                        const unsigned char* vp = vbuf + (dt * 16 + fr) * VROW + (kk * 32 + fq * 4) * 2;
                        const bf16x4 v0 = *(const bf16x4*)vp, v1 = *(const bf16x4*)(vp + 32);
                        const bf16x8 vf = __builtin_shufflevector(v0, v1, 0, 1, 2, 3, 4, 5, 6, 7);
                        o[0][dt] = __builtin_amdgcn_mfma_f32_16x16x32_bf16(vf, pf[0][kk], o[0][dt], 0, 0, 0);
                        o[1][dt] = __builtin_amdgcn_mfma_f32_16x16x32_bf16(vf, pf[1][kk], o[1][dt], 0, 0, 0);
                    }
                }
                if (more) {
                    unsigned char* nb = shm + ((st + 1) & 1) * BUF;
#pragma unroll
                    for (int u = 0; u < 4; ++u) { *(u32x4*)(nb + klds + 32 * u * KROW) = kreg[u]; *(u32x4*)(nb + vlds + 32 * u * VROW) = vreg[u]; }
                }
                __syncthreads();
            }
#pragma unroll
            for (int hh = 0; hh < 2; ++hh) {
                float lt = lrow[hh]; lt += __shfl_xor(lt, 16); lt += __shfl_xor(lt, 32);
                const float inv = 1.0f / lt;
                bf16_t* op = proj + qrow * NP + C_Q + (kvh * 4 + hp * 2 + hh) * 128 + fq * 4;
#pragma unroll
                for (int dt = 0; dt < 8; ++dt) {
                    u32x2 w; w.x = pg8::cvt_pk_bf16(o[hh][dt][0] * inv, o[hh][dt][1] * inv); w.y = pg8::cvt_pk_bf16(o[hh][dt][2] * inv, o[hh][dt][3] * inv);
                    *(u32x2*)(op + dt * 16) = w;
                }
            }
        }
    }
}

__device__ __forceinline__ void phase_ssd_simple(int wv, KParams p, int l, bf16_t* proj, const float* misc, float* ssq, unsigned char* shm) {
    const int tid = opaque_tid(wv), lane = tid & 63;
    float* xs = (float*)shm; float* Bs = xs + 64 * 64; float* Cs = Bs + 64 * 128; float* dts = Cs + 64 * 128; float* decs = dts + 64; float* ybuf = decs + 64;
    const float* cw = p->ssd_conv_w + (size_t)l * 4 * 3072; const float* cb = p->ssd_conv_b + (size_t)l * 3072;
    for (int item = blockIdx.x; item < 128; item += gridDim.x) {
        const int bl = item >> 5, head = item & 31, g = head >> 3;
        const float Aneg = -__expf(p->ssd_a_log[l * 32 + head]), dtb = p->ssd_dt_bias[l * 32 + head], Dsk = p->ssd_d[l * 32 + head];
        const int pp = tid >> 3, ng = tid & 7;
        float hs[16];
#pragma unroll
        for (int k = 0; k < 16; ++k) hs[k] = 0.f;
        for (int c = 0; c < 64; ++c) {
            const int t0 = c * 64;
            __syncthreads();
            for (int i = 0; i < 40; ++i) {
                const int idx = tid + 512 * i, tok = idx / 320, cc = idx - tok * 320;
                int ch; float* dstp;
                if (cc < 64) { ch = head * 64 + cc; dstp = xs + tok * 64 + cc; }
                else if (cc < 192) { ch = 2048 + g * 128 + (cc - 64); dstp = Bs + tok * 128 + (cc - 64); }
                else { ch = 2560 + g * 128 + (cc - 192); dstp = Cs + tok * 128 + (cc - 192); }
                float a = cb[ch];
#pragma unroll
                for (int j = 0; j < 4; ++j) { const int tt = t0 + tok - 3 + j; if (tt >= 0) a += cw[j * 3072 + ch] * bf2f(proj[(size_t)(bl * SEQ + tt) * NP + C_XBC + ch]); }
                *dstp = silu_f(a);
            }
            if (tid < 64) {
                const float v = misc[(size_t)(bl * SEQ + t0 + tid) * 256 + 72 + head] + dtb;
                const float dt = (v > 20.f) ? v : log1pf(__expf(v));
                dts[tid] = dt; decs[tid] = __expf(dt * Aneg);
            }
            __syncthreads();
            for (int tok = 0; tok < 64; ++tok) {
                const float xv = xs[tok * 64 + pp], dt = dts[tok], dec = decs[tok], xdt = xv * dt;
                float y = 0.f;
#pragma unroll
                for (int k4 = 0; k4 < 4; ++k4) {
                    const f32x4 b4 = *(const f32x4*)(Bs + tok * 128 + ng * 16 + k4 * 4), c4 = *(const f32x4*)(Cs + tok * 128 + ng * 16 + k4 * 4);
#pragma unroll
                    for (int j = 0; j < 4; ++j) { float& hh = hs[k4 * 4 + j]; hh = hh * dec + xdt * b4[j]; y += c4[j] * hh; }
                }
                y += __shfl_xor(y, 1); y += __shfl_xor(y, 2); y += __shfl_xor(y, 4);
                if (ng == 0) ybuf[tok * 65 + pp] = y + Dsk * xv;
            }
            __syncthreads();
#pragma unroll
            for (int i = 0; i < 8; ++i) {
                const int idx = tid + 512 * i, tok = idx >> 6, p2 = idx & 63;
                bf16_t* zp = proj + (size_t)(bl * SEQ + t0 + tok) * NP + C_Z + head * 64 + p2;
                const float yg = ybuf[tok * 65 + p2] * silu_f(bf2f(*zp));
                *zp = f2bf(yg);
                const float s2 = wave_sum(yg * yg);
                if (lane == 0) ssq[(size_t)(bl * SEQ + t0 + tok) * 32 + head] = s2;
            }
        }
    }
}


__device__ __forceinline__ void phase_bcconv(int wv, KParams p, int l, const bf16_t* proj, bf16_t* bc, bf16_t* btg) {
    const int tid = opaque_tid(wv);
    const float* cw = p->ssd_conv_w + (size_t)l * 4 * 3072 + 2048; const float* cb = p->ssd_conv_b + (size_t)l * 3072 + 2048;
    for (int idx = blockIdx.x * 512 + tid; idx < 128 * (SLAB / 16); idx += gridDim.x * 512) {
        const int run = idx >> 7, c = (idx & 127) * 8, t0 = run * 16;
        float wt[4][8], bias[8];
#pragma unroll
        for (int e = 0; e < 8; ++e) { bias[e] = cb[c + e];
#pragma unroll
            for (int j = 0; j < 4; ++j) wt[j][e] = cw[j * 3072 + c + e]; }
        const bf16_t* xb = proj + (size_t)t0 * NP + C_XBC + 2048 + c;
        u32x4 r0 = (u32x4){0u, 0u, 0u, 0u}, r1 = r0, r2 = r0;
        if ((t0 & (SEQ - 1)) != 0) { r0 = *(const u32x4*)(xb - 3 * (ptrdiff_t)NP); r1 = *(const u32x4*)(xb - 2 * (ptrdiff_t)NP); r2 = *(const u32x4*)(xb - (ptrdiff_t)NP); }
        unsigned W[16][4];
#pragma unroll
        for (int tb = 0; tb < 16; tb += 4) {
            u32x4 rn[4];
#pragma unroll
            for (int u = 0; u < 4; ++u) rn[u] = *(const u32x4*)(xb + (size_t)(tb + u) * NP);
#pragma unroll
            for (int u = 0; u < 4; ++u) {
                const unsigned a0[4] = {r0.x, r0.y, r0.z, r0.w}, a1[4] = {r1.x, r1.y, r1.z, r1.w}, a2[4] = {r2.x, r2.y, r2.z, r2.w}, a3[4] = {rn[u].x, rn[u].y, rn[u].z, rn[u].w};
#pragma unroll
                for (int e = 0; e < 4; ++e) {
                    const float lo = bias[2 * e] + wt[0][2 * e] * lo16(a0[e]) + wt[1][2 * e] * lo16(a1[e]) + wt[2][2 * e] * lo16(a2[e]) + wt[3][2 * e] * lo16(a3[e]);
                    const float hi = bias[2 * e + 1] + wt[0][2 * e + 1] * hi16(a0[e]) + wt[1][2 * e + 1] * hi16(a1[e]) + wt[2][2 * e + 1] * hi16(a2[e]) + wt[3][2 * e + 1] * hi16(a3[e]);
                    W[tb + u][e] = pack2(silu_f(lo), silu_f(hi));
                }
                u32x4 o; o.x = W[tb + u][0]; o.y = W[tb + u][1]; o.z = W[tb + u][2]; o.w = W[tb + u][3];
                *(u32x4*)(bc + (size_t)(t0 + tb + u) * 1024 + c) = o;
                r0 = r1; r1 = r2; r2 = rn[u];
            }
        }
        if (c < 512) {
            bf16_t* tp = btg + ((size_t)((t0 >> 12) * 512 + c)) * SEQ + (t0 & (SEQ - 1));
#pragma unroll
            for (int e = 0; e < 4; ++e) {
                u32x4 lo0, lo1, hi0, hi1;
                lo0.x = (W[0][e] & 0xffffu) | (W[1][e] << 16); lo0.y = (W[2][e] & 0xffffu) | (W[3][e] << 16); lo0.z = (W[4][e] & 0xffffu) | (W[5][e] << 16); lo0.w = (W[6][e] & 0xffffu) | (W[7][e] << 16);
                lo1.x = (W[8][e] & 0xffffu) | (W[9][e] << 16); lo1.y = (W[10][e] & 0xffffu) | (W[11][e] << 16); lo1.z = (W[12][e] & 0xffffu) | (W[13][e] << 16); lo1.w = (W[14][e] & 0xffffu) | (W[15][e] << 16);
                hi0.x = (W[0][e] >> 16) | (W[1][e] & 0xffff0000u); hi0.y = (W[2][e] >> 16) | (W[3][e] & 0xffff0000u); hi0.z = (W[4][e] >> 16) | (W[5][e] & 0xffff0000u); hi0.w = (W[6][e] >> 16) | (W[7][e] & 0xffff0000u);
                hi1.x = (W[8][e] >> 16) | (W[9][e] & 0xffff0000u); hi1.y = (W[10][e] >> 16) | (W[11][e] & 0xffff0000u); hi1.z = (W[12][e] >> 16) | (W[13][e] & 0xffff0000u); hi1.w = (W[14][e] >> 16) | (W[15][e] & 0xffff0000u);
                *(u32x4*)(tp + (size_t)(2 * e) * SEQ) = lo0; *(u32x4*)(tp + (size_t)(2 * e) * SEQ + 8) = lo1;
                *(u32x4*)(tp + (size_t)(2 * e + 1) * SEQ) = hi0; *(u32x4*)(tp + (size_t)(2 * e + 1) * SEQ + 8) = hi1;
            }
        }
    }
}

#define SSD_SCAN(cc) do { float* dts_ = dbase + ((cc) & 1) * 384; float* acs_ = dts_ + 128; float* wdec_ = acs_ + 128; \
                const float v0 = dtr0 + dtb, v1 = dtr1 + dtb; \
                const float dt0 = (v0 > 20.f) ? v0 : log1pf(__expf(v0)), dt1 = (v1 > 20.f) ? v1 : log1pf(__expf(v1)); \
                const float a0 = dt0 * Aneg, a1 = dt1 * Aneg; \
                float sc = a0 + a1; \
                _Pragma("unroll") for (int o = 1; o < 64; o <<= 1) { const float tv = __shfl_up(sc, o); if (lane >= o) sc += tv; } \
                const float atot = __shfl(sc, 63); \
                dts_[2 * lane] = dt0; dts_[2 * lane + 1] = dt1; acs_[2 * lane] = sc - a1; acs_[2 * lane + 1] = sc; \
                wdec_[2 * lane] = dt0 * __expf(atot - (sc - a1)); wdec_[2 * lane + 1] = dt1 * __expf(atot - sc); } while (0)
__device__ __forceinline__ void phase_ssd(int wv, KParams p, int l, bf16_t* proj, const float* misc, const bf16_t* bc, const bf16_t* btg, float* ssq, unsigned char* shm, unsigned long long& tacc, unsigned long long& tst) {
    const int tid = opaque_tid(wv), wave = __builtin_amdgcn_readfirstlane(tid >> 6), lane = tid & 63, fr = lane & 15, fq = lane >> 4;
    constexpr int ROW = 272;
    unsigned char* Cr = shm; unsigned char* Br = Cr + 128 * ROW; unsigned char* BT = Br + 128 * ROW;
    unsigned char* XT = BT + 128 * ROW; unsigned char* Hb = XT + 32 * ROW;
    float* wtab = (float*)(Hb + 32 * ROW) + 768;
    float* dbase = (float*)(Hb + 32 * ROW);
    const float* cw = p->ssd_conv_w + (size_t)l * 4 * 3072; const float* cb = p->ssd_conv_b + (size_t)l * 3072;
    for (int item = blockIdx.x; item < 256; item += gridDim.x) {
        const int pr = (item & 7) * 2 + ((item >> 3) >> 4), wi = (item >> 3) & 15;
        const int bl = pr >> 2, g = pr & 3, head = g * 8 + (wi >> 1), ph = wi & 1;
        const float Aneg = -__expf(p->ssd_a_log[l * 32 + head]), dtb = p->ssd_dt_bias[l * 32 + head], Dsk = p->ssd_d[l * 32 + head];
        const int lx = tid >> 2, cgx = tid & 3, chx = head * 64 + ph * 32 + cgx * 8;
        const int sr = tid >> 4, sc16 = tid & 15;
        f32x4 Hacc[2][2];
#pragma unroll
        for (int q2 = 0; q2 < 2; ++q2) { Hacc[q2][0] = (f32x4){0.f, 0.f, 0.f, 0.f}; Hacc[q2][1] = (f32x4){0.f, 0.f, 0.f, 0.f}; }
        __syncthreads();
        for (int i = tid; i < 32 * ROW / 4; i += 512) ((unsigned*)Hb)[i] = 0u;
        if (tid < 160) { const int cgi = tid / 40, r = tid - cgi * 40, j = r >> 3, chn = head * 64 + ph * 32 + cgi * 8 + (r & 7); wtab[tid] = (j == 0) ? cb[chn] : cw[(j - 1) * 3072 + chn]; }
        __syncthreads();
        u32x4 xr[4], br[12]; float dtr0 = 0.f, dtr1 = 0.f;
        {
            const char* gb = (const char*)(proj + ((ptrdiff_t)bl * SEQ - 3) * NP + C_XBC);
            unsigned vo = (unsigned)((lx * NP + chx) * 2); asm volatile("" : "+v"(vo));
#pragma unroll
            for (int j = 0; j < 4; ++j) { xr[j] = (u32x4){0u, 0u, 0u, 0u}; if (lx - 3 + j >= 0) xr[j] = *(const u32x4*)(gb + (vo + (unsigned)(j * NP * 2))); }
            const char* hb2 = (const char*)(bc + ((size_t)bl * SEQ) * 1024);
            unsigned vb = (unsigned)((sr * 1024 + g * 128 + sc16 * 8) * 2); asm volatile("" : "+v"(vb));
            const char* tb2 = (const char*)(btg + ((size_t)(bl * 512 + g * 128)) * SEQ);
            unsigned vt2 = (unsigned)((sr * SEQ + sc16 * 8) * 2); asm volatile("" : "+v"(vt2));
#pragma unroll
            for (int u = 0; u < 4; ++u) { br[u] = *(const u32x4*)(hb2 + (vb + (unsigned)(u * 32 * 1024 * 2))); br[4 + u] = *(const u32x4*)(hb2 + (vb + (unsigned)(u * 32 * 1024 * 2 + 1024)));
                br[8 + u] = *(const u32x4*)(tb2 + (vt2 + (unsigned)(u * 32 * SEQ * 2))); }
            if (wave == 0) { const float* mp = misc + ((size_t)bl * SEQ + 2 * lane) * 256 + 72 + head; dtr0 = mp[0]; dtr1 = mp[256];
                SSD_SCAN(0);
                dtr0 = mp[128 * 256]; dtr1 = mp[128 * 256 + 256]; }
        }
        for (int c = 0; c < 32; ++c) {
            TIC(12);
            const int t0 = c * 128;
            const size_t rbase = (size_t)bl * SEQ + t0;
            const float* dts = dbase + (c & 1) * 384; const float* acs = dts + 128; const float* wdec = acs + 128;
            {
                float wt[4][8], bias[8];
                { const float* wl = wtab + cgx * 40;
                  const f32x4 b0 = *(const f32x4*)wl, b1 = *(const f32x4*)(wl + 4);
#pragma unroll
                  for (int e = 0; e < 4; ++e) { bias[e] = b0[e]; bias[4 + e] = b1[e]; }
#pragma unroll
                  for (int j = 0; j < 4; ++j) { const f32x4 w0 = *(const f32x4*)(wl + 8 + j * 8), w1 = *(const f32x4*)(wl + 12 + j * 8);
#pragma unroll
                      for (int e = 0; e < 4; ++e) { wt[j][e] = w0[e]; wt[j][4 + e] = w1[e]; } } }
                const unsigned a0[4] = {xr[0].x, xr[0].y, xr[0].z, xr[0].w}, a1[4] = {xr[1].x, xr[1].y, xr[1].z, xr[1].w}, a2[4] = {xr[2].x, xr[2].y, xr[2].z, xr[2].w}, a3[4] = {xr[3].x, xr[3].y, xr[3].z, xr[3].w};
                unsigned char* xp = XT + (cgx * 8) * ROW + lx * 2;
#pragma unroll
                for (int e = 0; e < 4; ++e) {
                    const float lo = bias[2 * e] + wt[0][2 * e] * lo16(a0[e]) + wt[1][2 * e] * lo16(a1[e]) + wt[2][2 * e] * lo16(a2[e]) + wt[3][2 * e] * lo16(a3[e]);
                    const float hi = bias[2 * e + 1] + wt[0][2 * e + 1] * hi16(a0[e]) + wt[1][2 * e + 1] * hi16(a1[e]) + wt[2][2 * e + 1] * hi16(a2[e]) + wt[3][2 * e + 1] * hi16(a3[e]);
                    *(bf16_t*)(xp + (2 * e) * ROW) = f2bf(silu_f(lo)); *(bf16_t*)(xp + (2 * e + 1) * ROW) = f2bf(silu_f(hi));
                }
            }
            {
#pragma unroll
                for (int u = 0; u < 4; ++u) {
                    *(u32x4*)(Br + (sr + 32 * u) * ROW + sc16 * 16) = br[u];
                    *(u32x4*)(Cr + (sr + 32 * u) * ROW + sc16 * 16) = br[4 + u];
                    *(u32x4*)(BT + (sr + 32 * u) * ROW + sc16 * 16) = br[8 + u];
                }
            }
            __syncthreads(); TOC(12); TIC(11);
            {
                const size_t rnext = rbase + ((c + 1 < 32) ? 128 : 0);
                const char* gb = (const char*)(proj + ((ptrdiff_t)rnext - 3) * NP + C_XBC);
                unsigned vo = (unsigned)((lx * NP + chx) * 2); asm volatile("" : "+v"(vo));
#pragma unroll
                for (int j = 0; j < 4; ++j) xr[j] = *(const u32x4*)(gb + (vo + (unsigned)(j * NP * 2)));
                const char* hb2 = (const char*)(bc + rnext * 1024);
                unsigned vb = (unsigned)((sr * 1024 + g * 128 + sc16 * 8) * 2); asm volatile("" : "+v"(vb));
                const char* tb2 = (const char*)(btg + ((size_t)(bl * 512 + g * 128)) * SEQ + (rnext - (size_t)bl * SEQ));
                unsigned vt2 = (unsigned)((sr * SEQ + sc16 * 8) * 2); asm volatile("" : "+v"(vt2));
#pragma unroll
                for (int u = 0; u < 4; ++u) { br[u] = *(const u32x4*)(hb2 + (vb + (unsigned)(u * 32 * 1024 * 2))); br[4 + u] = *(const u32x4*)(hb2 + (vb + (unsigned)(u * 32 * 1024 * 2 + 1024)));
                    br[8 + u] = *(const u32x4*)(tb2 + (vt2 + (unsigned)(u * 32 * SEQ * 2))); }
            }
            {
                const int lt = (wave < 4) ? wave : 11 - wave;
                bf16_t* zp = proj + (rbase + lt * 16 + fr) * NP + C_Z + head * 64 + ph * 32 + fq * 4;
                const u32x2 zr0 = *(const u32x2*)zp, zr1 = *(const u32x2*)(zp + 16);
                const float acs_l = acs[lt * 16 + fr];
                bf16x8 cf[4];
#pragma unroll
                for (int ks = 0; ks < 4; ++ks) cf[ks] = *(const bf16x8*)(Cr + (lt * 16 + fr) * ROW + (ks * 32 + fq * 8) * 2);
                f32x4 yacc[2];
                {
                    bf16x8 hf[2][4];
#pragma unroll
                    for (int pt = 0; pt < 2; ++pt)
#pragma unroll
                        for (int ks = 0; ks < 4; ++ks) hf[pt][ks] = *(const bf16x8*)(Hb + (pt * 16 + fr) * ROW + (ks * 32 + fq * 8) * 2);
                    const float el = __expf(acs_l);
#pragma unroll
                    for (int pt = 0; pt < 2; ++pt) {
                        yacc[pt] = (f32x4){0.f, 0.f, 0.f, 0.f};
#pragma unroll
                        for (int ks = 0; ks < 4; ++ks) yacc[pt] = __builtin_amdgcn_mfma_f32_16x16x32_bf16(hf[pt][ks], cf[ks], yacc[pt], 0, 0, 0);
                        yacc[pt] *= el;
                    }
                    __builtin_amdgcn_sched_group_barrier(0x100, 12, 0); __builtin_amdgcn_sched_group_barrier(0x008, 8, 0);
                }
                const int lloc = fr - fq * 4;
                f32x4 cbt[8];
#pragma unroll
                for (int kk = 0; kk < 4; ++kk) {
                    cbt[2 * kk] = (f32x4){0.f, 0.f, 0.f, 0.f}; cbt[2 * kk + 1] = (f32x4){0.f, 0.f, 0.f, 0.f};
                    if (2 * kk <= lt) {
                        bf16x8 bfr[2][4];
#pragma unroll
                        for (int h2 = 0; h2 < 2; ++h2)
#pragma unroll
                            for (int ks = 0; ks < 4; ++ks) bfr[h2][ks] = *(const bf16x8*)(Br + ((2 * kk + h2) * 16 + fr) * ROW + (ks * 32 + fq * 8) * 2);
#pragma unroll
                        for (int ks = 0; ks < 4; ++ks) {
                            cbt[2 * kk] = __builtin_amdgcn_mfma_f32_16x16x32_bf16(bfr[0][ks], cf[ks], cbt[2 * kk], 0, 0, 0);
                            cbt[2 * kk + 1] = __builtin_amdgcn_mfma_f32_16x16x32_bf16(bfr[1][ks], cf[ks], cbt[2 * kk + 1], 0, 0, 0);
                        }
                        __builtin_amdgcn_sched_group_barrier(0x100, 8, 0); __builtin_amdgcn_sched_group_barrier(0x008, 8, 0);
                    }
                }
                unsigned mp[8][2];
#pragma unroll
                for (int st = 0; st < 8; ++st) {
                    mp[st][0] = 0u; mp[st][1] = 0u;
                    if (st <= lt) {
                        const f32x4 av = *(const f32x4*)(acs + st * 16 + fq * 4), dv = *(const f32x4*)(dts + st * 16 + fq * 4);
                        float mv[4];
#pragma unroll
                        for (int r = 0; r < 4; ++r) {
                            const int dl = (lt - st) * 16 + lloc - r;
                            float m = (dl >= 0) ? cbt[st][r] * __expf(acs_l - av[r]) * dv[r] : 0.f;
                            if (dl == 0) m += Dsk;
                            mv[r] = m;
                        }
                        mp[st][0] = pg8::cvt_pk_bf16(mv[0], mv[1]); mp[st][1] = pg8::cvt_pk_bf16(mv[2], mv[3]);
                    }
                }
#pragma unroll
                for (int kk = 0; kk < 4; ++kk) {
                    if (2 * kk <= lt) {
                        u32x4 pk; pk.x = mp[2 * kk][0]; pk.y = mp[2 * kk][1]; pk.z = mp[2 * kk + 1][0]; pk.w = mp[2 * kk + 1][1];
                        const bf16x8 pf = __builtin_bit_cast(bf16x8, pk);
#pragma unroll
                        for (int pt = 0; pt < 2; ++pt) {
                            const unsigned char* xp = XT + (pt * 16 + fr) * ROW + (kk * 32 + fq * 4) * 2;
                            const bf16x4 v0 = *(const bf16x4*)xp, v1 = *(const bf16x4*)(xp + 32);
                            const bf16x8 xf = __builtin_shufflevector(v0, v1, 0, 1, 2, 3, 4, 5, 6, 7);
                            yacc[pt] = __builtin_amdgcn_mfma_f32_16x16x32_bf16(xf, pf, yacc[pt], 0, 0, 0);
                        }
                    }
                }
                float sq = 0.f;
#pragma unroll
                for (int pt = 0; pt < 2; ++pt) {
                    const u32x2 zr = pt ? zr1 : zr0;
                    const float y0 = yacc[pt][0] * silu_f(lo16(zr.x)), y1 = yacc[pt][1] * silu_f(hi16(zr.x)), y2 = yacc[pt][2] * silu_f(lo16(zr.y)), y3 = yacc[pt][3] * silu_f(hi16(zr.y));
                    sq += y0 * y0 + y1 * y1 + y2 * y2 + y3 * y3;
                    u32x2 w; w.x = pg8::cvt_pk_bf16(y0, y1); w.y = pg8::cvt_pk_bf16(y2, y3);
                    *(u32x2*)(zp + pt * 16) = w;
                }
                sq += __shfl_xor(sq, 16); sq += __shfl_xor(sq, 32);
                if (fq == 0) ssq[(rbase + lt * 16 + fr) * 64 + head * 2 + ph] = sq;
                if (wave < 4) {
                    const float dec = __expf(acs[127]);
#pragma unroll
                    for (int q2 = 0; q2 < 2; ++q2) { Hacc[q2][0] *= dec; Hacc[q2][1] *= dec; }
#pragma unroll
                    for (int ks = 0; ks < 4; ++ks) {
                        const f32x4 w0 = *(const f32x4*)(wdec + ks * 32 + fq * 8), w1 = *(const f32x4*)(wdec + ks * 32 + fq * 8 + 4);
                        bf16x8 xw[2];
#pragma unroll
                        for (int pt = 0; pt < 2; ++pt) {
                            const u32x4 raw = *(const u32x4*)(XT + (pt * 16 + fr) * ROW + (ks * 32 + fq * 8) * 2);
                            u32x4 sc4;
                            sc4.x = pg8::cvt_pk_bf16(lo16(raw.x) * w0[0], hi16(raw.x) * w0[1]); sc4.y = pg8::cvt_pk_bf16(lo16(raw.y) * w0[2], hi16(raw.y) * w0[3]);
                            sc4.z = pg8::cvt_pk_bf16(lo16(raw.z) * w1[0], hi16(raw.z) * w1[1]); sc4.w = pg8::cvt_pk_bf16(lo16(raw.w) * w1[2], hi16(raw.w) * w1[3]);
                            xw[pt] = __builtin_bit_cast(bf16x8, sc4);
                        }
#pragma unroll
                        for (int q2 = 0; q2 < 2; ++q2) {
                            const bf16x8 btf = *(const bf16x8*)(BT + ((wave * 2 + q2) * 16 + fr) * ROW + (ks * 32 + fq * 8) * 2);
                            Hacc[q2][0] = __builtin_amdgcn_mfma_f32_16x16x32_bf16(xw[0], btf, Hacc[q2][0], 0, 0, 0);
                            Hacc[q2][1] = __builtin_amdgcn_mfma_f32_16x16x32_bf16(xw[1], btf, Hacc[q2][1], 0, 0, 0);
                        }
                    }
                }
            }
            TOC(11); TIC(13);
            if (wave == 0 && c + 1 < 32) {
                SSD_SCAN(c + 1);
                if (c + 2 < 32) { const float* mp = misc + (rbase + 256 + 2 * lane) * 256 + 72 + head; dtr0 = mp[0]; dtr1 = mp[256]; }
            }
            __syncthreads();
            if (wave < 4) {
#pragma unroll
                for (int q2 = 0; q2 < 2; ++q2)
#pragma unroll
                    for (int pt = 0; pt < 2; ++pt)
#pragma unroll
                        for (int r = 0; r < 4; ++r) *(bf16_t*)(Hb + (pt * 16 + fq * 4 + r) * ROW + ((wave * 2 + q2) * 16 + fr) * 2) = f2bf(Hacc[q2][pt][r]);
            }
            TOC(13);
        }
    }
}

#undef SSD_SCAN
__device__ __forceinline__ void phase_gtab(int wv, const float* ssq, float* gtab) {
    const int tid = opaque_tid(wv);
    pg8::StaticOrder S; S.init(SLAB, 1024, (int)gridDim.x, (int)blockIdx.x);
    pg8::Unit u;
    for (int ui = 0; ui < 4 && S.next(ui, u); ++ui) {
        if (tid < 256) {
            const float* sp = ssq + (size_t)(u.pm * 256 + tid) * 64;
            float r[4];
#pragma unroll
            for (int g = 0; g < 4; ++g) {
                const f32x4 s0 = *(const f32x4*)(sp + g * 16), s1 = *(const f32x4*)(sp + g * 16 + 4), s2 = *(const f32x4*)(sp + g * 16 + 8), s3 = *(const f32x4*)(sp + g * 16 + 12);
                const float tot = s0[0] + s0[1] + s0[2] + s0[3] + s1[0] + s1[1] + s1[2] + s1[3] + s2[0] + s2[1] + s2[2] + s2[3] + s3[0] + s3[1] + s3[2] + s3[3];
                r[g] = rsqrtf(tot * (1.0f / 512.0f) + EPS);
            }
            float* tp = gtab + ui * 1024 + tid;
            tp[0] = r[0] / r[1]; tp[256] = r[1] / r[2]; tp[512] = r[2] / r[3]; tp[768] = r[3];
        }
    }
    __syncthreads();
}

__device__ __forceinline__ void phase_convglu(int wv, const bf16_t* U, bf16_t* GL, const float* cw, const float* cb) {
    const int tid = opaque_tid(wv);
    for (int idx = blockIdx.x * 512 + tid; idx < 352 * (SLAB / 32); idx += gridDim.x * 512) {
        const int run = idx / 352, f = (idx - run * 352) * 8, t0 = run * 32;
        float wg[3][8], wvv[3][8], bg[8], bv[8];
#pragma unroll
        for (int e = 0; e < 8; ++e) { bg[e] = cb[f + e]; bv[e] = cb[FFN + f + e];
#pragma unroll
            for (int j = 0; j < 3; ++j) { wg[j][e] = cw[j * FFN2 + f + e]; wvv[j][e] = cw[j * FFN2 + FFN + f + e]; } }
        u32x4 g0 = (u32x4){0u, 0u, 0u, 0u}, g1 = g0, v0 = g0, v1 = g0;
        if ((t0 & (SEQ - 1)) != 0) {
            const bf16_t* up = U + (size_t)(t0 - 2) * FFN2 + f;
            g0 = *(const u32x4*)up; v0 = *(const u32x4*)(up + FFN); g1 = *(const u32x4*)(up + FFN2); v1 = *(const u32x4*)(up + FFN2 + FFN);
        }
        for (int tb = 0; tb < 32; tb += 4) {
            u32x4 gn[4], vn[4];
#pragma unroll
            for (int u = 0; u < 4; ++u) { const bf16_t* up = U + (size_t)(t0 + tb + u) * FFN2 + f; gn[u] = *(const u32x4*)up; vn[u] = *(const u32x4*)(up + FFN); }
#pragma unroll
            for (int u = 0; u < 4; ++u) {
                const unsigned ga0[4] = {g0.x, g0.y, g0.z, g0.w}, ga1[4] = {g1.x, g1.y, g1.z, g1.w}, ga2[4] = {gn[u].x, gn[u].y, gn[u].z, gn[u].w};
                const unsigned va0[4] = {v0.x, v0.y, v0.z, v0.w}, va1[4] = {v1.x, v1.y, v1.z, v1.w}, va2[4] = {vn[u].x, vn[u].y, vn[u].z, vn[u].w};
                unsigned ow[4];
#pragma unroll
                for (int e = 0; e < 4; ++e) {
                    const float gl = bg[2 * e] + wg[0][2 * e] * lo16(ga0[e]) + wg[1][2 * e] * lo16(ga1[e]) + wg[2][2 * e] * lo16(ga2[e]);
                    const float gh = bg[2 * e + 1] + wg[0][2 * e + 1] * hi16(ga0[e]) + wg[1][2 * e + 1] * hi16(ga1[e]) + wg[2][2 * e + 1] * hi16(ga2[e]);
                    const float vl = bv[2 * e] + wvv[0][2 * e] * lo16(va0[e]) + wvv[1][2 * e] * lo16(va1[e]) + wvv[2][2 * e] * lo16(va2[e]);
                    const float vh = bv[2 * e + 1] + wvv[0][2 * e + 1] * hi16(va0[e]) + wvv[1][2 * e + 1] * hi16(va1[e]) + wvv[2][2 * e + 1] * hi16(va2[e]);
                    ow[e] = pack2(silu_f(gl) * vl, silu_f(gh) * vh);
                }
                u32x4 o; o.x = ow[0]; o.y = ow[1]; o.z = ow[2]; o.w = ow[3];
                *(u32x4*)(GL + (size_t)(t0 + tb + u) * FFN + f) = o;
                g0 = g1; g1 = gn[u]; v0 = v1; v1 = vn[u];
            }
        }
    }
}

__device__ __forceinline__ KParams kparams() { KParams k = (KParams)__builtin_amdgcn_kernarg_segment_ptr(); asm volatile("" : "+s"(k)); return k; }
#define WSP(T, off) ((T*)(kparams()->ws + (off)))

__global__ void __launch_bounds__(512, 2) mega(Params p_unused) {
    extern __shared__ __attribute__((aligned(16))) unsigned char shm[];
    cg::grid_group grid = cg::this_grid();
    const int wv = __builtin_amdgcn_readfirstlane((int)(threadIdx.x >> 6));
    LAS unsigned char* lds = (LAS unsigned char*)shm;
    unsigned long long tacc = 0ull, tst = 0ull;

#define NORM_MIX(l_, half_) do { KParams k_ = kparams(); const float* xi_ = ((l_) == 0) ? k_->x : k_->out; \
        phase_norm<false>(wv, xi_ + (size_t)(half_) * SLAB * 1024, k_->norm_mix_w + (l_) * 1024, WSP(bf16_t, OFF_H), nullptr, SLAB); } while (0)
#define NORM_FFN(l_, half_) do { KParams k_ = kparams(); \
        phase_norm<false>(wv, k_->out + (size_t)(half_) * SLAB * 1024, k_->norm_ffn_w + (l_) * 1024, WSP(bf16_t, OFF_H), nullptr, SLAB); } while (0)
    TIC(9); phase_convert(wv, kparams(), (float*)shm);
    NORM_MIX(0, 0);
    grid.sync(); TOC(9);
    for (int l = 0; l < DEPTH; ++l) {
        for (int half = 0; half < NSLAB; ++half) {
            const size_t r0 = (size_t)half * SLAB;
            TIC(1);
            { const float* rope = WSP(const float, OFF_ROPE);
              EpiInProj E{WSP(bf16_t, OFF_PROJ), WSP(float, OFF_MISC), rope, rope + 4096 * 16, rope + 4096 * 32, rope + 4096 * 40, WSP(bf16_t, OFF_VT)};
              pg8::gemm_phase(wv, lds, WSP(const bf16_t, OFF_H), 1024, WSP(const bf16_t, OFF_W + (size_t)l * SZ_WL), SLAB, NP, 1024, E); }
            grid.sync(); TOC(1); TIC(2);
            phase_bcconv(wv, kparams(), l, WSP(const bf16_t, OFF_PROJ), WSP(bf16_t, OFF_H), WSP(bf16_t, OFF_BTG));
            phase_idx(wv, WSP(const bf16_t, OFF_PROJ), WSP(const float, OFF_MISC), WSP(unsigned, OFF_MASK), shm);
            grid.sync(); TOC(2); TIC(3);
            phase_att(wv, WSP(bf16_t, OFF_PROJ), WSP(const bf16_t, OFF_VT), WSP(const unsigned, OFF_MASK), shm);
            __syncthreads(); TOC(3); TIC(4);
            { phase_ssd(wv, kparams(), l, WSP(bf16_t, OFF_PROJ), WSP(const float, OFF_MISC), WSP(const bf16_t, OFF_H), WSP(const bf16_t, OFF_BTG), WSP(float, OFF_SSQ), shm, tacc, tst); }
            TOC(4); TIC(10); grid.sync(); TOC(10); TIC(5);
            phase_gtab(wv, WSP(const float, OFF_SSQ), (float*)(shm + 131072));
            { EpiGateA E{WSP(bf16_t, OFF_PROJ)}; pg8::gemm_phase(wv, lds, WSP(const bf16_t, OFF_PROJ) + C_Q, NP, WSP(const bf16_t, OFF_W + (size_t)l * SZ_WL + SZ_WIN), SLAB, 1024, 1024, E); }
            { EpiGateS E{WSP(bf16_t, OFF_PROJ), (const float*)(shm + 131072)}; pg8::gemm_phase(wv, lds, WSP(const bf16_t, OFF_PROJ) + C_Z, NP, WSP(const bf16_t, OFF_W + (size_t)l * SZ_WL + SZ_WIN + SZ_WPA), SLAB, 1024, 2048, E); }
            grid.sync();
            { KParams k = kparams(); const float* xin = (l == 0) ? k->x : k->out;
              EpiResid E{xin + r0 * 1024, k->out + r0 * 1024};
              pg8::gemm_phase(wv, lds, WSP(const bf16_t, OFF_PROJ) + C_GS, NP, WSP(const bf16_t, OFF_W + (size_t)l * SZ_WL + SZ_WIN + SZ_WPA + SZ_WPS), SLAB, 1024, 1024, E); }
            if (half == 0) NORM_MIX(l, 1); else NORM_FFN(l, 0);
            grid.sync(); TOC(5);
        }
        for (int half = 0; half < NSLAB; ++half) {
            const size_t r0 = (size_t)half * SLAB;
            TIC(6);
            { EpiBf16 E{WSP(bf16_t, OFF_PROJ), FFN2};
              pg8::gemm_phase(wv, lds, WSP(const bf16_t, OFF_H), 1024, WSP(const bf16_t, OFF_W + (size_t)l * SZ_WL + SZ_WIN + SZ_WPA + SZ_WPS + SZ_WO), SLAB, FFN2, 1024, E); }
            grid.sync(); TOC(6); TIC(7);
            { KParams k = kparams(); phase_convglu(wv, WSP(const bf16_t, OFF_PROJ), WSP(bf16_t, OFF_GL), k->ffn_conv_w + (size_t)l * 3 * FFN2, k->ffn_conv_b + (size_t)l * FFN2); }
            grid.sync(); TOC(7); TIC(6);
            { KParams k = kparams(); EpiResid E{k->out + r0 * 1024, k->out + r0 * 1024};
              pg8::gemm_phase(wv, lds, WSP(const bf16_t, OFF_GL), FFN, WSP(const bf16_t, OFF_W + (size_t)l * SZ_WL + SZ_WIN + SZ_WPA + SZ_WPS + SZ_WO + SZ_WUP), SLAB, 1024, FFN, E); }
            if (half == 0) NORM_FFN(l, 1); else if (l + 1 < DEPTH) NORM_MIX(l + 1, 0);
            grid.sync(); TOC(6);
        }
    }
    { KParams k = kparams(); phase_norm<true>(wv, k->out, k->norm_final_w, nullptr, k->out, NTOK); }
    if (PROBE != 0 && blockIdx.x == 0) { const unsigned long long tend = __builtin_amdgcn_s_memrealtime() + 4ull * tacc; while (__builtin_amdgcn_s_memrealtime() < tend) __builtin_amdgcn_s_sleep(8); }
}

extern "C" void kernel_launch(void* const* d_in, const int* in_sizes, int n_in, void* d_out, int out_size, void* d_ws, size_t ws_size, hipStream_t stream) {
    static int grid_blocks = 0;
    if (!grid_blocks) {
        int dev = 0, cus = 0, per_cu = 0;
        hipGetDevice(&dev);
        hipDeviceGetAttribute(&cus, hipDeviceAttributeMultiprocessorCount, dev);
        hipFuncSetAttribute((const void*)mega, hipFuncAttributeMaxDynamicSharedMemorySize, LDS_BYTES);
        hipOccupancyMaxActiveBlocksPerMultiprocessor(&per_cu, mega, 512, LDS_BYTES);
        if (per_cu < 1) per_cu = 1;
        grid_blocks = cus * 1;
    }
    if (ws_size < OFF_END) { fprintf(stderr, "workspace too small: %zu < %zu\n", ws_size, (size_t)OFF_END); return; }
    Params p{};
    p.x = (const float*)d_in[0]; p.norm_mix_w = (const float*)d_in[1]; p.w_in = (const float*)d_in[2]; p.ssd_conv_w = (const float*)d_in[3]; p.ssd_conv_b = (const float*)d_in[4];
    p.ssd_dt_bias = (const float*)d_in[5]; p.ssd_a_log = (const float*)d_in[6]; p.ssd_d = (const float*)d_in[7]; p.ssd_norm_w = (const float*)d_in[8];
    p.w_proj_attn = (const float*)d_in[9]; p.w_proj_ssd = (const float*)d_in[10]; p.w_out = (const float*)d_in[11]; p.norm_ffn_w = (const float*)d_in[12];
    p.ffn_w_up = (const float*)d_in[13]; p.ffn_conv_w = (const float*)d_in[14]; p.ffn_conv_b = (const float*)d_in[15]; p.ffn_w_down = (const float*)d_in[16]; p.norm_final_w = (const float*)d_in[17];
    p.out = (float*)d_out; p.ws = (unsigned char*)d_ws;
    for (int i = 0; i < 16; ++i) p.invA[i] = powf(500000.0f, -(float)(2 * i) / 32.0f);
    for (int i = 0; i < 8; ++i) p.invI[i] = powf(500000.0f, -(float)(2 * i) / 16.0f);
    void* args[] = {&p};
    hipError_t e = hipLaunchCooperativeKernel((const void*)mega, dim3(grid_blocks), dim3(512), args, LDS_BYTES, stream);
    if (e != hipSuccess) fprintf(stderr, "cooperative launch failed: %s (grid %d)\n", hipGetErrorString(e), grid_blocks);
}
```

```cpp
#include <hip/hip_runtime.h>
#include <hip/hip_cooperative_groups.h>
#include <cstdio>
#include <cmath>
namespace cg = cooperative_groups;

#define LAS __attribute__((address_space(3)))
typedef unsigned short bf16_t;
typedef short bf16x8 __attribute__((ext_vector_type(8)));
typedef float f32x4 __attribute__((ext_vector_type(4)));
typedef unsigned u32x2 __attribute__((ext_vector_type(2)));
typedef unsigned u32x4 __attribute__((ext_vector_type(4)));

constexpr int D_MODEL = 1024, SEQ = 4096, NTOK = 32768, SLAB = 16384, NSLAB = 2, DEPTH = 2;
constexpr int IN_COLS = 9320, NP = 9472;
constexpr int C_Q = 0, C_K = 1024, C_V = 1280, C_QI = 1536, C_MISC = 2048, C_Z = 2304, C_XBC = 4352, C_GA = 7424, C_GS = 8448;
constexpr int FFN = 2816, FFN2 = 5632;
constexpr float EPS = 1e-6f;

constexpr size_t SZ_WIN = (size_t)NP * 1024 * 2, SZ_WPA = (size_t)1024 * 1024 * 2, SZ_WPS = (size_t)1024 * 2048 * 2, SZ_WO = SZ_WPA,
                 SZ_WUP = (size_t)FFN2 * 1024 * 2, SZ_WDN = (size_t)1024 * FFN * 2;
constexpr size_t SZ_WL = SZ_WIN + SZ_WPA + SZ_WPS + SZ_WO + SZ_WUP + SZ_WDN;
constexpr size_t OFF_W = 0;
constexpr size_t OFF_ROPE = OFF_W + 2 * SZ_WL;
constexpr size_t OFF_H = OFF_ROPE + (size_t)4096 * 48 * 4;
constexpr size_t OFF_PROJ = OFF_H + (size_t)SLAB * 1024 * 2;
constexpr size_t OFF_MISC = OFF_PROJ + (size_t)SLAB * NP * 2;
constexpr size_t OFF_MASK = OFF_MISC + (size_t)SLAB * 256 * 4;
constexpr size_t OFF_SEL = OFF_MASK + (size_t)SLAB * 128 * 4;
constexpr size_t OFF_SSQ = OFF_SEL + (size_t)SLAB * 256 * 4;
constexpr size_t OFF_VT = OFF_SSQ + (size_t)SLAB * 64 * 4;
constexpr size_t OFF_BTG = OFF_VT + (size_t)4 * 2 * 128 * 4096 * 2;
constexpr size_t OFF_END = OFF_BTG + (size_t)4 * 512 * 4096 * 2;
static_assert(OFF_END <= (size_t)536870912, "workspace budget");
constexpr size_t OFF_GL = OFF_PROJ + (size_t)SLAB * FFN2 * 2;

constexpr int LDS_BYTES = 150528;
#ifndef PROBE
#define PROBE 0
#endif
#define TIC(k) do { if (PROBE == (k)) tst = __builtin_amdgcn_s_memrealtime(); } while (0)
#define TOC(k) do { if (PROBE == (k)) tacc += __builtin_amdgcn_s_memrealtime() - tst; } while (0)

struct Params {
    const float* x; const float* norm_mix_w; const float* w_in; const float* ssd_conv_w; const float* ssd_conv_b;
    const float* ssd_dt_bias; const float* ssd_a_log; const float* ssd_d; const float* ssd_norm_w;
    const float* w_proj_attn; const float* w_proj_ssd; const float* w_out; const float* norm_ffn_w;
    const float* ffn_w_up; const float* ffn_conv_w; const float* ffn_conv_b; const float* ffn_w_down; const float* norm_final_w;
    float* out; unsigned char* ws;
    float invA[16]; float invI[8];
};
typedef const __attribute__((address_space(4))) Params* KParams;

__device__ __forceinline__ int opaque_tid(int wv) { int t; asm volatile("v_mbcnt_lo_u32_b32 %0, -1, 0\n\tv_mbcnt_hi_u32_b32 %0, -1, %0" : "=v"(t)); return wv * 64 + t; }
__device__ __forceinline__ float bf2f(bf16_t b) { return __uint_as_float(((unsigned)b) << 16); }
__device__ __forceinline__ bf16_t f2bf(float f) { unsigned u = __float_as_uint(f); u += 0x7FFFu + ((u >> 16) & 1u); return (bf16_t)(u >> 16); }
__device__ __forceinline__ unsigned pack2(float lo, float hi) { return (unsigned)f2bf(lo) | ((unsigned)f2bf(hi) << 16); }
__device__ __forceinline__ float lo16(unsigned w) { return __uint_as_float(w << 16); }
__device__ __forceinline__ float hi16(unsigned w) { return __uint_as_float(w & 0xffff0000u); }
__device__ __forceinline__ float silu_f(float v) { return v * __builtin_amdgcn_rcpf(1.0f + __expf(-v)); }
__device__ __forceinline__ float sigmoid_f(float v) { return __builtin_amdgcn_rcpf(1.0f + __expf(-v)); }
__device__ __forceinline__ void wave_lds_sync() { __builtin_amdgcn_fence(__ATOMIC_SEQ_CST, "wavefront"); __builtin_amdgcn_wave_barrier(); }
__device__ __forceinline__ float wave_sum(float v) {
#pragma unroll
    for (int o = 32; o >= 1; o >>= 1) v += __shfl_xor(v, o);
    return v;
}
__device__ __forceinline__ float wave_max(float v) {
#pragma unroll
    for (int o = 32; o >= 1; o >>= 1) v = fmaxf(v, __shfl_xor(v, o));
    return v;
}
__device__ __forceinline__ int permA(int s) { return 16 * ((s >> 2) & 1) + 4 * (s >> 3) + (s & 3); }
__device__ __forceinline__ int permI(int s) { return s < 16 ? 8 * ((s >> 2) & 1) + 4 * (s >> 3) + (s & 3) : s; }
__device__ __forceinline__ int perm32(int rho) { const int n = rho >> 4, i = rho & 15; return 8 * (i >> 2) + 4 * n + (i & 3); }
__device__ __forceinline__ int inproj_map(int n) {
    if (n < C_V) { const int sd = n & 127; return (sd < 32) ? (n & ~127) + permA(sd) : n; }
    if (n < C_QI) return n;
    if (n < C_MISC) { const int r = n - C_QI; return C_QI + (r & ~63) + permI(r & 63); }
    if (n < C_Z) { const int c = n - C_MISC; if (c < 64) return 2048 + permI(c); if (c < 72) return 2112 + (c - 64); if (c < 104) return 7240 + (c - 72); return -1; }
    if (n < C_XBC) return 2120 + (n - C_Z);
    if (n < C_GA) return 4168 + (n - C_XBC);
    if (n < C_GS) return 7272 + (n - C_GA);
    return 8296 + (n - C_GS);
}

namespace pg8 {
constexpr int BM = 256, BK = 64, HALF = 128, HTB = HALF * BK * 2, NXCD = 8, WGM = 2;
__device__ __forceinline__ int lds_byte(int r, int c) { const int st = (r >> 4) * 2 + (c >> 5), rr = r & 15, cc = c & 31, ob = rr * 64 + cc * 2; return st * 1024 + (ob ^ (((ob >> 9) & 1) << 5)); }
__device__ __forceinline__ void stage_rc(int b, int& R, int& C) { const int st = b / 1024, sb = b % 1024, swz = sb ^ (((sb >> 9) & 1) << 5); R = (st >> 1) * 16 + swz / 64; C = (st & 1) * 32 + (swz % 64) / 2; }
struct Unit { int pm, pn; };
struct StaticOrder {
    int nM, nN, nwg, G, c, wgm;
    __device__ void init(int M, int N, int G_, int c_, int wgm_ = WGM) { nM = M / BM; nN = N / BM; nwg = nM * nN; G = G_; c = c_; wgm = wgm_; }
    __device__ bool next(int i, Unit& u) const {
        const long L = (long)i * G + c; if (L >= nwg) return false;
        int wgid = (int)L; { const int q = nwg / NXCD, r = nwg % NXCD, xcd = wgid % NXCD, off = wgid / NXCD; wgid = (xcd < r ? xcd * (q + 1) : r * (q + 1) + (xcd - r) * q) + off; }
        const int nig = wgm * nN, gid = wgid / nig, fm = gid * wgm, gsz = (nM - fm) < wgm ? (nM - fm) : wgm;
        u.pm = fm + ((wgid % nig) % gsz); u.pn = (wgid % nig) / gsz; return true;
    }
};
__device__ __forceinline__ unsigned cvt_pk_bf16(float lo, float hi) { unsigned r; asm volatile("v_cvt_pk_bf16_f32 %0, %1, %2" : "=v"(r) : "v"(lo), "v"(hi)); return r; }

template <class Epi>
__device__ __forceinline__ void gemm_phase(int wv, LAS unsigned char* lds, const bf16_t* A, int lda, const bf16_t* Bt, int M, int N, int K, const Epi& E) {
    const int tid = opaque_tid(wv), wid = __builtin_amdgcn_readfirstlane(tid >> 6), lane = tid & 63, wr = wid >> 2, wc = wid & 3, fr = lane & 15, fq = lane >> 4;
    const int nt = K / BK;
    StaticOrder S; S.init(M, N, (int)gridDim.x, (int)blockIdx.x, (N == FFN2) ? 4 : WGM);
    unsigned voffA[2], voffB[2];
#pragma unroll
    for (int i = 0; i < 2; ++i) { int R, C; stage_rc(tid * 16 + i * 8192, R, C); voffA[i] = (unsigned)(R * lda + C) * 2u; voffB[i] = (unsigned)(R * K + C) * 2u; }
    const size_t kstep = (size_t)(BK * 2);
    const size_t hstepA = (size_t)HALF * lda * 2, hstepB = (size_t)HALF * K * 2;
    const size_t tstepA = 2 * hstepA, tstepB = 2 * hstepB;
    const unsigned ldsw = (unsigned)wid * 1024u;
    const int aoff = lds_byte(wr * 64 + fr, fq * 8), boff = lds_byte(wc * 32 + fr, fq * 8);
#define PG8_SA(b, h) (((b) * 2 + (h)) * HTB)
#define PG8_SB(b, h) ((4 + (b) * 2 + (h)) * HTB)
#define PG8_STAGE(bufoff, gbase, voff) do { _Pragma("unroll") for (int _i = 0; _i < 2; ++_i) \
        __builtin_amdgcn_global_load_lds((const unsigned*)((const char*)(gbase) + (voff)[_i]), (LAS unsigned*)(lds + (bufoff) + ldsw + _i * 8192), 16, 0, 0); } while (0)
#define PG8_LDA(dst, b, h) do { _Pragma("unroll") for (int m = 0; m < 4; ++m) _Pragma("unroll") for (int k = 0; k < 2; ++k) dst[m][k] = *(const LAS bf16x8*)(lds + PG8_SA(b, h) + aoff + m * 2048 + k * 1024); } while (0)
#define PG8_LDB(dst, b, h) do { _Pragma("unroll") for (int n = 0; n < 2; ++n) _Pragma("unroll") for (int k = 0; k < 2; ++k) dst[n][k] = *(const LAS bf16x8*)(lds + PG8_SB(b, h) + boff + n * 2048 + k * 1024); } while (0)
#define PG8_MMA(ai, bj, At, Bt_) do { __builtin_amdgcn_s_setprio(1); _Pragma("unroll") for (int m = 0; m < 4; ++m) _Pragma("unroll") for (int n = 0; n < 2; ++n) _Pragma("unroll") for (int k = 0; k < 2; ++k) \
        acc[ai][bj][m][n] = __builtin_amdgcn_mfma_f32_16x16x32_bf16(Bt_[n][k], At[m][k], acc[ai][bj][m][n], 0, 0, 0); __builtin_amdgcn_s_setprio(0); } while (0)
#define PG8_WAIT_V(n) asm volatile("s_waitcnt vmcnt(" #n ")" ::: "memory")
#define PG8_WAIT_L(n) asm volatile("s_waitcnt lgkmcnt(" #n ")" ::: "memory")
#define PG8_BAR __builtin_amdgcn_s_barrier()
#define PG8_SCHED __builtin_amdgcn_sched_barrier(0)
    Unit cur, nxt; int ui = 0;
    if (!S.next(0, cur)) return;
    f32x4 acc[2][2][4][2];
#pragma unroll
    for (int a = 0; a < 2; ++a)
#pragma unroll
        for (int b = 0; b < 2; ++b)
#pragma unroll
            for (int m = 0; m < 4; ++m)
#pragma unroll
                for (int n = 0; n < 2; ++n) acc[a][b][m][n] = (f32x4){0.f, 0.f, 0.f, 0.f};
    bf16x8 At[4][2], B0[2][2], B1[2][2];
    const char* cA = (const char*)A + (size_t)cur.pm * tstepA; const char* cB = (const char*)Bt + (size_t)cur.pn * tstepB;
    PG8_STAGE(PG8_SB(0, 0), cB, voffB); PG8_STAGE(PG8_SB(0, 1), cB + hstepB, voffB); PG8_STAGE(PG8_SA(0, 0), cA, voffA); PG8_STAGE(PG8_SA(0, 1), cA + hstepA, voffA);
    if (wr == 1) PG8_BAR;
    PG8_WAIT_V(2); PG8_BAR;
    PG8_STAGE(PG8_SB(1, 0), cB + kstep, voffB); PG8_STAGE(PG8_SA(1, 0), cA + kstep, voffA); PG8_STAGE(PG8_SB(1, 1), cB + hstepB + kstep, voffB);
    PG8_WAIT_V(6); PG8_BAR;
    for (;;) {
        const bool has_next = S.next(ui + 1, nxt);
        const char* nA = has_next ? (const char*)A + (size_t)nxt.pm * tstepA : cA; const char* nB = has_next ? (const char*)Bt + (size_t)nxt.pn * tstepB : cB;
        const int TG = Epi::GS ? 8 : nt;
        for (int tg = 0; tg < nt; tg += TG) {
        for (int t = tg; t < tg + TG; t += 2) {
            const bool last = (t == nt - 2);
            const char* a1 = cA + (size_t)(t + 1) * kstep;
            const char* a2 = last ? nA : cA + (size_t)(t + 2) * kstep; const char* b2 = last ? nB : cB + (size_t)(t + 2) * kstep;
            const char* a3 = a2 + kstep; const char* b3 = b2 + kstep;
            PG8_LDB(B0, 0, 0); PG8_LDB(B1, 0, 1); PG8_SCHED; PG8_LDA(At, 0, 0); PG8_STAGE(PG8_SA(1, 1), a1 + hstepA, voffA);
            PG8_WAIT_V(8); PG8_WAIT_L(0); PG8_BAR; PG8_MMA(0, 0, At, B0); PG8_MMA(0, 1, At, B1); PG8_BAR; PG8_SCHED;
            PG8_LDA(At, 0, 1); PG8_STAGE(PG8_SB(0, 0), b2, voffB); PG8_STAGE(PG8_SB(0, 1), b2 + hstepB, voffB); PG8_STAGE(PG8_SA(0, 0), a2, voffA);
            PG8_WAIT_V(8); PG8_WAIT_L(0); PG8_BAR; PG8_MMA(1, 0, At, B0); PG8_MMA(1, 1, At, B1); PG8_BAR; PG8_SCHED;
            PG8_LDB(B0, 1, 0); PG8_LDB(B1, 1, 1); PG8_SCHED; PG8_LDA(At, 1, 0); PG8_STAGE(PG8_SA(0, 1), a2 + hstepA, voffA);
            PG8_WAIT_V(8); PG8_WAIT_L(0); PG8_BAR; PG8_MMA(0, 0, At, B0); PG8_MMA(0, 1, At, B1); PG8_BAR; PG8_SCHED;
            PG8_LDA(At, 1, 1); PG8_STAGE(PG8_SB(1, 0), b3, voffB); PG8_STAGE(PG8_SB(1, 1), b3 + hstepB, voffB); PG8_STAGE(PG8_SA(1, 0), a3, voffA);
            PG8_WAIT_V(8); PG8_WAIT_L(0); PG8_BAR; PG8_MMA(1, 0, At, B0); PG8_MMA(1, 1, At, B1); PG8_BAR; PG8_SCHED;
        }
        if constexpr (Epi::GS) { if (tg + TG < nt) E.group_scale(acc, ui, tg >> 3, wr, fr); }
        }
        if (wr == 0) PG8_BAR;
        if constexpr (Epi::GS) E.run(acc, cur, wr, wc, fr, fq, ui); else E(acc, cur, wr, wc, fr, fq);
        if (!has_next) break;
#pragma unroll
        for (int a = 0; a < 2; ++a)
#pragma unroll
            for (int b = 0; b < 2; ++b)
#pragma unroll
                for (int m = 0; m < 4; ++m)
#pragma unroll
                    for (int n = 0; n < 2; ++n) acc[a][b][m][n] = (f32x4){0.f, 0.f, 0.f, 0.f};
        cur = nxt; cA = nA; cB = nB; ++ui;
        if (wr == 1) PG8_BAR;
    }
    PG8_WAIT_V(0);
    PG8_BAR;
#undef PG8_SA
#undef PG8_SB
#undef PG8_STAGE
#undef PG8_LDA
#undef PG8_LDB
#undef PG8_MMA
#undef PG8_WAIT_V
#undef PG8_WAIT_L
#undef PG8_BAR
#undef PG8_SCHED
}
}
using pg8::Unit;

struct EpiInProj {
    static constexpr bool GS = false;
    bf16_t* proj; float* misc; const float* cosA; const float* sinA; const float* cosI; const float* sinI; bf16_t* vt;
    __device__ __forceinline__ void operator()(const f32x4 (&acc)[2][2][4][2], const Unit& u, int wr, int wc, int fr, int fq) const {
        const int pn = u.pn, row0 = u.pm * 256 + wr * 64 + fr;
        const bool is_misc = (pn == 8), is_sig = (pn >= 29);
#pragma unroll
        for (int ai = 0; ai < 2; ++ai)
#pragma unroll
            for (int m = 0; m < 4; ++m) {
                const int r = row0 + ai * 128 + m * 16, pos = r & (SEQ - 1);
#pragma unroll
                for (int bj = 0; bj < 2; ++bj) {
                    int kind = 0;
                    if (pn <= 4) kind = (wc == 0) ? 1 : 0;
                    else if (pn == 6 || pn == 7) kind = (((wc & 1) == 0) && fq < 2) ? 2 : 0;
                    else if (pn == 8) kind = (bj == 0 && wc == 0 && fq < 2) ? 2 : 0;
                    f32x4 c4 = (f32x4){1.f, 1.f, 1.f, 1.f}, s4 = (f32x4){0.f, 0.f, 0.f, 0.f};
                    if (kind == 1) { c4 = *(const f32x4*)(cosA + pos * 16 + 4 * fq); s4 = *(const f32x4*)(sinA + pos * 16 + 4 * fq); }
                    else if (kind == 2) { c4 = *(const f32x4*)(cosI + pos * 8 + 4 * fq); s4 = *(const f32x4*)(sinI + pos * 8 + 4 * fq); }
                    const f32x4 v0 = acc[ai][bj][m][0], v1 = acc[ai][bj][m][1];
                    f32x4 o0 = v0 * c4 - v1 * s4, o1 = v1 * c4 + v0 * s4;
                    if (is_sig) {
#pragma unroll
                        for (int j = 0; j < 4; ++j) { o0[j] = sigmoid_f(o0[j]); o1[j] = sigmoid_f(o1[j]); }
                    }
                    const int cc = bj * 128 + wc * 32 + 8 * fq;
                    u32x4 pk; pk.x = pg8::cvt_pk_bf16(o0[0], o0[1]); pk.y = pg8::cvt_pk_bf16(o0[2], o0[3]); pk.z = pg8::cvt_pk_bf16(o1[0], o1[1]); pk.w = pg8::cvt_pk_bf16(o1[2], o1[3]);
                    if (is_misc) {
                        float* mp = misc + (size_t)r * 256 + cc;
                        *(f32x4*)mp = o0; *(f32x4*)(mp + 4) = o1;
                        if (bj == 0 && wc < 2) *(u32x4*)(proj + (size_t)r * NP + C_MISC + cc) = pk;
                    } else {
                        if (pn == 5) {
                            bf16_t* vp = vt + ((size_t)((r >> 12) * 2 + bj) * 128 + wc * 32 + 8 * fq) * SEQ + pos;
#pragma unroll
                            for (int j = 0; j < 4; ++j) { vp[(size_t)j * SEQ] = f2bf(o0[j]); vp[(size_t)(4 + j) * SEQ] = f2bf(o1[j]); }
                        }
                        *(u32x4*)(proj + (size_t)r * NP + pn * 256 + cc) = pk;
                    }
                }
            }
    }
};
struct EpiGateA {
    static constexpr bool GS = false;
    bf16_t* proj;
    __device__ __forceinline__ void operator()(const f32x4 (&acc)[2][2][4][2], const Unit& u, int wr, int wc, int fr, int fq) const {
        const int row0 = u.pm * 256 + wr * 64 + fr, col0 = u.pn * 256 + wc * 32 + 8 * fq;
#pragma unroll
        for (int ai = 0; ai < 2; ++ai)
#pragma unroll
            for (int m = 0; m < 4; ++m)
#pragma unroll
                for (int bj = 0; bj < 2; ++bj) {
                    bf16_t* pp = proj + (size_t)(row0 + ai * 128 + m * 16) * NP + C_GA + col0 + bj * 128;
                    const u32x4 g = *(const u32x4*)pp; const f32x4 a = acc[ai][bj][m][0], b = acc[ai][bj][m][1];
                    u32x4 w; w.x = pg8::cvt_pk_bf16(lo16(g.x) * a[0], hi16(g.x) * a[1]); w.y = pg8::cvt_pk_bf16(lo16(g.y) * a[2], hi16(g.y) * a[3]);
                    w.z = pg8::cvt_pk_bf16(lo16(g.z) * b[0], hi16(g.z) * b[1]); w.w = pg8::cvt_pk_bf16(lo16(g.w) * b[2], hi16(g.w) * b[3]);
                    *(u32x4*)pp = w;
                }
    }
};
struct EpiGateS {
    static constexpr bool GS = true;
    bf16_t* proj; const float* gtab;
    __device__ __forceinline__ void group_scale(f32x4 (&acc)[2][2][4][2], int u, int g, int wr, int fr) const {
        const float* tp = gtab + (u * 4 + g) * 256 + wr * 64 + fr;
#pragma unroll
        for (int ai = 0; ai < 2; ++ai)
#pragma unroll
            for (int m = 0; m < 4; ++m) {
                const float f = tp[ai * 128 + m * 16];
#pragma unroll
                for (int bj = 0; bj < 2; ++bj) { acc[ai][bj][m][0] *= f; acc[ai][bj][m][1] *= f; }
            }
    }
    __device__ __forceinline__ void run(const f32x4 (&acc)[2][2][4][2], const Unit& u, int wr, int wc, int fr, int fq, int ui) const {
        const int row0 = u.pm * 256 + wr * 64 + fr, col0 = u.pn * 256 + wc * 32 + 8 * fq;
        const float* tp = gtab + (ui * 4 + 3) * 256 + wr * 64 + fr;
#pragma unroll
        for (int ai = 0; ai < 2; ++ai)
#pragma unroll
            for (int m = 0; m < 4; ++m) {
                const float rl = tp[ai * 128 + m * 16];
#pragma unroll
                for (int bj = 0; bj < 2; ++bj) {
                    bf16_t* pa = proj + (size_t)(row0 + ai * 128 + m * 16) * NP + C_GA + col0 + bj * 128;
                    bf16_t* ps = pa + (C_GS - C_GA);
                    const u32x4 m1 = *(const u32x4*)pa; const u32x4 g = *(const u32x4*)ps; const f32x4 a = acc[ai][bj][m][0] * rl, b = acc[ai][bj][m][1] * rl;
                    u32x4 w; w.x = pg8::cvt_pk_bf16(lo16(m1.x) + lo16(g.x) * a[0], hi16(m1.x) + hi16(g.x) * a[1]);
                    w.y = pg8::cvt_pk_bf16(lo16(m1.y) + lo16(g.y) * a[2], hi16(m1.y) + hi16(g.y) * a[3]);
                    w.z = pg8::cvt_pk_bf16(lo16(m1.z) + lo16(g.z) * b[0], hi16(m1.z) + hi16(g.z) * b[1]);
                    w.w = pg8::cvt_pk_bf16(lo16(m1.w) + lo16(g.w) * b[2], hi16(m1.w) + hi16(g.w) * b[3]);
                    *(u32x4*)ps = w;
                }
            }
    }
};
struct EpiResid {
    static constexpr bool GS = false;
    const float* xin; float* xout;
    __device__ __forceinline__ void operator()(const f32x4 (&acc)[2][2][4][2], const Unit& u, int wr, int wc, int fr, int fq) const {
        const int row0 = u.pm * 256 + wr * 64 + fr, col0 = u.pn * 256 + wc * 32 + 8 * fq;
#pragma unroll
        for (int ai = 0; ai < 2; ++ai)
#pragma unroll
            for (int m = 0; m < 4; ++m)
#pragma unroll
                for (int bj = 0; bj < 2; ++bj)
#pragma unroll
                    for (int n = 0; n < 2; ++n) {
                        const size_t off = (size_t)(row0 + ai * 128 + m * 16) * 1024 + col0 + bj * 128 + n * 4;
                        *(f32x4*)(xout + off) = *(const f32x4*)(xin + off) + acc[ai][bj][m][n];
                    }
    }
};
struct EpiBf16 {
    static constexpr bool GS = false;
    bf16_t* O; int ldc;
    __device__ __forceinline__ void operator()(const f32x4 (&acc)[2][2][4][2], const Unit& u, int wr, int wc, int fr, int fq) const {
        const int row0 = u.pm * 256 + wr * 64 + fr, col0 = u.pn * 256 + wc * 32 + 8 * fq;
#pragma unroll
        for (int ai = 0; ai < 2; ++ai)
#pragma unroll
            for (int m = 0; m < 4; ++m)
#pragma unroll
                for (int bj = 0; bj < 2; ++bj) {
                    const f32x4 a = acc[ai][bj][m][0], b = acc[ai][bj][m][1];
                    u32x4 w; w.x = pg8::cvt_pk_bf16(a[0], a[1]); w.y = pg8::cvt_pk_bf16(a[2], a[3]); w.z = pg8::cvt_pk_bf16(b[0], b[1]); w.w = pg8::cvt_pk_bf16(b[2], b[3]);
                    *(u32x4*)(O + (size_t)(row0 + ai * 128 + m * 16) * ldc + col0 + bj * 128) = w;
                }
    }
};

template <int MODE>
__device__ __forceinline__ void convT(int wv, const float* src, int K, int Nsrc, bf16_t* dst, int Ndst, const float* kscale, float* tile) {
    const int tid = opaque_tid(wv), kt = K / 64, ntiles = (Ndst / 64) * kt;
    for (int ti = blockIdx.x; ti < ntiles; ti += gridDim.x) {
        const int n0 = (ti / kt) * 64, k0 = (ti % kt) * 64;
        {
            const int nn = tid & 63; const int nd = n0 + nn; const int n = (nd & ~31) + perm32(nd & 31); const int ns = MODE ? inproj_map(n) : n;
#pragma unroll
            for (int i = 0; i < 8; ++i) {
                const int kk = (tid >> 6) + 8 * i;
                float v = (ns >= 0) ? src[(size_t)(k0 + kk) * Nsrc + ns] : 0.f;
                if (kscale) v *= kscale[k0 + kk];
                tile[nn * 65 + kk] = v;
            }
        }
        __syncthreads();
        {
            const int kk = tid & 63;
#pragma unroll
            for (int i = 0; i < 8; ++i) { const int nn = (tid >> 6) + 8 * i; dst[(size_t)(n0 + nn) * K + k0 + kk] = f2bf(tile[nn * 65 + kk]); }
        }
        __syncthreads();
    }
}

__device__ __forceinline__ void phase_convert(int wv, KParams p, float* tile) {
    for (int l = 0; l < DEPTH; ++l) {
        unsigned char* wl = p->ws + OFF_W + (size_t)l * SZ_WL;
        bf16_t* win = (bf16_t*)wl; bf16_t* wpa = (bf16_t*)(wl + SZ_WIN); bf16_t* wps = (bf16_t*)(wl + SZ_WIN + SZ_WPA);
        bf16_t* wo = (bf16_t*)(wl + SZ_WIN + SZ_WPA + SZ_WPS); bf16_t* wup = (bf16_t*)(wl + SZ_WIN + SZ_WPA + SZ_WPS + SZ_WO); bf16_t* wdn = (bf16_t*)(wl + SZ_WIN + SZ_WPA + SZ_WPS + SZ_WO + SZ_WUP);
        convT<1>(wv, p->w_in + (size_t)l * 1024 * IN_COLS, 1024, IN_COLS, win, NP, nullptr, tile);
        convT<0>(wv, p->w_proj_attn + (size_t)l * 1024 * 1024, 1024, 1024, wpa, 1024, nullptr, tile);
        convT<0>(wv, p->w_proj_ssd + (size_t)l * 2048 * 1024, 2048, 1024, wps, 1024, p->ssd_norm_w + l * 2048, tile);
        convT<0>(wv, p->w_out + (size_t)l * 1024 * 1024, 1024, 1024, wo, 1024, nullptr, tile);
        convT<0>(wv, p->ffn_w_up + (size_t)l * 1024 * FFN2, 1024, FFN2, wup, FFN2, nullptr, tile);
        convT<0>(wv, p->ffn_w_down + (size_t)l * FFN * 1024, FFN, 1024, wdn, 1024, nullptr, tile);
    }
    float* rope = (float*)(p->ws + OFF_ROPE);
    float* cosA = rope; float* sinA = rope + 4096 * 16; float* cosI = rope + 4096 * 32; float* sinI = rope + 4096 * 40;
    for (int i = blockIdx.x * 512 + opaque_tid(wv); i < 4096 * 24; i += gridDim.x * 512) {
        int pos, f; float inv;
        if (i < 4096 * 16) { pos = i >> 4; f = i & 15; inv = p->invA[f]; } else { const int j = i - 4096 * 16; pos = j >> 3; f = j & 7; inv = p->invI[f]; }
        const float ang = (float)pos * inv;
        double rev = (double)ang * 0.15915494309189535; rev -= rint(rev);
        const float c = __builtin_amdgcn_cosf((float)rev), s = __builtin_amdgcn_sinf((float)rev);
        if (i < 4096 * 16) { cosA[pos * 16 + f] = c; sinA[pos * 16 + f] = s; } else { cosI[pos * 8 + f] = c; sinI[pos * 8 + f] = s; }
    }
}

template <bool F32OUT>
__device__ __forceinline__ void phase_norm(int wv, const float* xin, const float* w, bf16_t* hout, float* fout, int nrows) {
    const int tid = opaque_tid(wv); const int wave = tid >> 6, lane = tid & 63;
    const int stride = gridDim.x * 8;
    for (int row0 = blockIdx.x * 8 + wave; row0 < nrows; row0 += stride * 4) {
        f32x4 v[4][4];
#pragma unroll
        for (int u = 0; u < 4; ++u) {
            const int row = row0 + u * stride;
            if (row < nrows) {
                const f32x4* xr = (const f32x4*)(xin + (size_t)row * 1024);
#pragma unroll
                for (int i = 0; i < 4; ++i) v[u][i] = xr[lane + 64 * i];
            }
        }
        f32x4 w4[4];
#pragma unroll
        for (int i = 0; i < 4; ++i) w4[i] = ((const f32x4*)w)[lane + 64 * i];
#pragma unroll
        for (int u = 0; u < 4; ++u) {
            const int row = row0 + u * stride;
            if (row < nrows) {
                float ss = 0.f;
#pragma unroll
                for (int i = 0; i < 4; ++i) ss += v[u][i][0] * v[u][i][0] + v[u][i][1] * v[u][i][1] + v[u][i][2] * v[u][i][2] + v[u][i][3] * v[u][i][3];
                ss = wave_sum(ss);
                const float rstd = rsqrtf(ss * (1.0f / 1024.0f) + EPS);
#pragma unroll
                for (int i = 0; i < 4; ++i) {
                    const f32x4 o = v[u][i] * rstd * w4[i];
                    if (F32OUT) ((f32x4*)(fout + (size_t)row * 1024))[lane + 64 * i] = o;
                    else { u32x2 pk; pk.x = pack2(o[0], o[1]); pk.y = pack2(o[2], o[3]); *(u32x2*)(hout + (size_t)row * 1024 + 4 * (lane + 64 * i)) = pk; }
                }
            }
        }
    }
}

__device__ __forceinline__ unsigned fkey(float s) { s += 0.0f; const unsigned u = __float_as_uint(s); return (u & 0x80000000u) ? ~u : (u | 0x80000000u); }

__device__ __forceinline__ void phase_idx_simple(int wv, const bf16_t* proj, const float* misc, unsigned* mask, int* sel, unsigned char* shm) {
    const int tid = opaque_tid(wv); const int wave = tid >> 6, lane = tid & 63;
    float* qs = (float*)(shm + wave * 18432); unsigned* sk = (unsigned*)(shm + wave * 18432 + 2048);
    const unsigned long long lt_mask = (1ull << lane) - 1ull;
    for (int q = blockIdx.x * 8 + wave; q < SLAB; q += gridDim.x * 8) {
        const int bl = q >> 12, t = q & (SEQ - 1), n = t + 1;
        wave_lds_sync();
        {
            const u32x4 raw = *(const u32x4*)(proj + (size_t)q * NP + C_QI + lane * 8);
            f32x4 a, b; a[0] = lo16(raw.x); a[1] = hi16(raw.x); a[2] = lo16(raw.y); a[3] = hi16(raw.y); b[0] = lo16(raw.z); b[1] = hi16(raw.z); b[2] = lo16(raw.w); b[3] = hi16(raw.w);
            *(f32x4*)(qs + lane * 8) = a; *(f32x4*)(qs + lane * 8 + 4) = b;
        }
        float wv[8];
        { const f32x4 w0 = *(const f32x4*)(misc + (size_t)q * 256 + 64), w1 = *(const f32x4*)(misc + (size_t)q * 256 + 68);
#pragma unroll
          for (int j = 0; j < 4; ++j) { wv[j] = w0[j]; wv[4 + j] = w1[j]; } }
        wave_lds_sync();
        const int nr = (n + 63) & ~63;
        for (int s = lane; s < nr; s += 64) {
            if (s < n) {
                const f32x4* kp = (const f32x4*)(misc + (size_t)(bl * SEQ + s) * 256);
                f32x4 kv[16];
#pragma unroll
                for (int i = 0; i < 16; ++i) kv[i] = kp[i];
                float sc = 0.f;
#pragma unroll
                for (int h = 0; h < 8; ++h) {
                    float d = 0.f;
#pragma unroll
                    for (int i = 0; i < 16; ++i) { const f32x4 qv = *(const f32x4*)(qs + h * 64 + i * 4); d += kv[i][0] * qv[0] + kv[i][1] * qv[1] + kv[i][2] * qv[2] + kv[i][3] * qv[3]; }
                    sc += wv[h] * fmaxf(d, 0.f);
                }
                sk[s] = fkey(sc);
            }
        }
        wave_lds_sync();
        unsigned cur = 0u; int need = 1 << 30;
        if (n > 256) {
            for (int bit = 31; bit >= 0; --bit) {
                const unsigned cand = cur | (1u << bit); int cnt = 0;
                for (int s = lane; s < nr; s += 64) { const bool pr = (s < n) && (sk[s] >= cand); cnt += __popcll(__ballot(pr)); }
                if (cnt >= 256) cur = cand;
            }
            int cgt = 0;
            for (int s = lane; s < nr; s += 64) { const bool pr = (s < n) && (sk[s] > cur); cgt += __popcll(__ballot(pr)); }
            need = 256 - cgt;
        }
        int run_eq = 0, run_sel = 0; unsigned long long mybal = 0ull;
        for (int s = lane, c = 0; s < nr; s += 64, ++c) {
            const bool in = s < n; const unsigned k = in ? sk[s] : 0u;
            const bool gt = in && (k > cur), eq = in && (k == cur);
            const unsigned long long beq = __ballot(eq);
            const int rank = run_eq + __popcll(beq & lt_mask);
            const bool se = gt || (eq && rank < need);
            const unsigned long long bs = __ballot(se);
            const int pos = run_sel + __popcll(bs & lt_mask);
            if (se && pos < 256) sel[(size_t)q * 256 + pos] = s;
            run_eq += __popcll(beq); run_sel += __popcll(bs);
            if (lane == c) mybal = bs;
        }
        u32x2 mw; mw.x = (unsigned)mybal; mw.y = (unsigned)(mybal >> 32);
        *(u32x2*)(mask + (size_t)q * 128 + lane * 2) = mw;
        for (int j = run_sel + lane; j < 256; j += 64) sel[(size_t)q * 256 + j] = -1;
    }
}

__device__ __forceinline__ void phase_att_simple(int wv, bf16_t* proj, const int* sel, unsigned char* shm) {
    const int tid = opaque_tid(wv); const int wave = tid >> 6, lane = tid & 63, h = wave, kvh = h >> 2;
    float* qf = (float*)(shm + wave * 2560); float* pj = qf + 128; int* kj = (int*)(pj + 256);
    const float scale = 0.08838834764831845f;
    for (int q = blockIdx.x; q < SLAB; q += gridDim.x) {
        const int bl = q >> 12;
        wave_lds_sync();
        { const unsigned raw = *(const unsigned*)(proj + (size_t)q * NP + C_Q + h * 128 + 2 * lane); qf[2 * lane] = lo16(raw); qf[2 * lane + 1] = hi16(raw); }
        int keys[4];
#pragma unroll
        for (int i = 0; i < 4; ++i) { keys[i] = sel[(size_t)q * 256 + lane + 64 * i]; kj[lane + 64 * i] = keys[i]; }
        wave_lds_sync();
        float lg[4]; float mx = -INFINITY;
#pragma unroll
        for (int i = 0; i < 4; ++i) {
            lg[i] = -INFINITY;
            if (keys[i] >= 0) {
                const u32x4* kp = (const u32x4*)(proj + (size_t)(bl * SEQ + keys[i]) * NP + C_K + kvh * 128);
                float d = 0.f;
#pragma unroll
                for (int c = 0; c < 16; ++c) {
                    const u32x4 raw = kp[c]; const f32x4 q0 = *(const f32x4*)(qf + c * 8), q1 = *(const f32x4*)(qf + c * 8 + 4);
                    d += lo16(raw.x) * q0[0] + hi16(raw.x) * q0[1] + lo16(raw.y) * q0[2] + hi16(raw.y) * q0[3] + lo16(raw.z) * q1[0] + hi16(raw.z) * q1[1] + lo16(raw.w) * q1[2] + hi16(raw.w) * q1[3];
                }
                lg[i] = d * scale;
            }
            mx = fmaxf(mx, lg[i]);
        }
        mx = wave_max(mx);
        float sm = 0.f; float pe[4];
#pragma unroll
        for (int i = 0; i < 4; ++i) { pe[i] = (keys[i] >= 0) ? __expf(lg[i] - mx) : 0.f; sm += pe[i]; }
        sm = wave_sum(sm);
        const float inv = 1.0f / sm;
#pragma unroll
        for (int i = 0; i < 4; ++i) pj[lane + 64 * i] = pe[i] * inv;
        wave_lds_sync();
        float a0 = 0.f, a1 = 0.f;
        const bf16_t* vb = proj + (size_t)(bl * SEQ) * NP + C_V + kvh * 128 + 2 * lane;
        for (int j0 = 0; j0 < 256; j0 += 16) {
            if (kj[j0] < 0) break;
            unsigned raw[16]; float pv[16];
#pragma unroll
            for (int u = 0; u < 16; ++u) { const int key = max(kj[j0 + u], 0); pv[u] = pj[j0 + u]; raw[u] = *(const unsigned*)(vb + (size_t)key * NP); }
#pragma unroll
            for (int u = 0; u < 16; ++u) { a0 += pv[u] * lo16(raw[u]); a1 += pv[u] * hi16(raw[u]); }
        }
        *(unsigned*)(proj + (size_t)q * NP + C_Q + h * 128 + 2 * lane) = pack2(a0, a1);
    }
}


typedef short bf16x4 __attribute__((ext_vector_type(4)));
__device__ __forceinline__ void phase_idx(int wv, const bf16_t* proj, const float* misc, unsigned* mask, unsigned char* shm) {
    const int tid = opaque_tid(wv), wave = __builtin_amdgcn_readfirstlane(tid >> 6), lane = tid & 63, fr = lane & 15, fq = lane >> 4;
    int* cntbuf = (int*)shm;
    int* cbuf2 = cntbuf + 256;
    volatile int* tieflag = (volatile int*)(shm + 149760);
    for (int it = blockIdx.x; it < 256; it += gridDim.x) {
        for (int pass = 0; pass < 4; ++pass) {
            const int i = (pass == 0) ? it : (pass == 1) ? 511 - it : (pass == 2) ? 512 + it : 1023 - it;
            const int qt = 255 - (i >> 2), bl = i & 3;
            const int q0 = qt * 16, nch = (q0 + 15) / 64 + 1, t = q0 + fr;
            const size_t qrow = (size_t)bl * SEQ + q0 + fr;
            int lb = wave * 64 + fq * 4; asm volatile("" : "+v"(lb));
            u32x4 key[4][4];
            u32x4* klds = (u32x4*)(shm + 18688) + tid;
#define KGET(dst, ip, tt) do { if ((ip) < 4) dst = key[(ip) < 4 ? (ip) : 0][tt]; else dst = klds[(((ip) - 4) * 4 + (tt)) * 512]; } while (0)
            {
                float wv[8];
                { const f32x4 w0 = *(const f32x4*)(misc + qrow * 256 + 64), w1 = *(const f32x4*)(misc + qrow * 256 + 68);
#pragma unroll
                  for (int j = 0; j < 4; ++j) { wv[j] = w0[j]; wv[4 + j] = w1[j]; } }
#pragma unroll
                for (int u = 0; u < 2; ++u) { const int ch = tid + 512 * u, r = ch >> 6, cc = ch & 63;
                    *(u32x4*)(shm + 2048 + r * 1040 + cc * 16) = *(const u32x4*)(proj + ((size_t)bl * SEQ + q0 + r) * NP + C_QI + cc * 8); }
                if (tid == 0) tieflag[0] = 0;
                __syncthreads();
                const unsigned char* ql = shm + 2048 + fr * 1040 + fq * 16;
#pragma unroll
                for (int ip = 0; ip < 8; ++ip) {
                    int c = wave + 8 * ip; asm volatile("" : "+s"(c));
                    if (c < nch) {
                        const int trel = t - (c - wave) * 64 - lb;
                        const bf16_t* kp0 = proj + ((size_t)bl * SEQ + c * 64 + fr) * NP + C_MISC + fq * 8;
#pragma unroll
                        for (int tp = 0; tp < 2; ++tp) {
                            bf16x8 kf[2][2];
#pragma unroll
                            for (int u = 0; u < 2; ++u) { const bf16_t* kp = kp0 + (size_t)((tp * 2 + u) * 16) * NP; kf[u][0] = *(const bf16x8*)kp; kf[u][1] = *(const bf16x8*)(kp + 32); }
                            f32x4 sc[2];
                            sc[0] = (f32x4){0.f, 0.f, 0.f, 0.f}; sc[1] = (f32x4){0.f, 0.f, 0.f, 0.f};
#pragma unroll
                            for (int h = 0; h < 8; ++h) {
                                const bf16x8 q0f = *(const bf16x8*)(ql + h * 128), q1f = *(const bf16x8*)(ql + h * 128 + 64);
#pragma unroll
                                for (int u = 0; u < 2; ++u) {
                                    f32x4 d = __builtin_amdgcn_mfma_f32_16x16x32_bf16(kf[u][0], q0f, (f32x4){0.f, 0.f, 0.f, 0.f}, 0, 0, 0);
                                    d = __builtin_amdgcn_mfma_f32_16x16x32_bf16(kf[u][1], q1f, d, 0, 0, 0);
#pragma unroll
                                    for (int j = 0; j < 4; ++j) sc[u][j] += wv[h] * fmaxf(d[j], 0.f);
                                }
                                if ((h & 3) == 3) asm volatile("" ::: "memory");
                            }
#pragma unroll
                            for (int u = 0; u < 2; ++u) {
                                u32x4 kk;
#pragma unroll
                                for (int j = 0; j < 4; ++j) kk[j] = ((tp * 2 + u) * 16 + j <= trel) ? fkey(sc[u][j]) : 0u;
                                if (ip < 4) key[ip < 4 ? ip : 0][tp * 2 + u] = kk; else klds[((ip - 4) * 4 + tp * 2 + u) * 512] = kk;
                            }
                        }
                    } else if (ip < 4) {
#pragma unroll
                        for (int tt = 0; tt < 4; ++tt) key[ip < 4 ? ip : 0][tt] = (u32x4){0u, 0u, 0u, 0u};
                    }
                    asm volatile("" ::: "memory");
                }
            }
            __syncthreads();
            unsigned cur = 0u;
            bool rdone = (t + 1 <= 256);
            for (int bit = 31; bit >= 0; --bit) {
                if (__ballot(rdone) == ~0ull) break;
                const unsigned cand = cur | (1u << bit);
                int cnt = 0;
#pragma unroll
                for (int hp2 = 0; hp2 < 2; ++hp2) {
                    if (wave + 8 * (4 + 2 * hp2) < nch) {
                        u32x4 kl[8];
#pragma unroll
                        for (int q = 0; q < 8; ++q) kl[q] = klds[(hp2 * 8 + q) * 512];
                        const bool second = (wave + 8 * (5 + 2 * hp2) < nch);
#pragma unroll
                        for (int q = 0; q < 4; ++q)
#pragma unroll
                            for (int j = 0; j < 4; ++j) cnt += (kl[q][j] >= cand) ? 1 : 0;
                        if (second) {
#pragma unroll
                            for (int q = 4; q < 8; ++q)
#pragma unroll
                                for (int j = 0; j < 4; ++j) cnt += (kl[q][j] >= cand) ? 1 : 0;
                        }
                    }
                }
#pragma unroll
                for (int ip = 0; ip < 4; ++ip)
                    if (wave + 8 * ip < nch) {
#pragma unroll
                        for (int tt = 0; tt < 4; ++tt)
#pragma unroll
                            for (int j = 0; j < 4; ++j) cnt += (key[ip][tt][j] >= cand) ? 1 : 0;
                    }
                cnt += __shfl_xor(cnt, 16); cnt += __shfl_xor(cnt, 32);
                int* cb = cntbuf + (bit & 1) * 128;
                if (fq == 0) cb[fr * 8 + wave] = cnt;
                __syncthreads();
                const int4 a = *(const int4*)(cb + fr * 8), b = *(const int4*)(cb + fr * 8 + 4);
                const int tot = a.x + a.y + a.z + a.w + b.x + b.y + b.z + b.w;
                if (!rdone && tot >= 256) { cur = cand; if (tot == 256) rdone = true; }
            }
            int cg = 0, ce = 0;
#pragma unroll
            for (int ip = 0; ip < 8; ++ip)
                if (wave + 8 * ip < nch) {
#pragma unroll
                    for (int tt = 0; tt < 4; ++tt) { u32x4 kv; KGET(kv, ip, tt);
#pragma unroll
                        for (int j = 0; j < 4; ++j) { cg += (kv[j] > cur) ? 1 : 0; ce += (kv[j] == cur) ? 1 : 0; } }
                }
            cg += __shfl_xor(cg, 16); cg += __shfl_xor(cg, 32); ce += __shfl_xor(ce, 16); ce += __shfl_xor(ce, 32);
            if (fq == 0) { cbuf2[fr * 8 + wave] = cg; cbuf2[128 + fr * 8 + wave] = ce; }
            __syncthreads();
            int need, ceq;
            { const int4 a = *(const int4*)(cbuf2 + fr * 8), b = *(const int4*)(cbuf2 + fr * 8 + 4);
              need = 256 - (a.x + a.y + a.z + a.w + b.x + b.y + b.z + b.w);
              const int4 c4 = *(const int4*)(cbuf2 + 128 + fr * 8), d4 = *(const int4*)(cbuf2 + 128 + fr * 8 + 4);
              ceq = c4.x + c4.y + c4.z + c4.w + d4.x + d4.y + d4.z + d4.w; }
            const bool ties = (cur != 0u) && (ceq > need);
            unsigned J = 4095u;
            if (ties) tieflag[0] = 1;
            __syncthreads();
            if (tieflag[0] != 0) {
                unsigned Jt = 0u;
                for (int bit = 11; bit >= 0; --bit) {
                    const unsigned cand = Jt | (1u << bit);
                    const int crel = (int)cand - lb;
                    int cnt = 0;
#pragma unroll
                    for (int ip = 0; ip < 8; ++ip)
                        if (wave + 8 * ip < nch) {
#pragma unroll
                            for (int tt = 0; tt < 4; ++tt) { u32x4 kv; KGET(kv, ip, tt);
#pragma unroll
                                for (int j = 0; j < 4; ++j) cnt += (kv[j] == cur && (ip * 512 + tt * 16 + j) < crel) ? 1 : 0; }
                        }
                    cnt += __shfl_xor(cnt, 16); cnt += __shfl_xor(cnt, 32);
                    int* cb = cntbuf + (bit & 1) * 128;
                    if (fq == 0) cb[fr * 8 + wave] = cnt;
                    __syncthreads();
                    const int4 a = *(const int4*)(cb + fr * 8), b = *(const int4*)(cb + fr * 8 + 4);
                    const int tot = a.x + a.y + a.z + a.w + b.x + b.y + b.z + b.w;
                    if (tot < need) Jt = cand;
                }
                if (ties) J = Jt;
            }
#pragma unroll
            for (int ip = 0; ip < 8; ++ip) {
                const int c = wave + 8 * ip;
                if (c < nch) {
                    unsigned lo = 0u, hi = 0u;
                    const int jrel = (int)J - lb;
#pragma unroll
                    for (int tt = 0; tt < 4; ++tt) { u32x4 kv; KGET(kv, ip, tt);
#pragma unroll
                        for (int j = 0; j < 4; ++j) {
                            const unsigned k = kv[j];
                            const bool se = (k > cur) || (k == cur && cur != 0u && (ip * 512 + tt * 16 + j) <= jrel);
                            const unsigned b = se ? 1u : 0u;
                            if (tt < 2) lo |= b << (tt * 16 + j); else hi |= b << ((tt - 2) * 16 + j);
                        } }
                    lo <<= (lb & 15); hi <<= (lb & 15);
                    lo |= __shfl_xor(lo, 16); lo |= __shfl_xor(lo, 32); hi |= __shfl_xor(hi, 16); hi |= __shfl_xor(hi, 32);
                    if (fq == 0) { u32x2 mw; mw.x = lo; mw.y = hi; *(u32x2*)(mask + qrow * 128 + c * 2) = mw; }
                }
            }
            __syncthreads();
        }
    }
#undef KGET
}

__device__ __forceinline__ void phase_att(int wv, bf16_t* proj, const bf16_t* vt, const unsigned* mask, unsigned char* shm) {
    const int tid = opaque_tid(wv), wave = tid >> 6, lane = tid & 63, fr = lane & 15, fq = lane >> 4;
    const int qs = wave & 3, hp = wave >> 2;
    constexpr int KROW = 272, VROW = 272, KBYTES = 128 * KROW, VBYTES = 128 * VROW, BUF = KBYTES + VBYTES;
    const float sc2 = 0.08838834764831845f * 1.4426950408889634f;
    for (int it = blockIdx.x; it < 256; it += gridDim.x) {
        for (int pass = 0; pass < 2; ++pass) {
            const int i = (pass == 0) ? it : 511 - it;
            const int qb = 63 - (i >> 3), sub = i & 7, bl = sub >> 1, kvh = sub & 1, nkt = qb + 1;
            const size_t qrow = (size_t)bl * SEQ + qb * 64 + qs * 16 + fr;
            bf16x8 qf[2][4];
#pragma unroll
            for (int hh = 0; hh < 2; ++hh)
#pragma unroll
                for (int ks = 0; ks < 4; ++ks) qf[hh][ks] = *(const bf16x8*)(proj + qrow * NP + C_Q + (kvh * 4 + hp * 2 + hh) * 128 + ks * 32 + fq * 8);
            f32x4 o[2][8];
#pragma unroll
            for (int hh = 0; hh < 2; ++hh)
#pragma unroll
                for (int dt = 0; dt < 8; ++dt) o[hh][dt] = (f32x4){0.f, 0.f, 0.f, 0.f};
            float mrow[2] = {-1e30f, -1e30f}, lrow[2] = {0.f, 0.f};
            const int sr0 = tid >> 4, sc = tid & 15;
            const bf16_t* kg = proj + ((size_t)bl * SEQ + sr0) * NP + C_K + kvh * 128 + sc * 8;
            const bf16_t* vg = vt + ((size_t)(bl * 2 + kvh) * 128 + sr0) * SEQ + sc * 8;
            const int klds = sr0 * KROW + sc * 16, vlds = KBYTES + sr0 * VROW + sc * 16;
            const int nst = (nkt + 1) >> 1;
            u32x4 kreg[4], vreg[4];
            __syncthreads();
#pragma unroll
            for (int u = 0; u < 4; ++u) { kreg[u] = *(const u32x4*)(kg + (size_t)(32 * u) * NP); vreg[u] = *(const u32x4*)(vg + (size_t)(32 * u) * SEQ); }
#pragma unroll
            for (int u = 0; u < 4; ++u) { *(u32x4*)(shm + klds + 32 * u * KROW) = kreg[u]; *(u32x4*)(shm + vlds + 32 * u * VROW) = vreg[u]; }
            __syncthreads();
            u32x4 mknext = *(const u32x4*)(mask + qrow * 128);
            for (int st = 0; st < nst; ++st) {
                const unsigned char* sbuf = shm + (st & 1) * BUF;
                const bool more = (st + 1 < nst);
                if (more) {
                    const bf16_t* kg2 = kg + (size_t)(st + 1) * 128 * NP; const bf16_t* vg2 = vg + (st + 1) * 128;
#pragma unroll
                    for (int u = 0; u < 4; ++u) { kreg[u] = *(const u32x4*)(kg2 + (size_t)(32 * u) * NP); vreg[u] = *(const u32x4*)(vg2 + (size_t)(32 * u) * SEQ); }
                }
                const u32x4 mk4 = mknext;
                if (more) mknext = *(const u32x4*)(mask + qrow * 128 + (st + 1) * 4);
#pragma unroll
                for (int h2 = 0; h2 < 2; ++h2) {
                if (2 * st + h2 >= nkt) break;
                const unsigned char* buf = sbuf + h2 * 64 * KROW;
                const unsigned char* vbuf = sbuf + KBYTES + h2 * 128;
                const unsigned mlo = (h2 ? mk4.z : mk4.x) >> (fq * 4), mhi = (h2 ? mk4.w : mk4.y) >> (fq * 4);
                f32x4 s[2][4];
#pragma unroll
                for (int nt = 0; nt < 4; ++nt) {
                    s[0][nt] = (f32x4){0.f, 0.f, 0.f, 0.f}; s[1][nt] = (f32x4){0.f, 0.f, 0.f, 0.f};
#pragma unroll
                    for (int ks = 0; ks < 4; ++ks) {
                        const bf16x8 kf = *(const bf16x8*)(buf + (nt * 16 + fr) * KROW + (ks * 32 + fq * 8) * 2);
                        s[0][nt] = __builtin_amdgcn_mfma_f32_16x16x32_bf16(kf, qf[0][ks], s[0][nt], 0, 0, 0);
                        s[1][nt] = __builtin_amdgcn_mfma_f32_16x16x32_bf16(kf, qf[1][ks], s[1][nt], 0, 0, 0);
                    }
                }
                bf16x8 pf[2][2];
                f32x4 bias[4];
#pragma unroll
                for (int nt = 0; nt < 4; ++nt)
#pragma unroll
                    for (int j = 0; j < 4; ++j) { const unsigned w = (nt < 2) ? mlo : mhi; bias[nt][j] = ((w >> ((nt & 1) * 16 + j)) & 1u) ? 0.f : -INFINITY; }
#pragma unroll
                for (int hh = 0; hh < 2; ++hh) {
                    float mx = -INFINITY;
#pragma unroll
                    for (int nt = 0; nt < 4; ++nt)
#pragma unroll
                        for (int j = 0; j < 4; ++j) { const float tv = __builtin_fmaf(s[hh][nt][j], sc2, bias[nt][j]); s[hh][nt][j] = tv; mx = fmaxf(mx, tv); }
                    mx = fmaxf(mx, __shfl_xor(mx, 16)); mx = fmaxf(mx, __shfl_xor(mx, 32));
                    const float mnew = fmaxf(mrow[hh], mx);
                    const float alpha = __builtin_amdgcn_exp2f(mrow[hh] - mnew);
                    mrow[hh] = mnew;
                    float ls = 0.f;
#pragma unroll
                    for (int nt = 0; nt < 4; ++nt)
#pragma unroll
                        for (int j = 0; j < 4; ++j) { const float pv = __builtin_amdgcn_exp2f(s[hh][nt][j] - mnew); s[hh][nt][j] = pv; ls += pv; }
                    lrow[hh] = lrow[hh] * alpha + ls;
                    if (__ballot(alpha != 1.0f) != 0ull) {
#pragma unroll
                        for (int dt = 0; dt < 8; ++dt) o[hh][dt] *= alpha;
                    }
#pragma unroll
                    for (int kk = 0; kk < 2; ++kk) {
                        u32x4 pk;
                        pk.x = pg8::cvt_pk_bf16(s[hh][2 * kk][0], s[hh][2 * kk][1]); pk.y = pg8::cvt_pk_bf16(s[hh][2 * kk][2], s[hh][2 * kk][3]);
                        pk.z = pg8::cvt_pk_bf16(s[hh][2 * kk + 1][0], s[hh][2 * kk + 1][1]); pk.w = pg8::cvt_pk_bf16(s[hh][2 * kk + 1][2], s[hh][2 * kk + 1][3]);
                        pf[hh][kk] = __builtin_bit_cast(bf16x8, pk);
                    }
                }
#pragma unroll
                for (int kk = 0; kk < 2; ++kk)
#pragma unroll
                    for (int dt = 0; dt < 8; ++dt) {
                        const unsigned char* vp = vbuf + (dt * 16 + fr) * VROW + (kk * 32 + fq * 4) * 2;
                        const bf16x4 v0 = *(const bf16x4*)vp, v1 = *(const bf16x4*)(vp + 32);
                        const bf16x8 vf = __builtin_shufflevector(v0, v1, 0, 1, 2, 3, 4, 5, 6, 7);
                        o[0][dt] = __builtin_amdgcn_mfma_f32_16x16x32_bf16(vf, pf[0][kk], o[0][dt], 0, 0, 0);
                        o[1][dt] = __builtin_amdgcn_mfma_f32_16x16x32_bf16(vf, pf[1][kk], o[1][dt], 0, 0, 0);
                    }
                }
                if (more) {
                    unsigned char* nb = shm + ((st + 1) & 1) * BUF;
#pragma unroll
                    for (int u = 0; u < 4; ++u) { *(u32x4*)(nb + klds + 32 * u * KROW) = kreg[u]; *(u32x4*)(nb + vlds + 32 * u * VROW) = vreg[u]; }
                }
                __syncthreads();
            }
#pragma unroll
            for (int hh = 0; hh < 2; ++hh) {
                float lt = lrow[hh]; lt += __shfl_xor(lt, 16); lt += __shfl_xor(lt, 32);
                const float inv = 1.0f / lt;
                bf16_t* op = proj + qrow * NP + C_Q + (kvh * 4 + hp * 2 + hh) * 128 + fq * 4;
#pragma unroll
                for (int dt = 0; dt < 8; ++dt) {
                    u32x2 w; w.x = pg8::cvt_pk_bf16(o[hh][dt][0] * inv, o[hh][dt][1] * inv); w.y = pg8::cvt_pk_bf16(o[hh][dt][2] * inv, o[hh][dt][3] * inv);
                    *(u32x2*)(op + dt * 16) = w;
                }
            }
        }
    }
}

__device__ __forceinline__ void phase_ssd_simple(int wv, KParams p, int l, bf16_t* proj, const float* misc, float* ssq, unsigned char* shm) {
    const int tid = opaque_tid(wv), lane = tid & 63;
    float* xs = (float*)shm; float* Bs = xs + 64 * 64; float* Cs = Bs + 64 * 128; float* dts = Cs + 64 * 128; float* decs = dts + 64; float* ybuf = decs + 64;
    const float* cw = p->ssd_conv_w + (size_t)l * 4 * 3072; const float* cb = p->ssd_conv_b + (size_t)l * 3072;
    for (int item = blockIdx.x; item < 128; item += gridDim.x) {
        const int bl = item >> 5, head = item & 31, g = head >> 3;
        const float Aneg = -__expf(p->ssd_a_log[l * 32 + head]), dtb = p->ssd_dt_bias[l * 32 + head], Dsk = p->ssd_d[l * 32 + head];
        const int pp = tid >> 3, ng = tid & 7;
        float hs[16];
#pragma unroll
        for (int k = 0; k < 16; ++k) hs[k] = 0.f;
        for (int c = 0; c < 64; ++c) {
            const int t0 = c * 64;
            __syncthreads();
            for (int i = 0; i < 40; ++i) {
                const int idx = tid + 512 * i, tok = idx / 320, cc = idx - tok * 320;
                int ch; float* dstp;
                if (cc < 64) { ch = head * 64 + cc; dstp = xs + tok * 64 + cc; }
                else if (cc < 192) { ch = 2048 + g * 128 + (cc - 64); dstp = Bs + tok * 128 + (cc - 64); }
                else { ch = 2560 + g * 128 + (cc - 192); dstp = Cs + tok * 128 + (cc - 192); }
                float a = cb[ch];
#pragma unroll
                for (int j = 0; j < 4; ++j) { const int tt = t0 + tok - 3 + j; if (tt >= 0) a += cw[j * 3072 + ch] * bf2f(proj[(size_t)(bl * SEQ + tt) * NP + C_XBC + ch]); }
                *dstp = silu_f(a);
            }
            if (tid < 64) {
                const float v = misc[(size_t)(bl * SEQ + t0 + tid) * 256 + 72 + head] + dtb;
                const float dt = (v > 20.f) ? v : log1pf(__expf(v));
                dts[tid] = dt; decs[tid] = __expf(dt * Aneg);
            }
            __syncthreads();
            for (int tok = 0; tok < 64; ++tok) {
                const float xv = xs[tok * 64 + pp], dt = dts[tok], dec = decs[tok], xdt = xv * dt;
                float y = 0.f;
#pragma unroll
                for (int k4 = 0; k4 < 4; ++k4) {
                    const f32x4 b4 = *(const f32x4*)(Bs + tok * 128 + ng * 16 + k4 * 4), c4 = *(const f32x4*)(Cs + tok * 128 + ng * 16 + k4 * 4);
#pragma unroll
                    for (int j = 0; j < 4; ++j) { float& hh = hs[k4 * 4 + j]; hh = hh * dec + xdt * b4[j]; y += c4[j] * hh; }
                }
                y += __shfl_xor(y, 1); y += __shfl_xor(y, 2); y += __shfl_xor(y, 4);
                if (ng == 0) ybuf[tok * 65 + pp] = y + Dsk * xv;
            }
            __syncthreads();
#pragma unroll
            for (int i = 0; i < 8; ++i) {
                const int idx = tid + 512 * i, tok = idx >> 6, p2 = idx & 63;
                bf16_t* zp = proj + (size_t)(bl * SEQ + t0 + tok) * NP + C_Z + head * 64 + p2;
                const float yg = ybuf[tok * 65 + p2] * silu_f(bf2f(*zp));
                *zp = f2bf(yg);
                const float s2 = wave_sum(yg * yg);
                if (lane == 0) ssq[(size_t)(bl * SEQ + t0 + tok) * 32 + head] = s2;
            }
        }
    }
}


__device__ __forceinline__ void phase_bcconv(int wv, KParams p, int l, const bf16_t* proj, bf16_t* bc, bf16_t* btg) {
    const int tid = opaque_tid(wv);
    const float* cw = p->ssd_conv_w + (size_t)l * 4 * 3072 + 2048; const float* cb = p->ssd_conv_b + (size_t)l * 3072 + 2048;
    for (int idx = blockIdx.x * 512 + tid; idx < 128 * (SLAB / 16); idx += gridDim.x * 512) {
        const int run = idx >> 7, c = (idx & 127) * 8, t0 = run * 16;
        float wt[4][8], bias[8];
#pragma unroll
        for (int e = 0; e < 8; ++e) { bias[e] = cb[c + e];
#pragma unroll
            for (int j = 0; j < 4; ++j) wt[j][e] = cw[j * 3072 + c + e]; }
        const bf16_t* xb = proj + (size_t)t0 * NP + C_XBC + 2048 + c;
        u32x4 r0 = (u32x4){0u, 0u, 0u, 0u}, r1 = r0, r2 = r0;
        if ((t0 & (SEQ - 1)) != 0) { r0 = *(const u32x4*)(xb - 3 * (ptrdiff_t)NP); r1 = *(const u32x4*)(xb - 2 * (ptrdiff_t)NP); r2 = *(const u32x4*)(xb - (ptrdiff_t)NP); }
        unsigned W[16][4];
#pragma unroll
        for (int tb = 0; tb < 16; tb += 4) {
            u32x4 rn[4];
#pragma unroll
            for (int u = 0; u < 4; ++u) rn[u] = *(const u32x4*)(xb + (size_t)(tb + u) * NP);
#pragma unroll
            for (int u = 0; u < 4; ++u) {
                const unsigned a0[4] = {r0.x, r0.y, r0.z, r0.w}, a1[4] = {r1.x, r1.y, r1.z, r1.w}, a2[4] = {r2.x, r2.y, r2.z, r2.w}, a3[4] = {rn[u].x, rn[u].y, rn[u].z, rn[u].w};
#pragma unroll
                for (int e = 0; e < 4; ++e) {
                    const float lo = bias[2 * e] + wt[0][2 * e] * lo16(a0[e]) + wt[1][2 * e] * lo16(a1[e]) + wt[2][2 * e] * lo16(a2[e]) + wt[3][2 * e] * lo16(a3[e]);
                    const float hi = bias[2 * e + 1] + wt[0][2 * e + 1] * hi16(a0[e]) + wt[1][2 * e + 1] * hi16(a1[e]) + wt[2][2 * e + 1] * hi16(a2[e]) + wt[3][2 * e + 1] * hi16(a3[e]);
                    W[tb + u][e] = pack2(silu_f(lo), silu_f(hi));
                }
                u32x4 o; o.x = W[tb + u][0]; o.y = W[tb + u][1]; o.z = W[tb + u][2]; o.w = W[tb + u][3];
                *(u32x4*)(bc + (size_t)(t0 + tb + u) * 1024 + c) = o;
                r0 = r1; r1 = r2; r2 = rn[u];
            }
        }
        if (c < 512) {
            bf16_t* tp = btg + ((size_t)((t0 >> 12) * 512 + c)) * SEQ + (t0 & (SEQ - 1));
#pragma unroll
            for (int e = 0; e < 4; ++e) {
                u32x4 lo0, lo1, hi0, hi1;
                lo0.x = (W[0][e] & 0xffffu) | (W[1][e] << 16); lo0.y = (W[2][e] & 0xffffu) | (W[3][e] << 16); lo0.z = (W[4][e] & 0xffffu) | (W[5][e] << 16); lo0.w = (W[6][e] & 0xffffu) | (W[7][e] << 16);
                lo1.x = (W[8][e] & 0xffffu) | (W[9][e] << 16); lo1.y = (W[10][e] & 0xffffu) | (W[11][e] << 16); lo1.z = (W[12][e] & 0xffffu) | (W[13][e] << 16); lo1.w = (W[14][e] & 0xffffu) | (W[15][e] << 16);
                hi0.x = (W[0][e] >> 16) | (W[1][e] & 0xffff0000u); hi0.y = (W[2][e] >> 16) | (W[3][e] & 0xffff0000u); hi0.z = (W[4][e] >> 16) | (W[5][e] & 0xffff0000u); hi0.w = (W[6][e] >> 16) | (W[7][e] & 0xffff0000u);
                hi1.x = (W[8][e] >> 16) | (W[9][e] & 0xffff0000u); hi1.y = (W[10][e] >> 16) | (W[11][e] & 0xffff0000u); hi1.z = (W[12][e] >> 16) | (W[13][e] & 0xffff0000u); hi1.w = (W[14][e] >> 16) | (W[15][e] & 0xffff0000u);
                *(u32x4*)(tp + (size_t)(2 * e) * SEQ) = lo0; *(u32x4*)(tp + (size_t)(2 * e) * SEQ + 8) = lo1;
                *(u32x4*)(tp + (size_t)(2 * e + 1) * SEQ) = hi0; *(u32x4*)(tp + (size_t)(2 * e + 1) * SEQ + 8) = hi1;
            }
        }
    }
}

#define SSD_SCAN(cc) do { float* dts_ = dbase + ((cc) & 1) * 384; float* acs_ = dts_ + 128; float* wdec_ = acs_ + 128; \
                const float v0 = dtr0 + dtb, v1 = dtr1 + dtb; \
                const float dt0 = (v0 > 20.f) ? v0 : log1pf(__expf(v0)), dt1 = (v1 > 20.f) ? v1 : log1pf(__expf(v1)); \
                const float a0 = dt0 * Aneg, a1 = dt1 * Aneg; \
                float sc = a0 + a1; \
                _Pragma("unroll") for (int o = 1; o < 64; o <<= 1) { const float tv = __shfl_up(sc, o); if (lane >= o) sc += tv; } \
                const float atot = __shfl(sc, 63); \
                dts_[2 * lane] = dt0; dts_[2 * lane + 1] = dt1; acs_[2 * lane] = sc - a1; acs_[2 * lane + 1] = sc; \
                wdec_[2 * lane] = dt0 * __expf(atot - (sc - a1)); wdec_[2 * lane + 1] = dt1 * __expf(atot - sc); } while (0)
__device__ __forceinline__ void phase_ssd(int wv, KParams p, int l, bf16_t* proj, const float* misc, const bf16_t* bc, const bf16_t* btg, float* ssq, unsigned char* shm, unsigned long long& tacc, unsigned long long& tst) {
    const int tid = opaque_tid(wv), wave = __builtin_amdgcn_readfirstlane(tid >> 6), lane = tid & 63, fr = lane & 15, fq = lane >> 4;
    constexpr int ROW = 272;
    unsigned char* Cr = shm; unsigned char* Br = Cr + 128 * ROW; unsigned char* BT = Br + 128 * ROW;
    unsigned char* XT = BT + 128 * ROW; unsigned char* Hb = XT + 32 * ROW;
    float* wtab = (float*)(Hb + 32 * ROW) + 768;
    float* dbase = (float*)(Hb + 32 * ROW);
    const float* cw = p->ssd_conv_w + (size_t)l * 4 * 3072; const float* cb = p->ssd_conv_b + (size_t)l * 3072;
    for (int item = blockIdx.x; item < 256; item += gridDim.x) {
        const int pr = (item & 7) * 2 + ((item >> 3) >> 4), wi = (item >> 3) & 15;
        const int bl = pr >> 2, g = pr & 3, head = g * 8 + (wi >> 1), ph = wi & 1;
        const float Aneg = -__expf(p->ssd_a_log[l * 32 + head]), dtb = p->ssd_dt_bias[l * 32 + head], Dsk = p->ssd_d[l * 32 + head];
        const int lx = tid >> 2, cgx = tid & 3, chx = head * 64 + ph * 32 + cgx * 8;
        const int sr = tid >> 4, sc16 = tid & 15;
        f32x4 Hacc[2][2];
#pragma unroll
        for (int q2 = 0; q2 < 2; ++q2) { Hacc[q2][0] = (f32x4){0.f, 0.f, 0.f, 0.f}; Hacc[q2][1] = (f32x4){0.f, 0.f, 0.f, 0.f}; }
        __syncthreads();
        for (int i = tid; i < 32 * ROW / 4; i += 512) ((unsigned*)Hb)[i] = 0u;
        if (tid < 160) { const int cgi = tid / 40, r = tid - cgi * 40, j = r >> 3, chn = head * 64 + ph * 32 + cgi * 8 + (r & 7); wtab[tid] = (j == 0) ? cb[chn] : cw[(j - 1) * 3072 + chn]; }
        __syncthreads();
        u32x4 xr[4], br[12]; float dtr0 = 0.f, dtr1 = 0.f;
        {
            const char* gb = (const char*)(proj + ((ptrdiff_t)bl * SEQ - 3) * NP + C_XBC);
            unsigned vo = (unsigned)((lx * NP + chx) * 2); asm volatile("" : "+v"(vo));
#pragma unroll
            for (int j = 0; j < 4; ++j) { xr[j] = (u32x4){0u, 0u, 0u, 0u}; if (lx - 3 + j >= 0) xr[j] = *(const u32x4*)(gb + (vo + (unsigned)(j * NP * 2))); }
            const char* hb2 = (const char*)(bc + ((size_t)bl * SEQ) * 1024);
            unsigned vb = (unsigned)((sr * 1024 + g * 128 + sc16 * 8) * 2); asm volatile("" : "+v"(vb));
            const char* tb2 = (const char*)(btg + ((size_t)(bl * 512 + g * 128)) * SEQ);
            unsigned vt2 = (unsigned)((sr * SEQ + sc16 * 8) * 2); asm volatile("" : "+v"(vt2));
#pragma unroll
            for (int u = 0; u < 4; ++u) { br[u] = *(const u32x4*)(hb2 + (vb + (unsigned)(u * 32 * 1024 * 2))); br[4 + u] = *(const u32x4*)(hb2 + (vb + (unsigned)(u * 32 * 1024 * 2 + 1024)));
                br[8 + u] = *(const u32x4*)(tb2 + (vt2 + (unsigned)(u * 32 * SEQ * 2))); }
            if (wave == 0) { const float* mp = misc + ((size_t)bl * SEQ + 2 * lane) * 256 + 72 + head; dtr0 = mp[0]; dtr1 = mp[256];
                SSD_SCAN(0);
                dtr0 = mp[128 * 256]; dtr1 = mp[128 * 256 + 256]; }
        }
        for (int c = 0; c < 32; ++c) {
            TIC(12);
            const int t0 = c * 128;
            const size_t rbase = (size_t)bl * SEQ + t0;
            const float* dts = dbase + (c & 1) * 384; const float* acs = dts + 128; const float* wdec = acs + 128;
            {
                float wt[4][8], bias[8];
                { const float* wl = wtab + cgx * 40;
                  const f32x4 b0 = *(const f32x4*)wl, b1 = *(const f32x4*)(wl + 4);
#pragma unroll
                  for (int e = 0; e < 4; ++e) { bias[e] = b0[e]; bias[4 + e] = b1[e]; }
#pragma unroll
                  for (int j = 0; j < 4; ++j) { const f32x4 w0 = *(const f32x4*)(wl + 8 + j * 8), w1 = *(const f32x4*)(wl + 12 + j * 8);
#pragma unroll
                      for (int e = 0; e < 4; ++e) { wt[j][e] = w0[e]; wt[j][4 + e] = w1[e]; } } }
                const unsigned a0[4] = {xr[0].x, xr[0].y, xr[0].z, xr[0].w}, a1[4] = {xr[1].x, xr[1].y, xr[1].z, xr[1].w}, a2[4] = {xr[2].x, xr[2].y, xr[2].z, xr[2].w}, a3[4] = {xr[3].x, xr[3].y, xr[3].z, xr[3].w};
                unsigned char* xp = XT + (cgx * 8) * ROW + lx * 2;
#pragma unroll
                for (int e = 0; e < 4; ++e) {
                    const float lo = bias[2 * e] + wt[0][2 * e] * lo16(a0[e]) + wt[1][2 * e] * lo16(a1[e]) + wt[2][2 * e] * lo16(a2[e]) + wt[3][2 * e] * lo16(a3[e]);
                    const float hi = bias[2 * e + 1] + wt[0][2 * e + 1] * hi16(a0[e]) + wt[1][2 * e + 1] * hi16(a1[e]) + wt[2][2 * e + 1] * hi16(a2[e]) + wt[3][2 * e + 1] * hi16(a3[e]);
                    *(bf16_t*)(xp + (2 * e) * ROW) = f2bf(silu_f(lo)); *(bf16_t*)(xp + (2 * e + 1) * ROW) = f2bf(silu_f(hi));
                }
            }
            {
#pragma unroll
                for (int u = 0; u < 4; ++u) {
                    *(u32x4*)(Br + (sr + 32 * u) * ROW + sc16 * 16) = br[u];
                    *(u32x4*)(Cr + (sr + 32 * u) * ROW + sc16 * 16) = br[4 + u];
                    *(u32x4*)(BT + (sr + 32 * u) * ROW + sc16 * 16) = br[8 + u];
                }
            }
            __syncthreads(); TOC(12); TIC(11);
            {
                const size_t rnext = rbase + ((c + 1 < 32) ? 128 : 0);
                const char* gb = (const char*)(proj + ((ptrdiff_t)rnext - 3) * NP + C_XBC);
                unsigned vo = (unsigned)((lx * NP + chx) * 2); asm volatile("" : "+v"(vo));
#pragma unroll
                for (int j = 0; j < 4; ++j) xr[j] = *(const u32x4*)(gb + (vo + (unsigned)(j * NP * 2)));
                const char* hb2 = (const char*)(bc + rnext * 1024);
                unsigned vb = (unsigned)((sr * 1024 + g * 128 + sc16 * 8) * 2); asm volatile("" : "+v"(vb));
                const char* tb2 = (const char*)(btg + ((size_t)(bl * 512 + g * 128)) * SEQ + (rnext - (size_t)bl * SEQ));
                unsigned vt2 = (unsigned)((sr * SEQ + sc16 * 8) * 2); asm volatile("" : "+v"(vt2));
#pragma unroll
                for (int u = 0; u < 4; ++u) { br[u] = *(const u32x4*)(hb2 + (vb + (unsigned)(u * 32 * 1024 * 2))); br[4 + u] = *(const u32x4*)(hb2 + (vb + (unsigned)(u * 32 * 1024 * 2 + 1024)));
                    br[8 + u] = *(const u32x4*)(tb2 + (vt2 + (unsigned)(u * 32 * SEQ * 2))); }
            }
            {
                const int lt = (wave < 4) ? wave : 11 - wave;
                bf16_t* zp = proj + (rbase + lt * 16 + fr) * NP + C_Z + head * 64 + ph * 32 + fq * 4;
                const u32x2 zr0 = *(const u32x2*)zp, zr1 = *(const u32x2*)(zp + 16);
                const float acs_l = acs[lt * 16 + fr];
                bf16x8 cf[4];
#pragma unroll
                for (int ks = 0; ks < 4; ++ks) cf[ks] = *(const bf16x8*)(Cr + (lt * 16 + fr) * ROW + (ks * 32 + fq * 8) * 2);
                f32x4 yacc[2];
                {
                    bf16x8 hf[2][4];
#pragma unroll
                    for (int pt = 0; pt < 2; ++pt)
#pragma unroll
                        for (int ks = 0; ks < 4; ++ks) hf[pt][ks] = *(const bf16x8*)(Hb + (pt * 16 + fr) * ROW + (ks * 32 + fq * 8) * 2);
                    const float el = __expf(acs_l);
#pragma unroll
                    for (int pt = 0; pt < 2; ++pt) {
                        yacc[pt] = (f32x4){0.f, 0.f, 0.f, 0.f};
#pragma unroll
                        for (int ks = 0; ks < 4; ++ks) yacc[pt] = __builtin_amdgcn_mfma_f32_16x16x32_bf16(hf[pt][ks], cf[ks], yacc[pt], 0, 0, 0);
                        yacc[pt] *= el;
                    }
                    __builtin_amdgcn_sched_group_barrier(0x100, 12, 0); __builtin_amdgcn_sched_group_barrier(0x008, 8, 0);
                }
                const int lloc = fr - fq * 4;
                f32x4 cbt[8];
#pragma unroll
                for (int kk = 0; kk < 4; ++kk) {
                    cbt[2 * kk] = (f32x4){0.f, 0.f, 0.f, 0.f}; cbt[2 * kk + 1] = (f32x4){0.f, 0.f, 0.f, 0.f};
                    if (2 * kk <= lt) {
                        bf16x8 bfr[2][4];
#pragma unroll
                        for (int h2 = 0; h2 < 2; ++h2)
#pragma unroll
                            for (int ks = 0; ks < 4; ++ks) bfr[h2][ks] = *(const bf16x8*)(Br + ((2 * kk + h2) * 16 + fr) * ROW + (ks * 32 + fq * 8) * 2);
#pragma unroll
                        for (int ks = 0; ks < 4; ++ks) {
                            cbt[2 * kk] = __builtin_amdgcn_mfma_f32_16x16x32_bf16(bfr[0][ks], cf[ks], cbt[2 * kk], 0, 0, 0);
                            cbt[2 * kk + 1] = __builtin_amdgcn_mfma_f32_16x16x32_bf16(bfr[1][ks], cf[ks], cbt[2 * kk + 1], 0, 0, 0);
                        }
                        __builtin_amdgcn_sched_group_barrier(0x100, 8, 0); __builtin_amdgcn_sched_group_barrier(0x008, 8, 0);
                    }
                }
                unsigned mp[8][2];
#pragma unroll
                for (int st = 0; st < 8; ++st) {
                    mp[st][0] = 0u; mp[st][1] = 0u;
                    if (st <= lt) {
                        const f32x4 av = *(const f32x4*)(acs + st * 16 + fq * 4), dv = *(const f32x4*)(dts + st * 16 + fq * 4);
                        float mv[4];
#pragma unroll
                        for (int r = 0; r < 4; ++r) {
                            const int dl = (lt - st) * 16 + lloc - r;
                            float m = (dl >= 0) ? cbt[st][r] * __expf(acs_l - av[r]) * dv[r] : 0.f;
                            if (dl == 0) m += Dsk;
                            mv[r] = m;
                        }
                        mp[st][0] = pg8::cvt_pk_bf16(mv[0], mv[1]); mp[st][1] = pg8::cvt_pk_bf16(mv[2], mv[3]);
                    }
                }
#pragma unroll
                for (int kk = 0; kk < 4; ++kk) {
                    if (2 * kk <= lt) {
                        u32x4 pk; pk.x = mp[2 * kk][0]; pk.y = mp[2 * kk][1]; pk.z = mp[2 * kk + 1][0]; pk.w = mp[2 * kk + 1][1];
                        const bf16x8 pf = __builtin_bit_cast(bf16x8, pk);
#pragma unroll
                        for (int pt = 0; pt < 2; ++pt) {
                            const unsigned char* xp = XT + (pt * 16 + fr) * ROW + (kk * 32 + fq * 4) * 2;
                            const bf16x4 v0 = *(const bf16x4*)xp, v1 = *(const bf16x4*)(xp + 32);
                            const bf16x8 xf = __builtin_shufflevector(v0, v1, 0, 1, 2, 3, 4, 5, 6, 7);
                            yacc[pt] = __builtin_amdgcn_mfma_f32_16x16x32_bf16(xf, pf, yacc[pt], 0, 0, 0);
                        }
                    }
                }
                float sq = 0.f;
#pragma unroll
                for (int pt = 0; pt < 2; ++pt) {
                    const u32x2 zr = pt ? zr1 : zr0;
                    const float y0 = yacc[pt][0] * silu_f(lo16(zr.x)), y1 = yacc[pt][1] * silu_f(hi16(zr.x)), y2 = yacc[pt][2] * silu_f(lo16(zr.y)), y3 = yacc[pt][3] * silu_f(hi16(zr.y));
                    sq += y0 * y0 + y1 * y1 + y2 * y2 + y3 * y3;
                    u32x2 w; w.x = pg8::cvt_pk_bf16(y0, y1); w.y = pg8::cvt_pk_bf16(y2, y3);
                    *(u32x2*)(zp + pt * 16) = w;
                }
                sq += __shfl_xor(sq, 16); sq += __shfl_xor(sq, 32);
                if (fq == 0) ssq[(rbase + lt * 16 + fr) * 64 + head * 2 + ph] = sq;
                if (wave < 4) {
                    const float dec = __expf(acs[127]);
#pragma unroll
                    for (int q2 = 0; q2 < 2; ++q2) { Hacc[q2][0] *= dec; Hacc[q2][1] *= dec; }
#pragma unroll
                    for (int ks = 0; ks < 4; ++ks) {
                        const f32x4 w0 = *(const f32x4*)(wdec + ks * 32 + fq * 8), w1 = *(const f32x4*)(wdec + ks * 32 + fq * 8 + 4);
                        bf16x8 xw[2];
#pragma unroll
                        for (int pt = 0; pt < 2; ++pt) {
                            const u32x4 raw = *(const u32x4*)(XT + (pt * 16 + fr) * ROW + (ks * 32 + fq * 8) * 2);
                            u32x4 sc4;
                            sc4.x = pg8::cvt_pk_bf16(lo16(raw.x) * w0[0], hi16(raw.x) * w0[1]); sc4.y = pg8::cvt_pk_bf16(lo16(raw.y) * w0[2], hi16(raw.y) * w0[3]);
                            sc4.z = pg8::cvt_pk_bf16(lo16(raw.z) * w1[0], hi16(raw.z) * w1[1]); sc4.w = pg8::cvt_pk_bf16(lo16(raw.w) * w1[2], hi16(raw.w) * w1[3]);
                            xw[pt] = __builtin_bit_cast(bf16x8, sc4);
                        }
#pragma unroll
                        for (int q2 = 0; q2 < 2; ++q2) {
                            const bf16x8 btf = *(const bf16x8*)(BT + ((wave * 2 + q2) * 16 + fr) * ROW + (ks * 32 + fq * 8) * 2);
                            Hacc[q2][0] = __builtin_amdgcn_mfma_f32_16x16x32_bf16(xw[0], btf, Hacc[q2][0], 0, 0, 0);
                            Hacc[q2][1] = __builtin_amdgcn_mfma_f32_16x16x32_bf16(xw[1], btf, Hacc[q2][1], 0, 0, 0);
                        }
                    }
                }
            }
            TOC(11); TIC(13);
            if (wave == 0 && c + 1 < 32) {
                SSD_SCAN(c + 1);
                if (c + 2 < 32) { const float* mp = misc + (rbase + 256 + 2 * lane) * 256 + 72 + head; dtr0 = mp[0]; dtr1 = mp[256]; }
            }
            __syncthreads();
            if (wave < 4) {
#pragma unroll
                for (int q2 = 0; q2 < 2; ++q2)
#pragma unroll
                    for (int pt = 0; pt < 2; ++pt)
#pragma unroll
                        for (int r = 0; r < 4; ++r) *(bf16_t*)(Hb + (pt * 16 + fq * 4 + r) * ROW + ((wave * 2 + q2) * 16 + fr) * 2) = f2bf(Hacc[q2][pt][r]);
            }
            TOC(13);
        }
    }
}

#undef SSD_SCAN
__device__ __forceinline__ void phase_gtab(int wv, const float* ssq, float* gtab) {
    const int tid = opaque_tid(wv);
    pg8::StaticOrder S; S.init(SLAB, 1024, (int)gridDim.x, (int)blockIdx.x);
    pg8::Unit u;
    for (int ui = 0; ui < 4 && S.next(ui, u); ++ui) {
        if (tid < 256) {
            const float* sp = ssq + (size_t)(u.pm * 256 + tid) * 64;
            float r[4];
#pragma unroll
            for (int g = 0; g < 4; ++g) {
                const f32x4 s0 = *(const f32x4*)(sp + g * 16), s1 = *(const f32x4*)(sp + g * 16 + 4), s2 = *(const f32x4*)(sp + g * 16 + 8), s3 = *(const f32x4*)(sp + g * 16 + 12);
                const float tot = s0[0] + s0[1] + s0[2] + s0[3] + s1[0] + s1[1] + s1[2] + s1[3] + s2[0] + s2[1] + s2[2] + s2[3] + s3[0] + s3[1] + s3[2] + s3[3];
                r[g] = rsqrtf(tot * (1.0f / 512.0f) + EPS);
            }
            float* tp = gtab + ui * 1024 + tid;
            tp[0] = r[0] / r[1]; tp[256] = r[1] / r[2]; tp[512] = r[2] / r[3]; tp[768] = r[3];
        }
    }
    __syncthreads();
}

__device__ __forceinline__ void phase_convglu(int wv, const bf16_t* U, bf16_t* GL, const float* cw, const float* cb) {
    const int tid = opaque_tid(wv);
    for (int idx = blockIdx.x * 512 + tid; idx < 352 * (SLAB / 32); idx += gridDim.x * 512) {
        const int run = idx / 352, f = (idx - run * 352) * 8, t0 = run * 32;
        float wg[3][8], wvv[3][8], bg[8], bv[8];
#pragma unroll
        for (int e = 0; e < 8; ++e) { bg[e] = cb[f + e]; bv[e] = cb[FFN + f + e];
#pragma unroll
            for (int j = 0; j < 3; ++j) { wg[j][e] = cw[j * FFN2 + f + e]; wvv[j][e] = cw[j * FFN2 + FFN + f + e]; } }
        u32x4 g0 = (u32x4){0u, 0u, 0u, 0u}, g1 = g0, v0 = g0, v1 = g0;
        if ((t0 & (SEQ - 1)) != 0) {
            const bf16_t* up = U + (size_t)(t0 - 2) * FFN2 + f;
            g0 = *(const u32x4*)up; v0 = *(const u32x4*)(up + FFN); g1 = *(const u32x4*)(up + FFN2); v1 = *(const u32x4*)(up + FFN2 + FFN);
        }
        for (int tb = 0; tb < 32; tb += 4) {
            u32x4 gn[4], vn[4];
#pragma unroll
            for (int u = 0; u < 4; ++u) { const bf16_t* up = U + (size_t)(t0 + tb + u) * FFN2 + f; gn[u] = *(const u32x4*)up; vn[u] = *(const u32x4*)(up + FFN); }
#pragma unroll
            for (int u = 0; u < 4; ++u) {
                const unsigned ga0[4] = {g0.x, g0.y, g0.z, g0.w}, ga1[4] = {g1.x, g1.y, g1.z, g1.w}, ga2[4] = {gn[u].x, gn[u].y, gn[u].z, gn[u].w};
                const unsigned va0[4] = {v0.x, v0.y, v0.z, v0.w}, va1[4] = {v1.x, v1.y, v1.z, v1.w}, va2[4] = {vn[u].x, vn[u].y, vn[u].z, vn[u].w};
                unsigned ow[4];
#pragma unroll
                for (int e = 0; e < 4; ++e) {
                    const float gl = bg[2 * e] + wg[0][2 * e] * lo16(ga0[e]) + wg[1][2 * e] * lo16(ga1[e]) + wg[2][2 * e] * lo16(ga2[e]);
                    const float gh = bg[2 * e + 1] + wg[0][2 * e + 1] * hi16(ga0[e]) + wg[1][2 * e + 1] * hi16(ga1[e]) + wg[2][2 * e + 1] * hi16(ga2[e]);
                    const float vl = bv[2 * e] + wvv[0][2 * e] * lo16(va0[e]) + wvv[1][2 * e] * lo16(va1[e]) + wvv[2][2 * e] * lo16(va2[e]);
                    const float vh = bv[2 * e + 1] + wvv[0][2 * e + 1] * hi16(va0[e]) + wvv[1][2 * e + 1] * hi16(va1[e]) + wvv[2][2 * e + 1] * hi16(va2[e]);
                    ow[e] = pack2(silu_f(gl) * vl, silu_f(gh) * vh);
                }
                u32x4 o; o.x = ow[0]; o.y = ow[1]; o.z = ow[2]; o.w = ow[3];
                *(u32x4*)(GL + (size_t)(t0 + tb + u) * FFN + f) = o;
                g0 = g1; g1 = gn[u]; v0 = v1; v1 = vn[u];
            }
        }
    }
}

__device__ __forceinline__ KParams kparams() { KParams k = (KParams)__builtin_amdgcn_kernarg_segment_ptr(); asm volatile("" : "+s"(k)); return k; }
#define WSP(T, off) ((T*)(kparams()->ws + (off)))

__global__ void __launch_bounds__(512, 2) mega(Params p_unused) {
    extern __shared__ __attribute__((aligned(16))) unsigned char shm[];
    cg::grid_group grid = cg::this_grid();
    const int wv = __builtin_amdgcn_readfirstlane((int)(threadIdx.x >> 6));
    LAS unsigned char* lds = (LAS unsigned char*)shm;
    unsigned long long tacc = 0ull, tst = 0ull;

#define NORM_MIX(l_, half_) do { KParams k_ = kparams(); const float* xi_ = ((l_) == 0) ? k_->x : k_->out; \
        phase_norm<false>(wv, xi_ + (size_t)(half_) * SLAB * 1024, k_->norm_mix_w + (l_) * 1024, WSP(bf16_t, OFF_H), nullptr, SLAB); } while (0)
#define NORM_FFN(l_, half_) do { KParams k_ = kparams(); \
        phase_norm<false>(wv, k_->out + (size_t)(half_) * SLAB * 1024, k_->norm_ffn_w + (l_) * 1024, WSP(bf16_t, OFF_H), nullptr, SLAB); } while (0)
    TIC(9); phase_convert(wv, kparams(), (float*)shm);
    NORM_MIX(0, 0);
    grid.sync(); TOC(9);
    for (int l = 0; l < DEPTH; ++l) {
        for (int half = 0; half < NSLAB; ++half) {
            const size_t r0 = (size_t)half * SLAB;
            TIC(1);
            { const float* rope = WSP(const float, OFF_ROPE);
              EpiInProj E{WSP(bf16_t, OFF_PROJ), WSP(float, OFF_MISC), rope, rope + 4096 * 16, rope + 4096 * 32, rope + 4096 * 40, WSP(bf16_t, OFF_VT)};
              pg8::gemm_phase(wv, lds, WSP(const bf16_t, OFF_H), 1024, WSP(const bf16_t, OFF_W + (size_t)l * SZ_WL), SLAB, NP, 1024, E); }
            grid.sync(); TOC(1); TIC(2);
            phase_bcconv(wv, kparams(), l, WSP(const bf16_t, OFF_PROJ), WSP(bf16_t, OFF_H), WSP(bf16_t, OFF_BTG));
            phase_idx(wv, WSP(const bf16_t, OFF_PROJ), WSP(const float, OFF_MISC), WSP(unsigned, OFF_MASK), shm);
            grid.sync(); TOC(2); TIC(3);
            phase_att(wv, WSP(bf16_t, OFF_PROJ), WSP(const bf16_t, OFF_VT), WSP(const unsigned, OFF_MASK), shm);
            __syncthreads(); TOC(3); TIC(4);
            { phase_ssd(wv, kparams(), l, WSP(bf16_t, OFF_PROJ), WSP(const float, OFF_MISC), WSP(const bf16_t, OFF_H), WSP(const bf16_t, OFF_BTG), WSP(float, OFF_SSQ), shm, tacc, tst); }
            TOC(4); TIC(10); grid.sync(); TOC(10); TIC(5);
            phase_gtab(wv, WSP(const float, OFF_SSQ), (float*)(shm + 131072));
            { EpiGateA E{WSP(bf16_t, OFF_PROJ)}; pg8::gemm_phase(wv, lds, WSP(const bf16_t, OFF_PROJ) + C_Q, NP, WSP(const bf16_t, OFF_W + (size_t)l * SZ_WL + SZ_WIN), SLAB, 1024, 1024, E); }
            { EpiGateS E{WSP(bf16_t, OFF_PROJ), (const float*)(shm + 131072)}; pg8::gemm_phase(wv, lds, WSP(const bf16_t, OFF_PROJ) + C_Z, NP, WSP(const bf16_t, OFF_W + (size_t)l * SZ_WL + SZ_WIN + SZ_WPA), SLAB, 1024, 2048, E); }
            grid.sync();
            { KParams k = kparams(); const float* xin = (l == 0) ? k->x : k->out;
              EpiResid E{xin + r0 * 1024, k->out + r0 * 1024};
              pg8::gemm_phase(wv, lds, WSP(const bf16_t, OFF_PROJ) + C_GS, NP, WSP(const bf16_t, OFF_W + (size_t)l * SZ_WL + SZ_WIN + SZ_WPA + SZ_WPS), SLAB, 1024, 1024, E); }
            if (half == 0) NORM_MIX(l, 1); else NORM_FFN(l, 0);
            grid.sync(); TOC(5);
        }
        for (int half = 0; half < NSLAB; ++half) {
            const size_t r0 = (size_t)half * SLAB;
            TIC(6);
            { EpiBf16 E{WSP(bf16_t, OFF_PROJ), FFN2};
              pg8::gemm_phase(wv, lds, WSP(const bf16_t, OFF_H), 1024, WSP(const bf16_t, OFF_W + (size_t)l * SZ_WL + SZ_WIN + SZ_WPA + SZ_WPS + SZ_WO), SLAB, FFN2, 1024, E); }
            grid.sync(); TOC(6); TIC(7);
            { KParams k = kparams(); phase_convglu(wv, WSP(const bf16_t, OFF_PROJ), WSP(bf16_t, OFF_GL), k->ffn_conv_w + (size_t)l * 3 * FFN2, k->ffn_conv_b + (size_t)l * FFN2); }
            grid.sync(); TOC(7); TIC(6);
            { KParams k = kparams(); EpiResid E{k->out + r0 * 1024, k->out + r0 * 1024};
              pg8::gemm_phase(wv, lds, WSP(const bf16_t, OFF_GL), FFN, WSP(const bf16_t, OFF_W + (size_t)l * SZ_WL + SZ_WIN + SZ_WPA + SZ_WPS + SZ_WO + SZ_WUP), SLAB, 1024, FFN, E); }
            if (half == 0) NORM_FFN(l, 1); else if (l + 1 < DEPTH) NORM_MIX(l + 1, 0);
            grid.sync(); TOC(6);
        }
    }
    { KParams k = kparams(); phase_norm<true>(wv, k->out, k->norm_final_w, nullptr, k->out, NTOK); }
    if (PROBE != 0 && blockIdx.x == 0) { const unsigned long long tend = __builtin_amdgcn_s_memrealtime() + 4ull * tacc; while (__builtin_amdgcn_s_memrealtime() < tend) __builtin_amdgcn_s_sleep(8); }
}

extern "C" void kernel_launch(void* const* d_in, const int* in_sizes, int n_in, void* d_out, int out_size, void* d_ws, size_t ws_size, hipStream_t stream) {
    static int grid_blocks = 0;
    if (!grid_blocks) {
        int dev = 0, cus = 0, per_cu = 0;
        hipGetDevice(&dev);
        hipDeviceGetAttribute(&cus, hipDeviceAttributeMultiprocessorCount, dev);
        hipFuncSetAttribute((const void*)mega, hipFuncAttributeMaxDynamicSharedMemorySize, LDS_BYTES);
        hipOccupancyMaxActiveBlocksPerMultiprocessor(&per_cu, mega, 512, LDS_BYTES);
        if (per_cu < 1) per_cu = 1;
        grid_blocks = cus * 1;
    }
    if (ws_size < OFF_END) { fprintf(stderr, "workspace too small: %zu < %zu\n", ws_size, (size_t)OFF_END); return; }
    Params p{};
    p.x = (const float*)d_in[0]; p.norm_mix_w = (const float*)d_in[1]; p.w_in = (const float*)d_in[2]; p.ssd_conv_w = (const float*)d_in[3]; p.ssd_conv_b = (const float*)d_in[4];
    p.ssd_dt_bias = (const float*)d_in[5]; p.ssd_a_log = (const float*)d_in[6]; p.ssd_d = (const float*)d_in[7]; p.ssd_norm_w = (const float*)d_in[8];
    p.w_proj_attn = (const float*)d_in[9]; p.w_proj_ssd = (const float*)d_in[10]; p.w_out = (const float*)d_in[11]; p.norm_ffn_w = (const float*)d_in[12];
    p.ffn_w_up = (const float*)d_in[13]; p.ffn_conv_w = (const float*)d_in[14]; p.ffn_conv_b = (const float*)d_in[15]; p.ffn_w_down = (const float*)d_in[16]; p.norm_final_w = (const float*)d_in[17];
    p.out = (float*)d_out; p.ws = (unsigned char*)d_ws;
    for (int i = 0; i < 16; ++i) p.invA[i] = powf(500000.0f, -(float)(2 * i) / 32.0f);
    for (int i = 0; i < 8; ++i) p.invI[i] = powf(500000.0f, -(float)(2 * i) / 16.0f);
    void* args[] = {&p};
    hipError_t e = hipLaunchCooperativeKernel((const void*)mega, dim3(grid_blocks), dim3(512), args, LDS_BYTES, stream);
    if (e != hipSuccess) fprintf(stderr, "cooperative launch failed: %s (grid %d)\n", hipGetErrorString(e), grid_blocks);
}
```
